# Optimizing an MI355X kernel written in HIP

```python
import math
import jax, jax.numpy as jnp
from jax import lax
import numpy as np

D_MODEL = 1024
BATCH = 32
SEQ = 256
DEPTH = 2
DEC_BATCH = 4
DEC_SEQ = 2048
PAST_LEN = 512

GRID_W = 64
HEAD_DIM = 64
N_Q_HEADS = 8
N_KV_HEADS = 2
Q_PER_KV = N_Q_HEADS // N_KV_HEADS
D_ATTN = N_Q_HEADS * HEAD_DIM
D_KV = N_KV_HEADS * HEAD_DIM
D_SSM = D_MODEL - D_ATTN
SSM_GROUP = 16
N_SSM_GROUPS = D_SSM // SSM_GROUP
SSM_STATE = 64
D_IN = D_ATTN + 2 * D_KV + D_SSM
D_MIX = D_ATTN + D_SSM
D_FF = ((8 * D_MODEL // 3 + 255) // 256) * 256
AXIS_DIM = HEAD_DIM // 2
ROPE_THETA = 10000.0
Q_BLOCK = 128
N_MOD = 6
EPS = 1e-6

kernel_name = "hymba_s5_gqa_prefix_dit_step"


def rmsnorm(x, g):
    xf = x.astype(jnp.float32)
    y = xf * lax.rsqrt(jnp.mean(xf * xf, axis=-1, keepdims=True) + EPS)
    return (y * g.astype(jnp.float32)).astype(x.dtype)


def axial_rope(n_tokens):
    rows = n_tokens // GRID_W
    row = jnp.repeat(jnp.arange(rows, dtype=jnp.float32), GRID_W)
    col = jnp.tile(jnp.arange(GRID_W, dtype=jnp.float32), rows)
    inv_freq = ROPE_THETA ** (-jnp.arange(0, AXIS_DIM, 2, dtype=jnp.float32) / AXIS_DIM)
    ang = jnp.concatenate([row[:, None] * inv_freq, col[:, None] * inv_freq], axis=-1)
    return jnp.cos(ang), jnp.sin(ang)


def apply_rope(x, cos, sin):
    b, l, h, d = x.shape
    xp = x.reshape(b, l, h, d // 2, 2)
    x0, x1 = xp[..., 0], xp[..., 1]
    cs = cos[None, :, None, :].astype(x.dtype)
    sn = sin[None, :, None, :].astype(x.dtype)
    out = jnp.stack([x0 * cs - x1 * sn, x0 * sn + x1 * cs], axis=-1)
    return out.reshape(b, l, h, d)


def block_attention(q, k, v):
    b, l = q.shape[0], q.shape[1]
    nb = l // Q_BLOCK
    qb = q.reshape(b, nb, Q_BLOCK, N_KV_HEADS, Q_PER_KV, HEAD_DIM).transpose(1, 0, 2, 3, 4, 5)
    scale = HEAD_DIM ** -0.5

    def one_block(q_blk):
        s = jnp.einsum("bqkgd,bskd->bkgqs", q_blk, k, preferred_element_type=jnp.float32) * scale
        p = jax.nn.softmax(s, axis=-1).astype(v.dtype)
        return jnp.einsum("bkgqs,bskd->bqkgd", p, v)

    out = lax.map(one_block, qb)
    return out.transpose(1, 0, 2, 3, 4, 5).reshape(b, l, D_ATTN)


def ssm_discretise(a_re, a_im, log_dt, b_re, b_im):
    dt = jnp.exp(log_dt.astype(jnp.float32))[:, None]
    ar = a_re.astype(jnp.float32)
    ai = a_im.astype(jnp.float32)
    mag = jnp.exp(ar * dt)
    lr = mag * jnp.cos(ai * dt)
    li = mag * jnp.sin(ai * dt)
    den = ar * ar + ai * ai
    zr = ((lr - 1.0) * ar + li * ai) / den
    zi = (li * ar - (lr - 1.0) * ai) / den
    br = b_re.astype(jnp.float32)
    bi = b_im.astype(jnp.float32)
    bbar_re = zr[..., None] * br - zi[..., None] * bi
    bbar_im = zr[..., None] * bi + zi[..., None] * br
    return lr, li, bbar_re, bbar_im


def _combine(e1, e2):
    a1r, a1i, b1r, b1i = e1
    a2r, a2i, b2r, b2i = e2
    return (a2r * a1r - a2i * a1i, a2r * a1i + a2i * a1r,
            a2r * b1r - a2i * b1i + b2r, a2r * b1i + a2i * b1r + b2i)


def ssm_direction(u, a_re, a_im, log_dt, b_re, b_im, c_re, c_im, h0, reverse):
    lr, li, bbr, bbi = ssm_discretise(a_re, a_im, log_dt, b_re, b_im)
    xr = jnp.einsum("blgh,gph->blgp", u, bbr)
    xi = jnp.einsum("blgh,gph->blgp", u, bbi)
    if h0 is not None:
        first = -1 if reverse else 0
        h0r, h0i = h0
        xr = xr.at[:, first].add(lr * h0r - li * h0i)
        xi = xi.at[:, first].add(lr * h0i + li * h0r)
    ar = jnp.broadcast_to(lr, xr.shape)
    ai = jnp.broadcast_to(li, xr.shape)
    _, _, hr, hi = lax.associative_scan(_combine, (ar, ai, xr, xi), reverse=reverse, axis=1)
    y = (jnp.einsum("blgp,ghp->blgh", hr, c_re.astype(jnp.float32))
         - jnp.einsum("blgp,ghp->blgh", hi, c_im.astype(jnp.float32)))
    return y, hr, hi


def ssm_mixer(u, p, h0, return_state):
    b, l, _ = u.shape
    uf = u.astype(jnp.float32).reshape(b, l, N_SSM_GROUPS, SSM_GROUP)
    y_sum = None
    finals = []
    for d, reverse in ((0, False), (1, True)):
        init = None if h0 is None else (h0[:, d, 0].astype(jnp.float32), h0[:, d, 1].astype(jnp.float32))
        y, hr, hi = ssm_direction(uf, p["a_re"][d], p["a_im"][d], p["log_dt"][d], p["b_re"][d],
                                  p["b_im"][d], p["c_re"][d], p["c_im"][d], init, reverse)
        y_sum = y if y_sum is None else y_sum + y
        if return_state:
            last = 0 if reverse else -1
            finals.append(jnp.stack([hr[:, last], hi[:, last]], axis=1))
    y = y_sum.reshape(b, l, D_SSM) + p["d_skip"].astype(jnp.float32) * uf.reshape(b, l, D_SSM)
    g = jax.nn.gelu(y, approximate=False).astype(u.dtype)
    out = g * jax.nn.sigmoid(g @ p["w_glu"] + p["b_glu"])
    if return_state:
        return out, jnp.stack(finals, axis=1)
    return out


def adaln(cond_act, w_mod, b_mod):
    m = (cond_act @ w_mod + b_mod).reshape(cond_act.shape[0], 1, N_MOD, D_MODEL)
    return tuple(m[:, :, i] for i in range(N_MOD))


def trunk_layer(x, mods, p, rope=None, ctx_k=None, ctx_v=None, h0=None):
    shift1, scale1, gate1, shift2, scale2, gate2 = mods
    b, l, _ = x.shape
    h = rmsnorm(x, p["norm1"]) * (1.0 + scale1) + shift1
    proj = h @ p["w_in"]
    q, k, v, u = jnp.split(proj, [D_ATTN, D_ATTN + D_KV, D_ATTN + 2 * D_KV], axis=-1)
    q = rmsnorm(q.reshape(b, l, N_Q_HEADS, HEAD_DIM), p["q_norm"])
    k = rmsnorm(k.reshape(b, l, N_KV_HEADS, HEAD_DIM), p["k_norm"])
    v = v.reshape(b, l, N_KV_HEADS, HEAD_DIM)
    is_context = rope is None
    if is_context:
        attn = block_attention(q, k, v)
        ssm_out, state = ssm_mixer(u, p, None, True)
    else:
        cos, sin = rope
        q = apply_rope(q, cos, sin)
        k_lat = apply_rope(k, cos, sin)
        k_all = jnp.concatenate([ctx_k.astype(k.dtype), k_lat], axis=1)
        v_all = jnp.concatenate([ctx_v.astype(v.dtype), v], axis=1)
        attn = block_attention(q, k_all, v_all)
        ssm_out = ssm_mixer(u, p, h0, False)
    mixed = jnp.concatenate([attn, ssm_out], axis=-1) @ p["w_out"]
    x = x + gate1 * mixed
    h2 = rmsnorm(x, p["norm2"]) * (1.0 + scale2) + shift2
    gate, up = jnp.split(h2 @ p["w_ffn_in"], [D_FF], axis=-1)
    x = x + gate2 * ((jax.nn.silu(gate) * up) @ p["w_ffn_out"])
    if is_context:
        return x, k, v, state
    return x


def setup_inputs(seed: int = 0) -> dict:
    key = jax.random.key(seed)
    ks = iter(jax.random.split(key, 40))
    f32 = jnp.float32
    G, P, H = N_SSM_GROUPS, SSM_STATE, SSM_GROUP

    def nrm(shape, scale):
        return jax.random.normal(next(ks), shape, f32) * scale

    n_idx = jnp.arange(P, dtype=f32)
    return {
        "x_prompt": nrm((BATCH, SEQ, D_MODEL), 1.0),
        "x_sample": nrm((DEC_BATCH, DEC_SEQ, D_MODEL), 1.0),
        "cache_k": nrm((DEC_BATCH, DEPTH, PAST_LEN, N_KV_HEADS, HEAD_DIM), 1.0),
        "cache_v": nrm((DEC_BATCH, DEPTH, PAST_LEN, N_KV_HEADS, HEAD_DIM), 1.0),
        "state_ssm": nrm((DEC_BATCH, DEPTH, 2, 2, G, P), 0.5),
        "c": nrm((DEC_BATCH, D_MODEL), 1.0),
        "c_ctx": nrm((D_MODEL,), 1.0),
        "w_mod": nrm((DEPTH, D_MODEL, N_MOD * D_MODEL), 0.5 * D_MODEL ** -0.5),
        "b_mod": nrm((DEPTH, N_MOD * D_MODEL), 0.01),
        "norm1": 1.0 + nrm((DEPTH, D_MODEL), 0.02),
        "norm2": 1.0 + nrm((DEPTH, D_MODEL), 0.02),
        "w_in": nrm((DEPTH, D_MODEL, D_IN), D_MODEL ** -0.5),
        "q_norm": 1.0 + nrm((DEPTH, HEAD_DIM), 0.02),
        "k_norm": 1.0 + nrm((DEPTH, HEAD_DIM), 0.02),
        "ssm_a_re": -0.5 + nrm((DEPTH, 2, G, P), 0.01),
        "ssm_a_im": math.pi * n_idx + nrm((DEPTH, 2, G, P), 0.01),
        "ssm_log_dt": jax.random.uniform(next(ks), (DEPTH, 2, G), f32, math.log(1e-3), math.log(1e-1)),
        "ssm_b_re": nrm((DEPTH, 2, G, P, H), H ** -0.5),
        "ssm_b_im": nrm((DEPTH, 2, G, P, H), H ** -0.5),
        "ssm_c_re": nrm((DEPTH, 2, G, H, P), 0.5 * P ** -0.5),
        "ssm_c_im": nrm((DEPTH, 2, G, H, P), 0.5 * P ** -0.5),
        "ssm_d": nrm((DEPTH, D_SSM), 0.5),
        "w_glu": nrm((DEPTH, D_SSM, D_SSM), D_SSM ** -0.5),
        "b_glu": nrm((DEPTH, D_SSM), 0.01),
        "w_out": nrm((DEPTH, D_MIX, D_MODEL), D_MIX ** -0.5),
        "w_ffn_in": nrm((DEPTH, D_MODEL, 2 * D_FF), D_MODEL ** -0.5),
        "w_ffn_out": nrm((DEPTH, D_FF, D_MODEL), D_FF ** -0.5),
        "final_norm": 1.0 + nrm((D_MODEL,), 0.02),
    }


def reference(x_prompt, x_sample, cache_k, cache_v, state_ssm, c, c_ctx, w_mod, b_mod, norm1, norm2,
              w_in, q_norm, k_norm, ssm_a_re, ssm_a_im, ssm_log_dt, ssm_b_re, ssm_b_im, ssm_c_re,
              ssm_c_im, ssm_d, w_glu, b_glu, w_out, w_ffn_in, w_ffn_out, final_norm):
    rope = axial_rope(x_sample.shape[1])
    cond_ctx = jax.nn.silu(c_ctx)[None, :]
    cond_lat = jax.nn.silu(c)
    xp, xs = x_prompt, x_sample
    new_k, new_v, new_s = [], [], []
    for l in range(DEPTH):
        p = {
            "norm1": norm1[l], "norm2": norm2[l], "w_in": w_in[l],
            "q_norm": q_norm[l], "k_norm": k_norm[l],
            "a_re": ssm_a_re[l], "a_im": ssm_a_im[l], "log_dt": ssm_log_dt[l],
            "b_re": ssm_b_re[l], "b_im": ssm_b_im[l], "c_re": ssm_c_re[l], "c_im": ssm_c_im[l],
            "d_skip": ssm_d[l], "w_glu": w_glu[l], "b_glu": b_glu[l], "w_out": w_out[l],
            "w_ffn_in": w_ffn_in[l], "w_ffn_out": w_ffn_out[l],
        }
        xp, k_ctx, v_ctx, s_ctx = trunk_layer(xp, adaln(cond_ctx, w_mod[l], b_mod[l]), p)
        new_k.append(k_ctx)
        new_v.append(v_ctx)
        new_s.append(s_ctx)
        xs = trunk_layer(xs, adaln(cond_lat, w_mod[l], b_mod[l]), p, rope=rope,
                         ctx_k=cache_k[:, l], ctx_v=cache_v[:, l], h0=state_ssm[:, l])
    y_prompt = rmsnorm(xp, final_norm)
    y_sample = rmsnorm(xs, final_norm)
    new_cache_k = jnp.stack(new_k, axis=1)
    new_cache_v = jnp.stack(new_v, axis=1)
    new_state_ssm = jnp.stack(new_s, axis=1)
    return (y_prompt, y_sample, new_cache_k, new_cache_v, new_state_ssm)
```

```cpp
#include <hip/hip_runtime.h>
#include <hip/hip_cooperative_groups.h>
#include <cstdio>
namespace cg = cooperative_groups;
#define DI __device__ __forceinline__
DI int ltid() { int t = threadIdx.x; asm volatile("" : "+v"(t)); return t; }

namespace pg8 {
#define PG8_LAS __attribute__((address_space(3)))
typedef unsigned short bf16_t;
typedef short bf16x8 __attribute__((ext_vector_type(8)));
typedef float f32x4 __attribute__((ext_vector_type(4)));
typedef unsigned u32x4 __attribute__((ext_vector_type(4)));
constexpr int BM = 256, BK = 64, HALF = 128, HTB = HALF * BK * 2  , STAGE_BYTES = 8 * HTB, NXCD = 8, WGM = 8;

__host__ __device__ __forceinline__ int lds_byte(int r, int c) { const int st = (r >> 4) * 2 + (c >> 5), rr = r & 15, cc = c & 31, ob = rr * 64 + cc * 2; return st * 1024 + (ob ^ (((ob >> 9) & 1) << 5)); }
__host__ __device__ __forceinline__ void stage_rc(int b, int& R, int& C) { const int st = b / 1024, sb = b % 1024, swz = sb ^ (((sb >> 9) & 1) << 5); R = (st >> 1) * 16 + swz / 64; C = (st & 1) * 32 + (swz % 64) / 2; }
__host__ __device__ __forceinline__ int perm32(int rho) { const int n = rho >> 4, i = rho & 15; return 8 * (i >> 2) + 4 * n + (i & 3); }

struct Unit { int pm, pn; };
struct Gemm { const bf16_t* A; const bf16_t* Bt; int M, N, K; };

struct StaticOrder {
    int nM, nN, nwg, G, c;
    __host__ __device__ void init(int M, int N, int G_, int c_) { nM = M / BM; nN = N / BM; nwg = nM * nN; G = G_; c = c_; }
    __host__ __device__ bool next(int i, Unit& u) const {
        const long L = (long)i * G + c; if (L >= nwg) return false;
        int wgid = (int)L; { const int q = nwg / NXCD, r = nwg % NXCD, xcd = wgid % NXCD, off = wgid / NXCD; wgid = (xcd < r ? xcd * (q + 1) : r * (q + 1) + (xcd - r) * q) + off; }
        const int nig = WGM * nN, gid = wgid / nig, fm = gid * WGM, gsz = (nM - fm) < WGM ? (nM - fm) : WGM;
        u.pm = fm + ((wgid % nig) % gsz); u.pn = (wgid % nig) / gsz; return true;
    }
    __device__ __forceinline__ void a_ready(const Unit&) const {}
    __device__ __forceinline__ void done(const Unit&) const {}
};

template <class Epi, class Sched, bool STAMP = false>
__device__ __forceinline__ void gemm_phase(PG8_LAS unsigned char* lds, const Gemm g, const Sched& S, const Epi& E, unsigned long long* stamps) {
    int tid_l = threadIdx.x; asm volatile("" : "+v"(tid_l));
    const int tid = tid_l, wid = __builtin_amdgcn_readfirstlane(tid >> 6), lane = tid & 63, wr = wid >> 2, wc = wid & 3, fr = lane & 15, fq = lane >> 4;
    const int K = g.K, nt = K / BK;
    int ts_lo = 0, ts_hi = 0, nts = 0; const unsigned long long rt_entry = STAMP ? (unsigned long long)wall_clock64() : 0ull;
#define PG8_STAMP() do { if (STAMP && wid == 0 && nts < 64) { const unsigned long long _c = (unsigned long long)clock64(); \
        ts_lo = (lane == nts) ? (int)(unsigned)_c : ts_lo; ts_hi = (lane == nts) ? (int)(unsigned)(_c >> 32) : ts_hi; ++nts; } } while (0)
    PG8_STAMP();
    unsigned voffA[2], voffB[2];
#pragma unroll
    for (int i = 0; i < 2; ++i) { int R, C; stage_rc(tid * 16 + i * 8192, R, C); const int Rb = Epi::PERM ? ((R & ~31) + perm32(R & 31)) : R;
        voffA[i] = (unsigned)(R * K + C) * 2u; voffB[i] = (unsigned)(Rb * K + C) * 2u; }
    const size_t kstep = (size_t)(BK * 2);
    const size_t hstep = (size_t)HALF * K * 2;
    const size_t tstep = 2 * hstep;
    const unsigned ldsw = (unsigned)wid * 1024u;
    const int aoff = lds_byte(wr * 64 + fr, fq * 8), boff = lds_byte(wc * 32 + fr, fq * 8);
#define PG8_SA(b, h) (((b) * 2 + (h)) * HTB)
#define PG8_SB(b, h) ((4 + (b) * 2 + (h)) * HTB)
#define PG8_STAGE(bufoff, gbase, voff) do { _Pragma("unroll") for (int _i = 0; _i < 2; ++_i) \
        __builtin_amdgcn_global_load_lds((const unsigned*)((const char*)(gbase) + (voff)[_i]), (PG8_LAS unsigned*)(lds + (bufoff) + ldsw + _i * 8192), 16, 0, 0); } while (0)
#define PG8_LDA(dst, b, h) do { _Pragma("unroll") for (int m = 0; m < 4; ++m) _Pragma("unroll") for (int k = 0; k < 2; ++k) dst[m][k] = *(const PG8_LAS bf16x8*)(lds + PG8_SA(b, h) + aoff + m * 2048 + k * 1024); } while (0)
#define PG8_LDB(dst, b, h) do { _Pragma("unroll") for (int n = 0; n < 2; ++n) _Pragma("unroll") for (int k = 0; k < 2; ++k) dst[n][k] = *(const PG8_LAS bf16x8*)(lds + PG8_SB(b, h) + boff + n * 2048 + k * 1024); } while (0)
#define PG8_MMA(ai, bj, At, Bt) do { __builtin_amdgcn_s_setprio(1); _Pragma("unroll") for (int m = 0; m < 4; ++m) _Pragma("unroll") for (int n = 0; n < 2; ++n) _Pragma("unroll") for (int k = 0; k < 2; ++k) \
        acc[ai][bj][m][n] = __builtin_amdgcn_mfma_f32_16x16x32_bf16(Bt[n][k], At[m][k], acc[ai][bj][m][n], 0, 0, 0); __builtin_amdgcn_s_setprio(0); } while (0)
#define PG8_WAIT_V(n) asm volatile("s_waitcnt vmcnt(" #n ")" ::: "memory")
#define PG8_WAIT_L(n) asm volatile("s_waitcnt lgkmcnt(" #n ")" ::: "memory")
#define PG8_BAR __builtin_amdgcn_s_barrier()
#define PG8_SCHED __builtin_amdgcn_sched_barrier(0)
    Unit cur, nxt; int ui = 0;
    if (!S.next(0, cur)) return;
    f32x4 acc[2][2][4][2];
#pragma unroll
    for (int a = 0; a < 2; ++a)
#pragma unroll
        for (int b = 0; b < 2; ++b)
#pragma unroll
            for (int m = 0; m < 4; ++m)
#pragma unroll
                for (int n = 0; n < 2; ++n) acc[a][b][m][n] = (f32x4){0.f, 0.f, 0.f, 0.f};
    bf16x8 At[4][2], B0[2][2], B1[2][2];
    const char* cA = (const char*)g.A + (size_t)cur.pm * tstep; const char* cB = (const char*)g.Bt + (size_t)cur.pn * tstep;
    S.a_ready(cur);
    PG8_STAGE(PG8_SB(0, 0), cB, voffB); PG8_STAGE(PG8_SA(0, 0), cA, voffA); PG8_STAGE(PG8_SB(0, 1), cB + hstep, voffB); PG8_STAGE(PG8_SA(0, 1), cA + hstep, voffA);
    if (wr == 1) PG8_BAR;
    PG8_WAIT_V(4); PG8_BAR;
    PG8_STAGE(PG8_SB(1, 0), cB + kstep, voffB); PG8_STAGE(PG8_SA(1, 0), cA + kstep, voffA); PG8_STAGE(PG8_SB(1, 1), cB + hstep + kstep, voffB);
    PG8_WAIT_V(6); PG8_BAR;
    PG8_STAMP();
    for (;;) {
        const bool has_next = S.next(ui + 1, nxt);
        const char* nA = has_next ? (const char*)g.A + (size_t)nxt.pm * tstep : cA; const char* nB = has_next ? (const char*)g.Bt + (size_t)nxt.pn * tstep : cB;
        for (int t = 0; t < nt; t += 2) {
            const bool last = (t == nt - 2);
            const char* a1 = cA + (size_t)(t + 1) * kstep;
            const char* a2 = last ? nA : cA + (size_t)(t + 2) * kstep; const char* b2 = last ? nB : cB + (size_t)(t + 2) * kstep;
            const char* a3 = a2 + kstep; const char* b3 = b2 + kstep;
            if (last && has_next) S.a_ready(nxt);
            PG8_LDB(B0, 0, 0); PG8_SCHED; PG8_LDA(At, 0, 0); PG8_STAGE(PG8_SA(1, 1), a1 + hstep, voffA);
            PG8_WAIT_L(8); PG8_BAR; PG8_WAIT_L(0); PG8_MMA(0, 0, At, B0); PG8_BAR; PG8_SCHED;
            PG8_LDB(B1, 0, 1); PG8_STAGE(PG8_SB(0, 0), b2, voffB);
            PG8_BAR; PG8_WAIT_L(0); PG8_MMA(0, 1, At, B1); PG8_BAR;
            PG8_LDA(At, 0, 1); PG8_STAGE(PG8_SA(0, 0), a2, voffA);
            PG8_BAR; PG8_WAIT_L(0); PG8_MMA(1, 0, At, B0); PG8_BAR; PG8_SCHED;
            PG8_STAGE(PG8_SB(0, 1), b2 + hstep, voffB);
            PG8_WAIT_V(6); PG8_BAR; PG8_MMA(1, 1, At, B1); PG8_BAR;
            PG8_LDB(B0, 1, 0); PG8_SCHED; PG8_LDA(At, 1, 0); PG8_STAGE(PG8_SA(0, 1), a2 + hstep, voffA);
            PG8_WAIT_L(8); PG8_BAR; PG8_WAIT_L(0); PG8_MMA(0, 0, At, B0); PG8_BAR; PG8_SCHED;
            PG8_LDB(B1, 1, 1); PG8_STAGE(PG8_SB(1, 0), b3, voffB);
            PG8_BAR; PG8_WAIT_L(0); PG8_MMA(0, 1, At, B1); PG8_BAR;
            PG8_LDA(At, 1, 1); PG8_STAGE(PG8_SA(1, 0), a3, voffA);
            PG8_BAR; PG8_WAIT_L(0); PG8_MMA(1, 0, At, B0); PG8_BAR; PG8_SCHED;
            PG8_STAGE(PG8_SB(1, 1), b3 + hstep, voffB);
            PG8_WAIT_V(6); PG8_BAR; PG8_MMA(1, 1, At, B1); PG8_BAR;
        }
        PG8_STAMP();
        if constexpr (!Epi::AFTER_DRAIN) { E(acc, cur, wr, wc, fr, fq); S.done(cur); }
        PG8_STAMP();
        if (!has_next) break;
#pragma unroll
        for (int a = 0; a < 2; ++a)
#pragma unroll
            for (int b = 0; b < 2; ++b)
#pragma unroll
                for (int m = 0; m < 4; ++m)
#pragma unroll
                    for (int n = 0; n < 2; ++n) acc[a][b][m][n] = (f32x4){0.f, 0.f, 0.f, 0.f};
        cur = nxt; cA = nA; cB = nB; ++ui;
    }
    PG8_WAIT_V(0);
    if (wr == 0) PG8_BAR;
    PG8_BAR;
    if constexpr (Epi::AFTER_DRAIN) { E.fused(acc, cur, wr, wc, fr, fq, lds, wid, lane); S.done(cur); }
    PG8_STAMP();
    if (STAMP && wid == 0) { stamps[lane] = lane < nts ? (((unsigned long long)(unsigned)ts_hi << 32) | (unsigned)ts_lo) : 0ull;
        if (lane == 62) stamps[62] = rt_entry; if (lane == 63) stamps[63] = (unsigned long long)wall_clock64(); }
#undef PG8_STAMP
#undef PG8_SA
#undef PG8_SB
#undef PG8_STAGE
#undef PG8_LDA
#undef PG8_LDB
#undef PG8_MMA
#undef PG8_WAIT_V
#undef PG8_WAIT_L
#undef PG8_BAR
#undef PG8_SCHED
}
}

typedef unsigned short bf16_t;
typedef short bf16x8 __attribute__((ext_vector_type(8)));
typedef short s16x4 __attribute__((ext_vector_type(4)));
typedef float f32x4 __attribute__((ext_vector_type(4)));
typedef float f32x2 __attribute__((ext_vector_type(2)));
typedef float f32x16 __attribute__((ext_vector_type(16)));
typedef unsigned u32x4 __attribute__((ext_vector_type(4)));
typedef unsigned u32x2 __attribute__((ext_vector_type(2)));
typedef __bf16 bf16x2_t __attribute__((ext_vector_type(2)));

constexpr int NTOK = 16384, DM = 1024, NCTX = 8192;
constexpr size_t SZ_WIN = (size_t)1280 * 1024 * 2, SZ_WGLU = (size_t)512 * 512 * 2, SZ_WOUT = (size_t)1024 * 1024 * 2, SZ_WF1 = (size_t)5632 * 1024 * 2, SZ_WF2 = (size_t)1024 * 2816 * 2;
constexpr size_t WS_WIN = 0, WS_WGLU = WS_WIN + 2 * SZ_WIN, WS_WOUT = WS_WGLU + 2 * SZ_WGLU, WS_WF1 = WS_WOUT + 2 * SZ_WOUT, WS_WF2 = WS_WF1 + 2 * SZ_WF1;
constexpr size_t WS_H = WS_WF2 + 2 * SZ_WF2;
constexpr size_t WS_Q = WS_H + (size_t)NTOK * 1024 * 2;
constexpr size_t WS_U = WS_Q + (size_t)NTOK * 512 * 2;
constexpr size_t WS_MIX = WS_U + (size_t)NTOK * 512 * 2;
constexpr size_t WS_G = WS_MIX + (size_t)NTOK * 1024 * 2;
constexpr size_t WS_ACT = WS_Q;
constexpr size_t WS_KLAT = WS_ACT + (size_t)NTOK * 2816 * 2;
constexpr size_t SZ_KLAT = (size_t)4 * 2 * 2560 * 64 * 2;
constexpr size_t WS_VLAT = WS_KLAT + 2 * SZ_KLAT;
constexpr size_t WS_KCTX = WS_VLAT + 2 * SZ_KLAT;
constexpr size_t SZ_KCTX = (size_t)32 * 2 * 256 * 64 * 2;
constexpr size_t WS_VCTX = WS_KCTX + SZ_KCTX;
constexpr size_t WS_MODS = WS_VCTX + SZ_KCTX;
constexpr size_t SZ_MODS = (size_t)2 * 5 * 6144 * 4;
constexpr size_t WS_ROPEC = WS_MODS + SZ_MODS;
constexpr size_t WS_ROPES = WS_ROPEC + (size_t)2048 * 32 * 4;
constexpr size_t WS_SSMB = WS_ROPES + (size_t)2048 * 32 * 4;
constexpr size_t WS_SSMC = WS_SSMB + (size_t)128 * 4096;
constexpr size_t WS_SSML = WS_SSMC + (size_t)128 * 4096;
constexpr size_t WS_SSEG = WS_SSML + (size_t)128 * 512;
constexpr size_t WS_END = WS_SSEG + (size_t)32 * 2 * 32 * 64 * 2 * 4;
constexpr size_t OUT_K = (size_t)2 * 8388608, OUT_V = OUT_K + 2097152, OUT_S = OUT_V + 2097152;
constexpr int LDS_BYTES = 131072;

struct Params { const float* in[28]; float* out; unsigned char* ws; };

DI unsigned pk2(float lo, float hi) { f32x2 v = {lo, hi}; return __builtin_bit_cast(unsigned, __builtin_convertvector(v, bf16x2_t)); }
DI float bf2f(bf16_t b) { return __uint_as_float(((unsigned)b) << 16); }
DI float bflo(unsigned w) { return __uint_as_float(w << 16); }
DI float bfhi(unsigned w) { return __uint_as_float(w & 0xffff0000u); }
DI bf16x8 pack8(float a0, float a1, float a2, float a3, float a4, float a5, float a6, float a7) {
    u32x4 p; p.x = pk2(a0, a1); p.y = pk2(a2, a3); p.z = pk2(a4, a5); p.w = pk2(a6, a7); return __builtin_bit_cast(bf16x8, p); }
DI f32x16 mfma32(bf16x8 a, bf16x8 b, f32x16 c) { return __builtin_amdgcn_mfma_f32_32x32x16_bf16(a, b, c, 0, 0, 0); }
DI f32x4 mfma16(bf16x8 a, bf16x8 b, f32x4 c) { return __builtin_amdgcn_mfma_f32_16x16x32_bf16(a, b, c, 0, 0, 0); }
DI float sigmoidf_(float x) { return __builtin_amdgcn_rcpf(1.0f + __expf(-x)); }

DI void tconv_tile(const float* __restrict__ src, size_t sld, int ca, int cb, bf16_t* __restrict__ dst, size_t dld, float* lds) {
    const int tid = ltid();
#pragma unroll
    for (int i = 0; i < 8; ++i) { const int idx = i * 512 + tid, kk = idx >> 6, nn = idx & 63; const int col = nn < 32 ? ca + nn : cb + nn - 32;
        lds[nn * 65 + kk] = src[(size_t)kk * sld + col]; }
    __syncthreads();
    { const int nn = tid >> 3, k8 = (tid & 7) * 8; const float* r = lds + nn * 65 + k8;
      u32x4 w; w.x = pk2(r[0], r[1]); w.y = pk2(r[2], r[3]); w.z = pk2(r[4], r[5]); w.w = pk2(r[6], r[7]);
      *(u32x4*)(dst + (size_t)nn * dld + k8) = w; }
    __syncthreads();
}
DI int srccol_in(int np) { const int pn = np >> 8, cpos = np & 255, bj = cpos >> 7, wc = (cpos >> 5) & 3, w = cpos & 31; return pn * 256 + wc * 64 + bj * 32 + w; }
DI int srccol_f1(int np) { const int tile = np >> 8, bj = (np >> 7) & 1, i = np & 127; return bj * 2816 + tile * 128 + i; }

DI void wconv_task(const Params& P, int t, float* lds) {
    const int l = t / 2752; int r = t % 2752;
    unsigned char* ws = P.ws;
    if (r < 320) { const int kt = r & 15, ntl = r >> 4, n0 = ntl * 64, k0 = kt * 64;
        tconv_tile(P.in[11] + ((size_t)l * 1024 + k0) * 1280, 1280, srccol_in(n0), srccol_in(n0 + 32), (bf16_t*)(ws + WS_WIN + l * SZ_WIN) + (size_t)n0 * 1024 + k0, 1024, lds); return; }
    r -= 320;
    if (r < 64) { const int kt = r & 7, ntl = r >> 3, n0 = ntl * 64, k0 = kt * 64;
        tconv_tile(P.in[22] + ((size_t)l * 512 + k0) * 512, 512, n0, n0 + 32, (bf16_t*)(ws + WS_WGLU + l * SZ_WGLU) + (size_t)n0 * 512 + k0, 512, lds); return; }
    r -= 64;
    if (r < 256) { const int kt = r & 15, ntl = r >> 4, n0 = ntl * 64, k0 = kt * 64;
        tconv_tile(P.in[24] + ((size_t)l * 1024 + k0) * 1024, 1024, n0, n0 + 32, (bf16_t*)(ws + WS_WOUT + l * SZ_WOUT) + (size_t)n0 * 1024 + k0, 1024, lds); return; }
    r -= 256;
    if (r < 1408) { const int kt = r & 15, ntl = r >> 4, n0 = ntl * 64, k0 = kt * 64;
        tconv_tile(P.in[25] + ((size_t)l * 1024 + k0) * 5632, 5632, srccol_f1(n0), srccol_f1(n0 + 32), (bf16_t*)(ws + WS_WF1 + l * SZ_WF1) + (size_t)n0 * 1024 + k0, 1024, lds); return; }
    r -= 1408;
    { const int kt = r % 44, ntl = r / 44, n0 = ntl * 64, k0 = kt * 64;
        tconv_tile(P.in[26] + ((size_t)l * 2816 + k0) * 1024, 1024, n0, n0 + 32, (bf16_t*)(ws + WS_WF2 + l * SZ_WF2) + (size_t)n0 * 2816 + k0, 2816, lds); }
}

DI void adaln_task(const Params& P, int task, float* lds) {
    const int tid = ltid(), w = tid >> 6, lane = tid & 63;
    const int kc = task & 7, cgp = (task >> 3) % 24, l = task / 192;
    const int n = cgp * 256 + lane * 4;
    const float* wm = P.in[7] + ((size_t)l * 1024) * 6144 + n;
    const float* cc = P.in[5]; const float* cx = P.in[6];
    float* mods = (float*)(P.ws + WS_MODS);
    f32x4 acc[5];
#pragma unroll
    for (int j = 0; j < 5; ++j) acc[j] = (f32x4){0.f, 0.f, 0.f, 0.f};
    const int k0 = kc * 128 + w * 16;
#pragma unroll 4
    for (int kk = 0; kk < 16; ++kk) { const int k = k0 + kk; const f32x4 wv = *(const f32x4*)(wm + (size_t)k * 6144);
#pragma unroll
        for (int j = 0; j < 5; ++j) { const float cv = (j == 0) ? cx[k] : cc[(j - 1) * 1024 + k]; const float sv = cv / (1.0f + __expf(-cv)); acc[j] += wv * sv; } }
#pragma unroll
    for (int j = 0; j < 5; ++j) *(f32x4*)(lds + (w * 5 + j) * 256 + lane * 4) = acc[j];
    __syncthreads();
    for (int e = tid; e < 1280; e += 512) { const int j = e >> 8, col = e & 255; float s = 0.f;
#pragma unroll
        for (int ww = 0; ww < 8; ++ww) s += lds[(ww * 5 + j) * 256 + col];
        const int nn = cgp * 256 + col; if (kc == 0) s += P.in[8][l * 6144 + nn];
        atomicAdd(mods + (l * 5 + j) * 6144 + nn, s); }
    __syncthreads();
}

DI void ssmconst_task(const Params& P, int task) {
    const int idx = task * 512 + ltid(); const int p = idx & 63, ldg = idx >> 6;
    const double dt = exp((double)P.in[16][ldg]); const double ar = (double)P.in[14][ldg * 64 + p], ai = (double)P.in[15][ldg * 64 + p];
    const double mag = exp(ar * dt); double sn, cs; sincos(ai * dt, &sn, &cs);
    const double lr = mag * cs, li = mag * sn, den = ar * ar + ai * ai;
    const double zr = ((lr - 1.0) * ar + li * ai) / den, zi = (li * ar - (lr - 1.0) * ai) / den;
    float* lam = (float*)(P.ws + WS_SSML); lam[(ldg * 64 + p) * 2] = (float)lr; lam[(ldg * 64 + p) * 2 + 1] = (float)li;
    bf16_t* Bm = (bf16_t*)(P.ws + WS_SSMB); bf16_t* Cm = (bf16_t*)(P.ws + WS_SSMC);
    const float* bre = P.in[17] + ((size_t)ldg * 64 + p) * 16; const float* bim = P.in[18] + ((size_t)ldg * 64 + p) * 16;
    const int ntb = (p >= 32) ? 2 : 0;
    for (int h = 0; h < 16; ++h) { const double br = bre[h], bi = bim[h]; const float bbr = (float)(zr * br - zi * bi), bbi = (float)(zr * bi + zi * br);
        const int ln = (p & 31) + 32 * (h >> 3), j = h & 7;
        Bm[(((size_t)ldg * 4 + ntb) * 64 + ln) * 8 + j] = (bf16_t)(pk2(bbr, 0.f) & 0xffffu);
        Bm[(((size_t)ldg * 4 + ntb + 1) * 64 + ln) * 8 + j] = (bf16_t)(pk2(bbi, 0.f) & 0xffffu); }
    for (int hp = 0; hp < 16; ++hp) { const float cr = P.in[19][((size_t)ldg * 16 + hp) * 64 + p], ci = P.in[20][((size_t)ldg * 16 + hp) * 64 + p];
#pragma unroll
        for (int ri = 0; ri < 2; ++ri) { const int pp = 2 * p + ri, ks = pp >> 5, kq = (pp >> 3) & 3, j = pp & 7;
            Cm[(((size_t)ldg * 4 + ks) * 64 + kq * 16 + hp) * 8 + j] = (bf16_t)(pk2(ri ? -ci : cr, 0.f) & 0xffffu); } }
}

DI void phase0(const Params& P, unsigned char* shm) {
    float* lds = (float*)shm;
    constexpr int T_ADA = 384, T_W = 5504, T_V = 128, T_K = 128, T_S = 16, T_R = 128;
    constexpr int T_TOTAL = T_ADA + T_W + T_V + T_K + T_S + T_R;
    for (int t = blockIdx.x; t < T_TOTAL; t += gridDim.x) {
        int r = t;
        if (r < T_ADA) { adaln_task(P, r, lds); continue; }
        r -= T_ADA;
        if (r < T_W) { wconv_task(P, r, lds); continue; }
        r -= T_W;
        if (r < T_V) { const int s8 = r & 7, kvh = (r >> 3) & 1, b = (r >> 4) & 3, l = r >> 6;
            tconv_tile(P.in[3] + (((size_t)(b * 2 + l) * 512 + s8 * 64) * 2 + kvh) * 64, 128, 0, 32,
                       (bf16_t*)(P.ws + WS_VLAT + l * SZ_KLAT) + ((size_t)(b * 2 + kvh) * 64) * 2560 + s8 * 64, 2560, lds); continue; }
        r -= T_V;
        if (r < T_K) { const int idx = r * 4096 + ltid() * 8; const int d = idx & 63, s = (idx >> 6) & 511, kvh = (idx >> 15) & 1, b = (idx >> 16) & 3, l = idx >> 18;
            const float* src = P.in[2] + ((((size_t)(b * 2 + l) * 512 + s) * 2 + kvh) * 64 + d);
            const f32x4 a = *(const f32x4*)src, c = *(const f32x4*)(src + 4);
            u32x4 w; w.x = pk2(a[0], a[1]); w.y = pk2(a[2], a[3]); w.z = pk2(c[0], c[1]); w.w = pk2(c[2], c[3]);
            *(u32x4*)((bf16_t*)(P.ws + WS_KLAT + l * SZ_KLAT) + ((size_t)(b * 2 + kvh) * 2560 + s) * 64 + d) = w; continue; }
        r -= T_K;
        if (r < T_S) { ssmconst_task(P, r); continue; }
        r -= T_S;
        { const int idx = r * 512 + ltid(); const int tt = idx >> 5, i = idx & 31; const int pos = (i < 16) ? (tt >> 6) : (tt & 63); const int f = i & 15;
          const double inv = pow(10000.0, -(2.0 * f) / 32.0); double sn, cs; sincos((double)pos * inv, &sn, &cs);
          ((float*)(P.ws + WS_ROPEC))[idx] = (float)cs; ((float*)(P.ws + WS_ROPES))[idx] = (float)sn; }
    }
}

DI float wave_sum(float v) {
    v += __shfl_xor(v, 32); v += __shfl_xor(v, 16); v += __shfl_xor(v, 8); v += __shfl_xor(v, 4); v += __shfl_xor(v, 2); v += __shfl_xor(v, 1); return v; }

DI void norm_phase(const float* __restrict__ xa, const float* __restrict__ xb, const float* __restrict__ gw, const float* __restrict__ mods_l, int shift_i, int scale_i, bf16_t* __restrict__ H) {
    const int tidl = ltid(); const int lane = tidl & 63, w = tidl >> 6;
    for (int row = blockIdx.x * 8 + w; row < NTOK; row += gridDim.x * 8) {
        const float* xr = row < NCTX ? xa + (size_t)row * 1024 : xb + (size_t)(row - NCTX) * 1024;
        const int j = row < NCTX ? 0 : 1 + ((row - NCTX) >> 11);
        f32x4 v[4]; float ss = 0.f;
#pragma unroll
        for (int i = 0; i < 4; ++i) { v[i] = *(const f32x4*)(xr + i * 256 + lane * 4); ss += v[i][0] * v[i][0] + v[i][1] * v[i][1] + v[i][2] * v[i][2] + v[i][3] * v[i][3]; }
        ss = wave_sum(ss);
        const float rstd = rsqrtf(ss * (1.0f / 1024.0f) + 1e-6f);
#pragma unroll
        for (int i = 0; i < 4; ++i) { const int col = i * 256 + lane * 4;
            const f32x4 g4 = *(const f32x4*)(gw + col), sc = *(const f32x4*)(mods_l + j * 6144 + scale_i * 1024 + col), sh = *(const f32x4*)(mods_l + j * 6144 + shift_i * 1024 + col);
            const f32x4 o = v[i] * rstd * g4 * (sc + 1.0f) + sh;
            u32x2 pw; pw.x = pk2(o[0], o[1]); pw.y = pk2(o[2], o[3]);
            *(u32x2*)(H + (size_t)row * 1024 + col) = pw; }
    }
}

DI void final_norm_phase(float* __restrict__ X, const float* __restrict__ gw) {
    const int tidl = ltid(); const int lane = tidl & 63, w = tidl >> 6;
    for (int row = blockIdx.x * 8 + w; row < NTOK; row += gridDim.x * 8) {
        float* xr = X + (size_t)row * 1024;
        f32x4 v[4]; float ss = 0.f;
#pragma unroll
        for (int i = 0; i < 4; ++i) { v[i] = *(const f32x4*)(xr + i * 256 + lane * 4); ss += v[i][0] * v[i][0] + v[i][1] * v[i][1] + v[i][2] * v[i][2] + v[i][3] * v[i][3]; }
        ss = wave_sum(ss);
        const float rstd = rsqrtf(ss * (1.0f / 1024.0f) + 1e-6f);
#pragma unroll
        for (int i = 0; i < 4; ++i) { const int col = i * 256 + lane * 4; const f32x4 g4 = *(const f32x4*)(gw + col); *(f32x4*)(xr + col) = v[i] * rstd * g4; }
    }
}

struct EpiIn {
    static constexpr bool PERM = false, AFTER_DRAIN = false;
    int layer; const float* qn; const float* kn; const float* ropec; const float* ropes;
    bf16_t* Q; bf16_t* U; bf16_t* Kctx; bf16_t* Vctx; bf16_t* Klat; bf16_t* Vlat; float* outk; float* outv;
    DI void operator()(const f32x4 (&acc)[2][2][4][2], const pg8::Unit& u, int wr, int wc, int fr, int fq) const {
        const bool lat = u.pm >= 32; const int pn = u.pn;
        if (pn >= 3) {
#pragma unroll
            for (int ai = 0; ai < 2; ++ai)
#pragma unroll
                for (int m = 0; m < 4; ++m) { const int row = u.pm * 256 + ai * 128 + wr * 64 + m * 16 + fr;
#pragma unroll
                    for (int bj = 0; bj < 2; ++bj)
#pragma unroll
                        for (int n = 0; n < 2; ++n) { const int col = (pn - 3) * 256 + 64 * wc + 32 * bj + 16 * n + 4 * fq; const f32x4 a = acc[ai][bj][m][n];
                            u32x2 pw; pw.x = pk2(a[0], a[1]); pw.y = pk2(a[2], a[3]); *(u32x2*)(U + (size_t)row * 512 + col) = pw; } }
            return;
        }
        if (pn == 2 && wc >= 2) {
            const int kvh = wc - 2;
#pragma unroll
            for (int ai = 0; ai < 2; ++ai)
#pragma unroll
                for (int m = 0; m < 4; ++m) { const int row = u.pm * 256 + ai * 128 + wr * 64 + m * 16 + fr;
                    if (!lat) { const int b = row >> 8, t = row & 255; float* ov = outv + (((size_t)(b * 2 + layer) * 256 + t) * 2 + kvh) * 64; bf16_t* vt = Vctx + ((size_t)(b * 2 + kvh) * 64) * 256 + t;
#pragma unroll
                        for (int bj = 0; bj < 2; ++bj)
#pragma unroll
                            for (int n = 0; n < 2; ++n) { const int d = 32 * bj + 16 * n + 4 * fq; const f32x4 a = acc[ai][bj][m][n]; *(f32x4*)(ov + d) = a;
                                const unsigned p0 = pk2(a[0], a[1]), p1 = pk2(a[2], a[3]);
                                vt[(size_t)(d + 0) * 256] = (bf16_t)(p0 & 0xffffu); vt[(size_t)(d + 1) * 256] = (bf16_t)(p0 >> 16); vt[(size_t)(d + 2) * 256] = (bf16_t)(p1 & 0xffffu); vt[(size_t)(d + 3) * 256] = (bf16_t)(p1 >> 16); } }
                    else { const int rl = row - NCTX, b = rl >> 11, t = rl & 2047; bf16_t* vt = Vlat + ((size_t)(b * 2 + kvh) * 64) * 2560 + 512 + t;
#pragma unroll
                        for (int bj = 0; bj < 2; ++bj)
#pragma unroll
                            for (int n = 0; n < 2; ++n) { const int d = 32 * bj + 16 * n + 4 * fq; const f32x4 a = acc[ai][bj][m][n];
                                const unsigned p0 = pk2(a[0], a[1]), p1 = pk2(a[2], a[3]);
                                vt[(size_t)(d + 0) * 2560] = (bf16_t)(p0 & 0xffffu); vt[(size_t)(d + 1) * 2560] = (bf16_t)(p0 >> 16); vt[(size_t)(d + 2) * 2560] = (bf16_t)(p1 & 0xffffu); vt[(size_t)(d + 3) * 2560] = (bf16_t)(p1 >> 16); } } }
            return;
        }
        const bool isq = pn < 2; const float* nw = isq ? qn : kn;
        f32x4 w4[2][2];
#pragma unroll
        for (int bj = 0; bj < 2; ++bj)
#pragma unroll
            for (int n = 0; n < 2; ++n) w4[bj][n] = *(const f32x4*)(nw + 32 * bj + 16 * n + 4 * fq);
        const float qscale = isq ? 0.125f * 1.4426950408889634f : 1.0f;
#pragma unroll
        for (int ai = 0; ai < 2; ++ai)
#pragma unroll
            for (int m = 0; m < 4; ++m) { const int row = u.pm * 256 + ai * 128 + wr * 64 + m * 16 + fr;
                float ss = 0.f;
#pragma unroll
                for (int bj = 0; bj < 2; ++bj)
#pragma unroll
                    for (int n = 0; n < 2; ++n) { const f32x4 a = acc[ai][bj][m][n]; ss += a[0] * a[0] + a[1] * a[1] + a[2] * a[2] + a[3] * a[3]; }
                ss += __shfl_xor(ss, 16); ss += __shfl_xor(ss, 32);
                const float rstd = rsqrtf(ss * (1.0f / 64.0f) + 1e-6f);
                f32x4 v[2][2];
#pragma unroll
                for (int bj = 0; bj < 2; ++bj)
#pragma unroll
                    for (int n = 0; n < 2; ++n) v[bj][n] = acc[ai][bj][m][n] * rstd * w4[bj][n];
                if (!lat) {
                    const int b = row >> 8, t = row & 255;
                    if (isq) { bf16_t* qp = Q + (size_t)row * 512 + (pn * 4 + wc) * 64;
#pragma unroll
                        for (int bj = 0; bj < 2; ++bj)
#pragma unroll
                            for (int n = 0; n < 2; ++n) { const f32x4 a = v[bj][n] * qscale; u32x2 pw; pw.x = pk2(a[0], a[1]); pw.y = pk2(a[2], a[3]); *(u32x2*)(qp + 32 * bj + 16 * n + 4 * fq) = pw; } }
                    else { const int kvh = wc; float* ok = outk + (((size_t)(b * 2 + layer) * 256 + t) * 2 + kvh) * 64; bf16_t* kp = Kctx + ((size_t)(b * 2 + kvh) * 256 + t) * 64;
#pragma unroll
                        for (int bj = 0; bj < 2; ++bj)
#pragma unroll
                            for (int n = 0; n < 2; ++n) { const int d = 32 * bj + 16 * n + 4 * fq; const f32x4 a = v[bj][n]; *(f32x4*)(ok + d) = a;
                                u32x2 pw; pw.x = pk2(a[0], a[1]); pw.y = pk2(a[2], a[3]); *(u32x2*)(kp + d) = pw; } }
                } else {
                    const int rl = row - NCTX, b = rl >> 11, t = rl & 2047;
                    bf16_t* dst = isq ? Q + (size_t)row * 512 + (pn * 4 + wc) * 64 : Klat + ((size_t)(b * 2 + wc) * 2560 + 512 + t) * 64;
#pragma unroll
                    for (int bj = 0; bj < 2; ++bj)
#pragma unroll
                        for (int n = 0; n < 2; ++n) { const int d = 32 * bj + 16 * n + 4 * fq; const int pi = d >> 1;
                            const f32x2 c2 = *(const f32x2*)(ropec + t * 32 + pi), s2 = *(const f32x2*)(ropes + t * 32 + pi); const f32x4 a = v[bj][n];
                            const float o0 = (a[0] * c2[0] - a[1] * s2[0]) * qscale, o1 = (a[0] * s2[0] + a[1] * c2[0]) * qscale, o2 = (a[2] * c2[1] - a[3] * s2[1]) * qscale, o3 = (a[2] * s2[1] + a[3] * c2[1]) * qscale;
                            u32x2 pw; pw.x = pk2(o0, o1); pw.y = pk2(o2, o3); *(u32x2*)(dst + d) = pw; }
                }
            }
    }
};

struct EpiGlu {
    static constexpr bool PERM = true, AFTER_DRAIN = false;
    const bf16_t* G; const float* bias; bf16_t* MIX;
    DI void operator()(const f32x4 (&acc)[2][2][4][2], const pg8::Unit& u, int wr, int wc, int fr, int fq) const {
#pragma unroll
        for (int ai = 0; ai < 2; ++ai)
#pragma unroll
            for (int m = 0; m < 4; ++m) { const int row = u.pm * 256 + ai * 128 + wr * 64 + m * 16 + fr;
#pragma unroll
                for (int bj = 0; bj < 2; ++bj) { const int c0 = u.pn * 256 + 128 * bj + 32 * wc + 8 * fq;
                    const u32x4 gw = *(const u32x4*)(G + (size_t)row * 512 + c0);
                    const f32x4 v0 = acc[ai][bj][m][0] + *(const f32x4*)(bias + c0), v1 = acc[ai][bj][m][1] + *(const f32x4*)(bias + c0 + 4);
                    u32x4 o;
                    o.x = pk2(bflo(gw.x) * sigmoidf_(v0[0]), bfhi(gw.x) * sigmoidf_(v0[1])); o.y = pk2(bflo(gw.y) * sigmoidf_(v0[2]), bfhi(gw.y) * sigmoidf_(v0[3]));
                    o.z = pk2(bflo(gw.z) * sigmoidf_(v1[0]), bfhi(gw.z) * sigmoidf_(v1[1])); o.w = pk2(bflo(gw.w) * sigmoidf_(v1[2]), bfhi(gw.w) * sigmoidf_(v1[3]));
                    *(u32x4*)(MIX + (size_t)row * 1024 + 512 + c0) = o; } }
    }
};

struct EpiRes {
    static constexpr bool PERM = false, AFTER_DRAIN = false;
    const float* xa; const float* xb; float* X; const float* gate;
    DI void operator()(const f32x4 (&acc)[2][2][4][2], const pg8::Unit& u, int wr, int wc, int fr, int fq) const {
#pragma unroll
        for (int ai = 0; ai < 2; ++ai)
#pragma unroll
            for (int m = 0; m < 4; ++m) { const int row = u.pm * 256 + ai * 128 + wr * 64 + m * 16 + fr;
                const int j = row < NCTX ? 0 : 1 + ((row - NCTX) >> 11);
                const float* xs = row < NCTX ? xa + (size_t)row * 1024 : xb + (size_t)(row - NCTX) * 1024; const float* gt = gate + j * 6144;
#pragma unroll
                for (int bj = 0; bj < 2; ++bj)
#pragma unroll
                    for (int n = 0; n < 2; ++n) { const int c = u.pn * 256 + 128 * bj + 32 * wc + 16 * n + 4 * fq;
                        const f32x4 xv = *(const f32x4*)(xs + c), gv = *(const f32x4*)(gt + c);
                        *(f32x4*)(X + (size_t)row * 1024 + c) = xv + gv * acc[ai][bj][m][n]; } }
    }
};

struct EpiFfn1 {
    static constexpr bool PERM = true, AFTER_DRAIN = false;
    bf16_t* ACT;
    DI void operator()(const f32x4 (&acc)[2][2][4][2], const pg8::Unit& u, int wr, int wc, int fr, int fq) const {
#pragma unroll
        for (int ai = 0; ai < 2; ++ai)
#pragma unroll
            for (int m = 0; m < 4; ++m) { const int row = u.pm * 256 + ai * 128 + wr * 64 + m * 16 + fr; const int a0 = u.pn * 128 + 32 * wc + 8 * fq;
                const f32x4 g0 = acc[ai][0][m][0], g1 = acc[ai][0][m][1], u0 = acc[ai][1][m][0], u1 = acc[ai][1][m][1];
                u32x4 o;
                o.x = pk2(g0[0] * sigmoidf_(g0[0]) * u0[0], g0[1] * sigmoidf_(g0[1]) * u0[1]); o.y = pk2(g0[2] * sigmoidf_(g0[2]) * u0[2], g0[3] * sigmoidf_(g0[3]) * u0[3]);
                o.z = pk2(g1[0] * sigmoidf_(g1[0]) * u1[0], g1[1] * sigmoidf_(g1[1]) * u1[1]); o.w = pk2(g1[2] * sigmoidf_(g1[2]) * u1[2], g1[3] * sigmoidf_(g1[3]) * u1[3]);
                *(u32x4*)(ACT + (size_t)row * 2816 + a0) = o; }
    }
};

template <class Epi> DI void run_gemm(unsigned char* shm, const bf16_t* A, const bf16_t* Bt, int N, int K, const Epi& E) {
    pg8::Gemm g; g.A = A; g.Bt = Bt; g.M = NTOK; g.N = N; g.K = K;
    pg8::StaticOrder S; S.init(NTOK, N, (int)gridDim.x, (int)blockIdx.x);
    pg8::gemm_phase<Epi, pg8::StaticOrder, false>((PG8_LAS unsigned char*)shm, g, S, E, nullptr);
}

DI void attn_item(const bf16_t* __restrict__ Q, const bf16_t* __restrict__ Kp, const bf16_t* __restrict__ Vp, int vld, int nkeys, int qtok0, int kvh, bf16_t* __restrict__ MIX, unsigned char* lds) {
    const int tid = ltid(), w = tid >> 6, lane = tid & 63, c = lane & 31, hh = lane >> 5;
    const int hq = kvh * 4 + (w & 3), qtok = qtok0 + 32 * (w >> 2) + c;
    bf16x8 qf[4];
#pragma unroll
    for (int s = 0; s < 4; ++s) qf[s] = *(const bf16x8*)(Q + (size_t)qtok * 512 + hq * 64 + 16 * s + 8 * hh);
    unsigned char* Kb = lds; unsigned char* Vb = lds + 2 * 9216;
    const int srow = tid >> 3, sseg = tid & 7;
    const bf16_t* kg = Kp + (size_t)srow * 64 + sseg * 8;
    const bf16_t* vg = Vp + (size_t)srow * vld + sseg * 8;
    u32x4 kr = *(const u32x4*)kg, vr = *(const u32x4*)vg;
    *(u32x4*)(Kb + srow * 144 + sseg * 16) = kr;
    { u32x2* d = (u32x2*)(Vb + srow * 136 + sseg * 16); u32x2 a; a.x = vr.x; a.y = vr.y; u32x2 b; b.x = vr.z; b.y = vr.w; d[0] = a; d[1] = b; }
    __syncthreads();
    f32x16 ot[2];
#pragma unroll
    for (int i = 0; i < 16; ++i) { ot[0][i] = 0.f; ot[1][i] = 0.f; }
    float mrun = -1e30f, lsum = 0.f;
    const int nt = nkeys >> 6;
    for (int it = 0; it < nt; ++it) {
        const int cur = it & 1;
        if (it + 1 < nt) { kr = *(const u32x4*)(kg + (size_t)(it + 1) * 4096); vr = *(const u32x4*)(vg + (it + 1) * 64); }
        const unsigned char* kb = Kb + cur * 9216; const unsigned char* vb = Vb + cur * 8704;
        f32x16 st[2];
#pragma unroll
        for (int kt = 0; kt < 2; ++kt) {
#pragma unroll
            for (int i = 0; i < 16; ++i) st[kt][i] = 0.f;
#pragma unroll
            for (int s = 0; s < 4; ++s) { const bf16x8 kf = *(const bf16x8*)(kb + (32 * kt + c) * 144 + (16 * s + 8 * hh) * 2); st[kt] = mfma32(kf, qf[s], st[kt]); } }
        float mx = st[0][0];
#pragma unroll
        for (int i = 1; i < 16; ++i) mx = fmaxf(mx, st[0][i]);
#pragma unroll
        for (int i = 0; i < 16; ++i) mx = fmaxf(mx, st[1][i]);
        mx = fmaxf(mx, __shfl_xor(mx, 32));
        const float mnew = fmaxf(mrun, mx), alpha = __builtin_amdgcn_exp2f(mrun - mnew); mrun = mnew;
        float ps = 0.f;
#pragma unroll
        for (int kt = 0; kt < 2; ++kt)
#pragma unroll
            for (int i = 0; i < 16; ++i) { const float p = __builtin_amdgcn_exp2f(st[kt][i] - mnew); st[kt][i] = p; ps += p; }
        lsum = lsum * alpha + ps;
#pragma unroll
        for (int i = 0; i < 16; ++i) { ot[0][i] *= alpha; ot[1][i] *= alpha; }
#pragma unroll
        for (int kt = 0; kt < 2; ++kt)
#pragma unroll
            for (int sp = 0; sp < 2; ++sp) {
                const bf16x8 pk = pack8(st[kt][8 * sp], st[kt][8 * sp + 1], st[kt][8 * sp + 2], st[kt][8 * sp + 3], st[kt][8 * sp + 4], st[kt][8 * sp + 5], st[kt][8 * sp + 6], st[kt][8 * sp + 7]);
#pragma unroll
                for (int dt = 0; dt < 2; ++dt) { const unsigned char* vrow = vb + (32 * dt + c) * 136 + (32 * kt + 16 * sp + 4 * hh) * 2;
                    const s16x4 lo = *(const s16x4*)vrow, hi = *(const s16x4*)(vrow + 16);
                    const bf16x8 va = __builtin_shufflevector(lo, hi, 0, 1, 2, 3, 4, 5, 6, 7);
                    ot[dt] = mfma32(va, pk, ot[dt]); } }
        if (it + 1 < nt) { const int nx = cur ^ 1;
            *(u32x4*)(Kb + nx * 9216 + srow * 144 + sseg * 16) = kr;
            u32x2* d = (u32x2*)(Vb + nx * 8704 + srow * 136 + sseg * 16); u32x2 a; a.x = vr.x; a.y = vr.y; u32x2 b; b.x = vr.z; b.y = vr.w; d[0] = a; d[1] = b; }
        __syncthreads();
    }
    const float ltot = lsum + __shfl_xor(lsum, 32); const float inv = 1.0f / ltot;
    bf16_t* op = MIX + (size_t)qtok * 1024 + hq * 64;
#pragma unroll
    for (int dt = 0; dt < 2; ++dt)
#pragma unroll
        for (int g4 = 0; g4 < 4; ++g4) { u32x2 pw; pw.x = pk2(ot[dt][4 * g4] * inv, ot[dt][4 * g4 + 1] * inv); pw.y = pk2(ot[dt][4 * g4 + 2] * inv, ot[dt][4 * g4 + 3] * inv);
            *(u32x2*)(op + 32 * dt + 8 * g4 + 4 * hh) = pw; }
}

template <int DIR, bool FULL>
DI void ssm_pass(int layer, int pr, int g, const bf16_t* __restrict__ U, const bf16x8* __restrict__ Bm, const bf16x8* __restrict__ Cm, const float* __restrict__ lam,
                 const float* __restrict__ state_in, const float* sseg_r, float* sseg_w, float* YF, bf16_t* __restrict__ G, const float* __restrict__ dskip,
                 float* __restrict__ out_state, unsigned char* hl) {
    const int lane = ltid() & 63, c = lane & 31, hh = lane >> 5, fr = lane & 15, kq = lane >> 4;
    const int ldg = (layer * 2 + DIR) * 32 + g;
    bf16x8 bm[4], cm[4];
#pragma unroll
    for (int i = 0; i < 4; ++i) { bm[i] = Bm[(ldg * 4 + i) * 64 + lane]; if (FULL) cm[i] = Cm[(ldg * 4 + i) * 64 + lane]; }
    const float l0r = lam[(ldg * 64 + c) * 2], l0i = lam[(ldg * 64 + c) * 2 + 1], l1r = lam[(ldg * 64 + 32 + c) * 2], l1i = lam[(ldg * 64 + 32 + c) * 2 + 1];
    const int s = 2 * pr + hh;
    float h0r = 0.f, h0i = 0.f, h1r = 0.f, h1i = 0.f;
    if (FULL && pr >= 16) {
        const int sl = s - 32, b = sl >> 3, seg = sl & 7;
        float a0r = l0r, a0i = l0i, a1r = l1r, a1i = l1i;
#pragma unroll
        for (int i = 0; i < 8; ++i) { const float t0 = a0r * a0r - a0i * a0i, t1 = 2.f * a0r * a0i; a0r = t0; a0i = t1; const float t2 = a1r * a1r - a1i * a1i, t3 = 2.f * a1r * a1i; a1r = t2; a1i = t3; }
        const float* si = state_in + ((((size_t)(b * 2 + layer) * 2 + DIR) * 2) * 32 + g) * 64;
        h0r = si[c]; h0i = si[2048 + c]; h1r = si[32 + c]; h1i = si[2048 + 32 + c];
        const int n = DIR == 0 ? seg : 7 - seg;
        for (int jj = 0; jj < n; ++jj) { const int j = DIR == 0 ? jj : 7 - jj;
            const float* sp = sseg_r + ((((size_t)(b * 8 + j) * 2 + DIR) * 32 + g) * 64) * 2;
            const float s0r = sp[c * 2], s0i = sp[c * 2 + 1], s1r = sp[(32 + c) * 2], s1i = sp[(32 + c) * 2 + 1];
            const float n0r = a0r * h0r - a0i * h0i + s0r, n0i = a0r * h0i + a0i * h0r + s0i; h0r = n0r; h0i = n0i;
            const float n1r = a1r * h1r - a1i * h1i + s1r, n1i = a1r * h1i + a1i * h1r + s1i; h1r = n1r; h1i = n1i; }
    }
    const int seq_r = (c >> 2) & 1, q_r = (c & 3) + 4 * (c >> 3);
    const bf16_t* ua_ptr = U + ((size_t)((2 * pr + seq_r) * 256 + q_r)) * 512 + g * 16 + 8 * hh;
    bf16x8 ua = *(const bf16x8*)(ua_ptr + (size_t)(DIR ? 240 : 0) * 512);
    f32x16 zero16;
#pragma unroll
    for (int i = 0; i < 16; ++i) zero16[i] = 0.f;
    const float dsk = FULL ? dskip[g * 16 + fr] : 0.f;
    for (int ch = 0; ch < 16; ++ch) {
        const int cb = DIR ? 240 - 16 * ch : 16 * ch;
        bf16x8 ua_n = ua;
        if (ch < 15) ua_n = *(const bf16x8*)(ua_ptr + (size_t)(DIR ? cb - 16 : cb + 16) * 512);
        f32x16 x[4];
#pragma unroll
        for (int i = 0; i < 4; ++i) x[i] = mfma32(ua, bm[i], zero16);
#pragma unroll
        for (int i = 0; i < 16; ++i) { const int reg = DIR ? 15 - i : i;
            const float n0r = l0r * h0r - l0i * h0i + x[0][reg], n0i = l0r * h0i + l0i * h0r + x[1][reg]; h0r = n0r; h0i = n0i;
            const float n1r = l1r * h1r - l1i * h1i + x[2][reg], n1i = l1r * h1i + l1i * h1r + x[3][reg]; h1r = n1r; h1i = n1i;
            if (FULL) { unsigned* hrow = (unsigned*)(hl + (hh * 16 + reg) * 272); hrow[c] = pk2(h0r, h0i); hrow[32 + c] = pk2(h1r, h1i); } }
        if (FULL) {
#pragma unroll
            for (int sq = 0; sq < 2; ++sq) { f32x4 y = (f32x4){0.f, 0.f, 0.f, 0.f};
#pragma unroll
                for (int ks = 0; ks < 4; ++ks) { const bf16x8 af = *(const bf16x8*)(hl + (sq * 16 + fr) * 272 + (32 * ks + 8 * kq) * 2); y = mfma16(af, cm[ks], y); }
#pragma unroll
                for (int j = 0; j < 4; ++j) { const size_t idx = ((size_t)((2 * pr + sq) * 256 + cb + kq * 4 + j)) * 512 + g * 16 + fr;
                    if (DIR == 0) YF[idx] = y[j];
                    else { const float v = YF[idx] + y[j] + dsk * bf2f(U[idx]); const float ge = 0.5f * v * (1.0f + erff(v * 0.70710678118654752f)); G[idx] = (bf16_t)(pk2(ge, 0.f) & 0xffffu); } } }
        }
        ua = ua_n;
    }
    if (FULL) { if (pr < 16) { float* os = out_state + ((((size_t)(s * 2 + layer) * 2 + DIR) * 2) * 32 + g) * 64; os[c] = h0r; os[2048 + c] = h0i; os[32 + c] = h1r; os[2048 + 32 + c] = h1i; } }
    else { float* sw = sseg_w + ((((size_t)(s - 32) * 2 + DIR) * 32 + g) * 64) * 2; sw[c * 2] = h0r; sw[c * 2 + 1] = h0i; sw[(32 + c) * 2] = h1r; sw[(32 + c) * 2 + 1] = h1i; }
}

__global__ __launch_bounds__(512, 2) void mega_fwd(Params P) {
    extern __shared__ __attribute__((aligned(16))) unsigned char shm[];
    cg::grid_group grid = cg::this_grid();
    unsigned char* ws = P.ws;
    float* X = P.out;
    const float* mods = (const float*)(ws + WS_MODS);
    bf16_t* Hb = (bf16_t*)(ws + WS_H); float* YF = (float*)(ws + WS_H);
    bf16_t* Qb = (bf16_t*)(ws + WS_Q); bf16_t* Ub = (bf16_t*)(ws + WS_U); bf16_t* MIXb = (bf16_t*)(ws + WS_MIX); bf16_t* Gb = (bf16_t*)(ws + WS_G); bf16_t* ACTb = (bf16_t*)(ws + WS_ACT);
    bf16_t* Kctx = (bf16_t*)(ws + WS_KCTX); bf16_t* Vctx = (bf16_t*)(ws + WS_VCTX);
    const int w = __builtin_amdgcn_readfirstlane(threadIdx.x >> 6);

    phase0(P, shm);
    grid.sync();
#pragma unroll 1
    for (int l = 0; l < 2; ++l) {
        const float* mods_l = mods + l * 5 * 6144;
        const float* xa = l == 0 ? P.in[0] : X; const float* xb = l == 0 ? P.in[1] : X + (size_t)NCTX * 1024;
        bf16_t* Klat = (bf16_t*)(ws + WS_KLAT + l * SZ_KLAT); bf16_t* Vlat = (bf16_t*)(ws + WS_VLAT + l * SZ_KLAT);
        norm_phase(xa, xb, P.in[9] + l * 1024, mods_l, 0, 1, Hb);
        grid.sync();
        { EpiIn E; E.layer = l; E.qn = P.in[12] + l * 64; E.kn = P.in[13] + l * 64; E.ropec = (const float*)(ws + WS_ROPEC); E.ropes = (const float*)(ws + WS_ROPES);
          E.Q = Qb; E.U = Ub; E.Kctx = Kctx; E.Vctx = Vctx; E.Klat = Klat; E.Vlat = Vlat; E.outk = P.out + OUT_K; E.outv = P.out + OUT_V;
          run_gemm(shm, Hb, (const bf16_t*)(ws + WS_WIN + l * SZ_WIN), 1280, 1024, E); }
        grid.sync();
        for (int it = blockIdx.x; it < 384; it += gridDim.x) {
            __syncthreads();
            if (it < 256) { const int qc = it & 3, kvh = (it >> 2) & 1, b = it >> 3;
                attn_item(Qb, Kctx + ((size_t)(b * 2 + kvh) * 256) * 64, Vctx + ((size_t)(b * 2 + kvh) * 64) * 256, 256, 256, b * 256 + qc * 64, kvh, MIXb, shm); }
            else { const int wi = (it - 256) * 8 + w; const int dir = wi & 1, g = (wi >> 1) & 31, pr = 16 + (wi >> 6);
                if (dir == 0) ssm_pass<0, false>(l, pr, g, Ub, (const bf16x8*)(ws + WS_SSMB), (const bf16x8*)(ws + WS_SSMC), (const float*)(ws + WS_SSML), P.in[4], nullptr, (float*)(ws + WS_SSEG), nullptr, nullptr, nullptr, nullptr, nullptr);
                else ssm_pass<1, false>(l, pr, g, Ub, (const bf16x8*)(ws + WS_SSMB), (const bf16x8*)(ws + WS_SSMC), (const float*)(ws + WS_SSML), P.in[4], nullptr, (float*)(ws + WS_SSEG), nullptr, nullptr, nullptr, nullptr, nullptr); }
        }
        grid.sync();
        for (int it = blockIdx.x; it < 384; it += gridDim.x) {
            __syncthreads();
            if (it < 256) { const int qc = it & 31, kvh = (it >> 5) & 1, b = it >> 6;
                attn_item(Qb, Klat + ((size_t)(b * 2 + kvh) * 2560) * 64, Vlat + ((size_t)(b * 2 + kvh) * 64) * 2560, 2560, 2560, NCTX + b * 2048 + qc * 64, kvh, MIXb, shm); }
            else { const int wi = (it - 256) * 8 + w; const int g = wi & 31, pr = wi >> 5;
                ssm_pass<0, true>(l, pr, g, Ub, (const bf16x8*)(ws + WS_SSMB), (const bf16x8*)(ws + WS_SSMC), (const float*)(ws + WS_SSML), P.in[4], (const float*)(ws + WS_SSEG), nullptr, YF, Gb, P.in[21] + l * 512, P.out + OUT_S, shm + w * 8704);
                ssm_pass<1, true>(l, pr, g, Ub, (const bf16x8*)(ws + WS_SSMB), (const bf16x8*)(ws + WS_SSMC), (const float*)(ws + WS_SSML), P.in[4], (const float*)(ws + WS_SSEG), nullptr, YF, Gb, P.in[21] + l * 512, P.out + OUT_S, shm + w * 8704); }
        }
        grid.sync();
        { EpiGlu E; E.G = Gb; E.bias = P.in[23] + l * 512; E.MIX = MIXb; run_gemm(shm, Gb, (const bf16_t*)(ws + WS_WGLU + l * SZ_WGLU), 512, 512, E); }
        grid.sync();
        { EpiRes E; E.xa = xa; E.xb = xb; E.X = X; E.gate = mods_l + 2 * 1024; run_gemm(shm, MIXb, (const bf16_t*)(ws + WS_WOUT + l * SZ_WOUT), 1024, 1024, E); }
        grid.sync();
        norm_phase(X, X + (size_t)NCTX * 1024, P.in[10] + l * 1024, mods_l, 3, 4, Hb);
        grid.sync();
        { EpiFfn1 E; E.ACT = ACTb; run_gemm(shm, Hb, (const bf16_t*)(ws + WS_WF1 + l * SZ_WF1), 5632, 1024, E); }
        grid.sync();
        { EpiRes E; E.xa = X; E.xb = X + (size_t)NCTX * 1024; E.X = X; E.gate = mods_l + 5 * 1024; run_gemm(shm, ACTb, (const bf16_t*)(ws + WS_WF2 + l * SZ_WF2), 1024, 2816, E); }
        grid.sync();
    }
    final_norm_phase(X, P.in[27]);
}

extern "C" void kernel_launch(void* const* d_in, const int* in_sizes, int n_in, void* d_out, int out_size, void* d_ws, size_t ws_size, hipStream_t stream) {
    static int grid_blocks = 0;
    if (grid_blocks == 0) {
        if (n_in < 28 || ws_size < WS_END) { fprintf(stderr, "kernel_launch: need 28 inputs and %zu bytes of workspace (got %d, %zu)\n", (size_t)WS_END, n_in, ws_size); grid_blocks = -1; return; }
        int dev = 0, cus = 0, per_cu = 0;
        hipGetDevice(&dev);
        hipDeviceGetAttribute(&cus, hipDeviceAttributeMultiprocessorCount, dev);
        if (hipFuncSetAttribute((const void*)mega_fwd, hipFuncAttributeMaxDynamicSharedMemorySize, LDS_BYTES) != hipSuccess) fprintf(stderr, "kernel_launch: hipFuncSetAttribute failed\n");
        if (hipOccupancyMaxActiveBlocksPerMultiprocessor(&per_cu, (const void*)mega_fwd, 512, LDS_BYTES) != hipSuccess || per_cu < 1) { per_cu = 1; (void)hipGetLastError(); }
        if (per_cu > 1) per_cu = 1;
        grid_blocks = cus * per_cu;
    }
    if (grid_blocks < 0) return;
    hipMemsetAsync((unsigned char*)d_ws + WS_MODS, 0, SZ_MODS, stream);
    Params p{};
    for (int i = 0; i < 28; ++i) p.in[i] = (const float*)d_in[i];
    p.out = (float*)d_out; p.ws = (unsigned char*)d_ws;
    void* args[] = {&p};
    hipError_t e = hipLaunchCooperativeKernel((const void*)mega_fwd, dim3(grid_blocks), dim3(512), args, LDS_BYTES, stream);
    if (e != hipSuccess) fprintf(stderr, "cooperative launch failed: %s (grid %d)\n", hipGetErrorString(e), grid_blocks);
}
```

```cpp
#include <hip/hip_runtime.h>
#include <hip/hip_cooperative_groups.h>
#include <cstdio>
namespace cg = cooperative_groups;
#define DI __device__ __forceinline__
DI unsigned char* opaque_ptr(unsigned char* p) { asm volatile("" : "+s"(p)); return p; }
DI float shx(float v, int m, int lane) { return __int_as_float(__builtin_amdgcn_ds_bpermute((lane ^ m) << 2, __float_as_int(v))); }
DI int lane_now() { int l; asm volatile("v_mbcnt_lo_u32_b32 %0, -1, 0\n\tv_mbcnt_hi_u32_b32 %0, -1, %0" : "=v"(l)); return l; }
DI int ltid(int wv) { return wv * 64 + lane_now(); }

namespace pg8 {
#define PG8_LAS __attribute__((address_space(3)))
typedef unsigned short bf16_t;
typedef short bf16x8 __attribute__((ext_vector_type(8)));
typedef float f32x4 __attribute__((ext_vector_type(4)));
typedef unsigned u32x4 __attribute__((ext_vector_type(4)));
constexpr int BM = 256, BK = 64, HALF = 128, HTB = HALF * BK * 2  , STAGE_BYTES = 8 * HTB, NXCD = 8, WGM = 1;

__host__ __device__ __forceinline__ int lds_byte(int r, int c) { const int st = (r >> 4) * 2 + (c >> 5), rr = r & 15, cc = c & 31, ob = rr * 64 + cc * 2; return st * 1024 + (ob ^ (((ob >> 9) & 1) << 5)); }
__host__ __device__ __forceinline__ void stage_rc(int b, int& R, int& C) { const int st = b / 1024, sb = b % 1024, swz = sb ^ (((sb >> 9) & 1) << 5); R = (st >> 1) * 16 + swz / 64; C = (st & 1) * 32 + (swz % 64) / 2; }
__host__ __device__ __forceinline__ int perm32(int rho) { const int n = rho >> 4, i = rho & 15; return 8 * (i >> 2) + 4 * n + (i & 3); }

struct Unit { int pm, pn; };
struct Gemm { const bf16_t* A; const bf16_t* Bt; int M, N, K; };

struct StaticOrder {
    int nM, nN, nwg, G, c;
    __host__ __device__ void init(int M, int N, int G_, int c_) { nM = M / BM; nN = N / BM; nwg = nM * nN; G = G_; c = c_; }
    __host__ __device__ bool next(int i, Unit& u) const {
        const long L = (long)i * G + c; if (L >= nwg) return false;
        int wgid = (int)L; { const int q = nwg / NXCD, r = nwg % NXCD, xcd = wgid % NXCD, off = wgid / NXCD; wgid = (xcd < r ? xcd * (q + 1) : r * (q + 1) + (xcd - r) * q) + off; }
        const int nig = WGM * nN, gid = wgid / nig, fm = gid * WGM, gsz = (nM - fm) < WGM ? (nM - fm) : WGM;
        u.pm = fm + ((wgid % nig) % gsz); u.pn = (wgid % nig) / gsz; return true;
    }
    __device__ __forceinline__ void a_ready(const Unit&) const {}
    __device__ __forceinline__ void done(const Unit&) const {}
};

template <class Epi, class Sched, bool STAMP = false>
__device__ __forceinline__ void gemm_phase(PG8_LAS unsigned char* lds, const Gemm g, const Sched& S, const Epi& E, unsigned long long* stamps, int wv) {
    int tid_l; asm volatile("v_mbcnt_lo_u32_b32 %0, -1, 0\n\tv_mbcnt_hi_u32_b32 %0, -1, %0" : "=v"(tid_l)); tid_l += wv * 64;
    const int tid = tid_l, wid = __builtin_amdgcn_readfirstlane(tid >> 6), lane = tid & 63, wr = wid >> 2, wc = wid & 3, fr = lane & 15, fq = lane >> 4;
    const int K = g.K, nt = K / BK;
    int ts_lo = 0, ts_hi = 0, nts = 0; const unsigned long long rt_entry = STAMP ? (unsigned long long)wall_clock64() : 0ull;
#define PG8_STAMP() do { if (STAMP && wid == 0 && nts < 64) { const unsigned long long _c = (unsigned long long)clock64(); \
        ts_lo = (lane == nts) ? (int)(unsigned)_c : ts_lo; ts_hi = (lane == nts) ? (int)(unsigned)(_c >> 32) : ts_hi; ++nts; } } while (0)
    PG8_STAMP();
    unsigned voffA[2], voffB[2];
#pragma unroll
    for (int i = 0; i < 2; ++i) { int R, C; stage_rc(tid * 16 + i * 8192, R, C); const int Rb = Epi::PERM ? ((R & ~31) + perm32(R & 31)) : R;
        voffA[i] = (unsigned)(R * K + C) * 2u; voffB[i] = (unsigned)(Rb * K + C) * 2u; }
    const size_t kstep = (size_t)(BK * 2);
    const size_t hstep = (size_t)HALF * K * 2;
    const size_t tstep = 2 * hstep;
    const unsigned ldsw = (unsigned)wid * 1024u;
    const int aoff = lds_byte(wr * 64 + fr, fq * 8), boff = lds_byte(wc * 32 + fr, fq * 8);
#define PG8_SA(b, h) (((b) * 2 + (h)) * HTB)
#define PG8_SB(b, h) ((4 + (b) * 2 + (h)) * HTB)
#define PG8_STAGE(bufoff, gbase, voff) do { _Pragma("unroll") for (int _i = 0; _i < 2; ++_i) \
        __builtin_amdgcn_global_load_lds((const unsigned*)((const char*)(gbase) + (voff)[_i]), (PG8_LAS unsigned*)(lds + (bufoff) + ldsw + _i * 8192), 16, 0, 0); } while (0)
#define PG8_LDA(dst, b, h) do { _Pragma("unroll") for (int m = 0; m < 4; ++m) _Pragma("unroll") for (int k = 0; k < 2; ++k) dst[m][k] = *(const PG8_LAS bf16x8*)(lds + PG8_SA(b, h) + aoff + m * 2048 + k * 1024); } while (0)
#define PG8_LDB(dst, b, h) do { _Pragma("unroll") for (int n = 0; n < 2; ++n) _Pragma("unroll") for (int k = 0; k < 2; ++k) dst[n][k] = *(const PG8_LAS bf16x8*)(lds + PG8_SB(b, h) + boff + n * 2048 + k * 1024); } while (0)
#define PG8_MMA(ai, bj, At, Bt) do { __builtin_amdgcn_s_setprio(1); _Pragma("unroll") for (int m = 0; m < 4; ++m) _Pragma("unroll") for (int n = 0; n < 2; ++n) _Pragma("unroll") for (int k = 0; k < 2; ++k) \
        acc[ai][bj][m][n] = __builtin_amdgcn_mfma_f32_16x16x32_bf16(Bt[n][k], At[m][k], acc[ai][bj][m][n], 0, 0, 0); __builtin_amdgcn_s_setprio(0); } while (0)
#define PG8_WAIT_V(n) asm volatile("s_waitcnt vmcnt(" #n ")" ::: "memory")
#define PG8_WAIT_L(n) asm volatile("s_waitcnt lgkmcnt(" #n ")" ::: "memory")
#define PG8_BAR __builtin_amdgcn_s_barrier()
#define PG8_SCHED __builtin_amdgcn_sched_barrier(0)
    Unit cur, nxt; int ui = 0;
    if (!S.next(0, cur)) return;
    f32x4 acc[2][2][4][2];
#pragma unroll
    for (int a = 0; a < 2; ++a)
#pragma unroll
        for (int b = 0; b < 2; ++b)
#pragma unroll
            for (int m = 0; m < 4; ++m)
#pragma unroll
                for (int n = 0; n < 2; ++n) acc[a][b][m][n] = (f32x4){0.f, 0.f, 0.f, 0.f};
    bf16x8 At[4][2], B0[2][2], B1[2][2];
    const char* cA = (const char*)g.A + (size_t)cur.pm * tstep; const char* cB = (const char*)g.Bt + (size_t)cur.pn * tstep;
    S.a_ready(cur);
    PG8_STAGE(PG8_SB(0, 0), cB, voffB); PG8_STAGE(PG8_SA(0, 0), cA, voffA); PG8_STAGE(PG8_SB(0, 1), cB + hstep, voffB); PG8_STAGE(PG8_SA(0, 1), cA + hstep, voffA);
    if (wr == 1) PG8_BAR;
    PG8_WAIT_V(4); PG8_BAR;
    PG8_STAGE(PG8_SB(1, 0), cB + kstep, voffB); PG8_STAGE(PG8_SA(1, 0), cA + kstep, voffA); PG8_STAGE(PG8_SB(1, 1), cB + hstep + kstep, voffB);
    PG8_WAIT_V(6); PG8_BAR;
    PG8_STAMP();
    for (;;) {
        const bool has_next = S.next(ui + 1, nxt);
        const char* nA = has_next ? (const char*)g.A + (size_t)nxt.pm * tstep : cA; const char* nB = has_next ? (const char*)g.Bt + (size_t)nxt.pn * tstep : cB;
        for (int t = 0; t < nt; t += 2) {
            const bool last = (t == nt - 2);
            const char* a1 = cA + (size_t)(t + 1) * kstep;
            const char* a2 = last ? nA : cA + (size_t)(t + 2) * kstep; const char* b2 = last ? nB : cB + (size_t)(t + 2) * kstep;
            const char* a3 = a2 + kstep; const char* b3 = b2 + kstep;
            if (last && has_next) S.a_ready(nxt);
            PG8_LDB(B0, 0, 0); PG8_SCHED; PG8_LDA(At, 0, 0); PG8_STAGE(PG8_SA(1, 1), a1 + hstep, voffA);
            PG8_WAIT_L(8); PG8_BAR; PG8_WAIT_L(0); PG8_MMA(0, 0, At, B0); PG8_BAR; PG8_SCHED;
            PG8_LDB(B1, 0, 1); PG8_STAGE(PG8_SB(0, 0), b2, voffB);
            PG8_BAR; PG8_WAIT_L(0); PG8_MMA(0, 1, At, B1); PG8_BAR;
            PG8_LDA(At, 0, 1); PG8_STAGE(PG8_SA(0, 0), a2, voffA);
            PG8_BAR; PG8_WAIT_L(0); PG8_MMA(1, 0, At, B0); PG8_BAR; PG8_SCHED;
            PG8_STAGE(PG8_SB(0, 1), b2 + hstep, voffB);
            PG8_WAIT_V(6); PG8_BAR; PG8_MMA(1, 1, At, B1); PG8_BAR;
            PG8_LDB(B0, 1, 0); PG8_SCHED; PG8_LDA(At, 1, 0); PG8_STAGE(PG8_SA(0, 1), a2 + hstep, voffA);
            PG8_WAIT_L(8); PG8_BAR; PG8_WAIT_L(0); PG8_MMA(0, 0, At, B0); PG8_BAR; PG8_SCHED;
            PG8_LDB(B1, 1, 1); PG8_STAGE(PG8_SB(1, 0), b3, voffB);
            PG8_BAR; PG8_WAIT_L(0); PG8_MMA(0, 1, At, B1); PG8_BAR;
            PG8_LDA(At, 1, 1); PG8_STAGE(PG8_SA(1, 0), a3, voffA);
            PG8_BAR; PG8_WAIT_L(0); PG8_MMA(1, 0, At, B0); PG8_BAR; PG8_SCHED;
            PG8_STAGE(PG8_SB(1, 1), b3 + hstep, voffB);
            PG8_WAIT_V(6); PG8_BAR; PG8_MMA(1, 1, At, B1); PG8_BAR;
        }
        PG8_STAMP();
        if constexpr (!Epi::AFTER_DRAIN) { E(acc, cur, wr, wc, fr, fq); S.done(cur); }
        PG8_STAMP();
        if (!has_next) break;
#pragma unroll
        for (int a = 0; a < 2; ++a)
#pragma unroll
            for (int b = 0; b < 2; ++b)
#pragma unroll
                for (int m = 0; m < 4; ++m)
#pragma unroll
                    for (int n = 0; n < 2; ++n) acc[a][b][m][n] = (f32x4){0.f, 0.f, 0.f, 0.f};
        cur = nxt; cA = nA; cB = nB; ++ui;
    }
    PG8_WAIT_V(0);
    if (wr == 0) PG8_BAR;
    PG8_BAR;
    if constexpr (Epi::AFTER_DRAIN) { E.fused(acc, cur, wr, wc, fr, fq, lds, wid, lane); S.done(cur); }
    PG8_STAMP();
    if (STAMP && wid == 0) { stamps[lane] = lane < nts ? (((unsigned long long)(unsigned)ts_hi << 32) | (unsigned)ts_lo) : 0ull;
        if (lane == 62) stamps[62] = rt_entry; if (lane == 63) stamps[63] = (unsigned long long)wall_clock64(); }
#undef PG8_STAMP
#undef PG8_SA
#undef PG8_SB
#undef PG8_STAGE
#undef PG8_LDA
#undef PG8_LDB
#undef PG8_MMA
#undef PG8_WAIT_V
#undef PG8_WAIT_L
#undef PG8_BAR
#undef PG8_SCHED
}
}

typedef unsigned short bf16_t;
typedef short bf16x8 __attribute__((ext_vector_type(8)));
typedef short s16x4 __attribute__((ext_vector_type(4)));
typedef float f32x4 __attribute__((ext_vector_type(4)));
typedef float f32x2 __attribute__((ext_vector_type(2)));
typedef float f32x16 __attribute__((ext_vector_type(16)));
typedef unsigned u32x4 __attribute__((ext_vector_type(4)));
typedef unsigned u32x2 __attribute__((ext_vector_type(2)));
typedef __bf16 bf16x2_t __attribute__((ext_vector_type(2)));

constexpr int NTOK = 16384, DM = 1024, NCTX = 8192;
constexpr size_t SZ_WIN = (size_t)1280 * 1024 * 2, SZ_WGLU = (size_t)512 * 512 * 2, SZ_WOUT = (size_t)1024 * 1024 * 2, SZ_WF1 = (size_t)5632 * 1024 * 2, SZ_WF2 = (size_t)1024 * 2816 * 2;
constexpr size_t WS_WIN = 0, WS_WGLU = WS_WIN + 2 * SZ_WIN, WS_WOUT = WS_WGLU + 2 * SZ_WGLU, WS_WF1 = WS_WOUT + 2 * SZ_WOUT, WS_WF2 = WS_WF1 + 2 * SZ_WF1;
constexpr size_t WS_H = WS_WF2 + 2 * SZ_WF2;
constexpr size_t WS_Q = WS_H + (size_t)NTOK * 1024 * 2;
constexpr size_t WS_U = WS_Q + (size_t)NTOK * 512 * 2;
constexpr size_t WS_MIX = WS_U + (size_t)NTOK * 512 * 2;
constexpr size_t WS_G = WS_MIX + (size_t)NTOK * 1024 * 2;
constexpr size_t WS_ACT = WS_Q;
constexpr size_t WS_KLAT = WS_ACT + (size_t)NTOK * 2816 * 2;
constexpr size_t SZ_KLAT = (size_t)4 * 2 * 2560 * 64 * 2;
constexpr size_t WS_VLAT = WS_KLAT + 2 * SZ_KLAT;
constexpr size_t WS_KCTX = WS_VLAT + 2 * SZ_KLAT;
constexpr size_t SZ_KCTX = (size_t)32 * 2 * 256 * 64 * 2;
constexpr size_t WS_VCTX = WS_KCTX + SZ_KCTX;
constexpr size_t WS_MODS = WS_VCTX + SZ_KCTX;
constexpr size_t SZ_MODS = (size_t)2 * 5 * 6144 * 4;
constexpr size_t WS_BAR = WS_MODS + SZ_MODS;
constexpr size_t SZ_BAR = (size_t)3456 * 4;
constexpr size_t WS_ROPEC = WS_BAR + SZ_BAR;
constexpr size_t WS_ROPES = WS_ROPEC + (size_t)2048 * 32 * 4;
constexpr size_t WS_SSMB = WS_ROPES + (size_t)2048 * 32 * 4;
constexpr size_t WS_SSMC = WS_SSMB + (size_t)128 * 4096;
constexpr size_t WS_SSML = WS_SSMC + (size_t)128 * 4096;
constexpr size_t WS_SSEG = WS_SSML + (size_t)128 * 512;
constexpr size_t WS_YB = WS_SSEG + (size_t)32 * 2 * 32 * 64 * 2 * 4;
constexpr size_t WS_MODP = WS_YB + (size_t)NTOK * 512 * 4;
constexpr size_t WS_XB = WS_MODP + (size_t)4 * 61440 * 4;
constexpr size_t WS_END = WS_XB + (size_t)NTOK * 1024 * 2;
constexpr size_t OUT_K = (size_t)2 * 8388608, OUT_V = OUT_K + 2097152, OUT_S = OUT_V + 2097152;
constexpr int LDS_BYTES = 131072 + 16;

#ifndef REP_NORM
#define REP_NORM 1
#endif
#ifndef REP_IN
#define REP_IN 1
#endif
#ifndef REP_ATT3
#define REP_ATT3 1
#endif
#ifndef REP_ATT4
#define REP_ATT4 1
#endif
#ifndef REP_GLU
#define REP_GLU 1
#endif
#ifndef REP_F1
#define REP_F1 1
#endif
#ifndef REP_P0
#define REP_P0 1
#endif
struct Params { const float* in[28]; float* out; unsigned char* ws; };

DI unsigned pk2(float lo, float hi) { f32x2 v = {lo, hi}; return __builtin_bit_cast(unsigned, __builtin_convertvector(v, bf16x2_t)); }
DI float bf2f(bf16_t b) { return __uint_as_float(((unsigned)b) << 16); }
DI float bflo(unsigned w) { return __uint_as_float(w << 16); }
DI float bfhi(unsigned w) { return __uint_as_float(w & 0xffff0000u); }
DI bf16x8 pack8(float a0, float a1, float a2, float a3, float a4, float a5, float a6, float a7) {
    u32x4 p; p.x = pk2(a0, a1); p.y = pk2(a2, a3); p.z = pk2(a4, a5); p.w = pk2(a6, a7); return __builtin_bit_cast(bf16x8, p); }
DI f32x16 mfma32(bf16x8 a, bf16x8 b, f32x16 c) { return __builtin_amdgcn_mfma_f32_32x32x16_bf16(a, b, c, 0, 0, 0); }
DI f32x16 mfma32p(bf16x8 a, bf16x8 b, f32x16 c) { __builtin_amdgcn_s_setprio(1); f32x16 r = __builtin_amdgcn_mfma_f32_32x32x16_bf16(a, b, c, 0, 0, 0); __builtin_amdgcn_s_setprio(0); return r; }
DI f32x4 mfma16(bf16x8 a, bf16x8 b, f32x4 c) { return __builtin_amdgcn_mfma_f32_16x16x32_bf16(a, b, c, 0, 0, 0); }
DI f32x2 gelu_pk(f32x2 v) {
    const f32x2 av = __builtin_elementwise_abs(v), d = av * 0.2316418882f + 1.0f;
    f32x2 t; t.x = __builtin_amdgcn_rcpf(d.x); t.y = __builtin_amdgcn_rcpf(d.y);
    f32x2 q = t * 0.5307027145f + (-0.7265760135f); q = q * t + 0.7107068705f; q = q * t + (-0.142248368f); q = q * t + 0.127414796f; q = q * t;
    const f32x2 sq = (v * v) * (-0.72134752044f);
    f32x2 e; e.x = __builtin_amdgcn_exp2f(sq.x); e.y = __builtin_amdgcn_exp2f(sq.y);
    const f32x2 m = v * (q * e), r = v - m;
    f32x2 o; o.x = v.x < 0.f ? m.x : r.x; o.y = v.y < 0.f ? m.y : r.y; return o;
}
#define GAS __attribute__((address_space(1)))
DI u32x2 ldg8(const void* p) { return *(const GAS u32x2*)p; }
DI u32x4 ldg16(const void* p) { return *(const GAS u32x4*)p; }
DI f32x4 ldg16f(const void* p) { return *(const GAS f32x4*)p; }
DI f32x2 ldg8f(const void* p) { return *(const GAS f32x2*)p; }
DI void stg8(void* p, u32x2 v) { *(GAS u32x2*)p = v; }
DI void stg16(void* p, u32x4 v) { *(GAS u32x4*)p = v; }
DI void stg16f(void* p, f32x4 v) { *(GAS f32x4*)p = v; }
DI float sigmoidf_(float x) { return __builtin_amdgcn_rcpf(1.0f + __expf(-x)); }

DI void tconv_tile(const float* __restrict__ src, size_t sld, int ca, int cb, bf16_t* __restrict__ dst, size_t dld, float* lds, int wv) {
    const int tid = ltid(wv);
#pragma unroll
    for (int i = 0; i < 8; ++i) { const int idx = i * 512 + tid, kk = idx >> 6, nn = idx & 63; const int col = nn < 32 ? ca + nn : cb + nn - 32;
        lds[nn * 65 + kk] = src[(size_t)kk * sld + col]; }
    __syncthreads();
    { const int nn = tid >> 3, k8 = (tid & 7) * 8; const float* r = lds + nn * 65 + k8;
      u32x4 w; w.x = pk2(r[0], r[1]); w.y = pk2(r[2], r[3]); w.z = pk2(r[4], r[5]); w.w = pk2(r[6], r[7]);
      *(u32x4*)(dst + (size_t)nn * dld + k8) = w; }
    __syncthreads();
}
DI int srccol_in(int np) { const int pn = np >> 8, cpos = np & 255, bj = cpos >> 7, wc = (cpos >> 5) & 3, w = cpos & 31; return pn * 256 + wc * 64 + bj * 32 + w; }
DI int srccol_f1(int np) { const int tile = np >> 8, bj = (np >> 7) & 1, i = np & 127; return bj * 2816 + tile * 128 + i; }

DI void wconv_task(const Params& P, int t, float* lds, int wv) {
    const int l = t / 2752; int r = t % 2752;
    unsigned char* ws = P.ws;
    if (r < 320) { const int kt = r & 15, ntl = r >> 4, n0 = ntl * 64, k0 = kt * 64;
        tconv_tile(P.in[11] + ((size_t)l * 1024 + k0) * 1280, 1280, srccol_in(n0), srccol_in(n0 + 32), (bf16_t*)(ws + WS_WIN + l * SZ_WIN) + (size_t)n0 * 1024 + k0, 1024, lds, wv); return; }
    r -= 320;
    if (r < 64) { const int kt = r & 7, ntl = r >> 3, n0 = ntl * 64, k0 = kt * 64;
        tconv_tile(P.in[22] + ((size_t)l * 512 + k0) * 512, 512, n0, n0 + 32, (bf16_t*)(ws + WS_WGLU + l * SZ_WGLU) + (size_t)n0 * 512 + k0, 512, lds, wv); return; }
    r -= 64;
    if (r < 256) { const int kt = r & 15, ntl = r >> 4, n0 = ntl * 64, k0 = kt * 64;
        tconv_tile(P.in[24] + ((size_t)l * 1024 + k0) * 1024, 1024, n0, n0 + 32, (bf16_t*)(ws + WS_WOUT + l * SZ_WOUT) + (size_t)n0 * 1024 + k0, 1024, lds, wv); return; }
    r -= 256;
    if (r < 1408) { const int kt = r & 15, ntl = r >> 4, n0 = ntl * 64, k0 = kt * 64;
        tconv_tile(P.in[25] + ((size_t)l * 1024 + k0) * 5632, 5632, srccol_f1(n0), srccol_f1(n0 + 32), (bf16_t*)(ws + WS_WF1 + l * SZ_WF1) + (size_t)n0 * 1024 + k0, 1024, lds, wv); return; }
    r -= 1408;
    { const int kt = r % 44, ntl = r / 44, n0 = ntl * 64, k0 = kt * 64;
        tconv_tile(P.in[26] + ((size_t)l * 2816 + k0) * 1024, 1024, n0, n0 + 32, (bf16_t*)(ws + WS_WF2 + l * SZ_WF2) + (size_t)n0 * 2816 + k0, 2816, lds, wv); }
}

DI void adaln_task(const Params& P, int task, float* lds, int wv) {
    const int tid = ltid(wv), w = tid >> 6, lane = tid & 63;
    const int kc = task & 3, cgp = (task >> 2) % 24, l = task / 96;
    const int n = cgp * 256 + lane * 4;
    const int k0 = kc * 256 + w * 32;
    const float* wm = P.in[7] + ((size_t)l * 1024 + k0) * 6144 + n;
    const float* cc = P.in[5]; const float* cx = P.in[6];
    f32x4 wrow[32];
#pragma unroll
    for (int kk = 0; kk < 32; ++kk) wrow[kk] = *(const f32x4*)(wm + (size_t)kk * 6144);
    f32x4 acc[5];
#pragma unroll
    for (int j = 0; j < 5; ++j) acc[j] = (f32x4){0.f, 0.f, 0.f, 0.f};
#pragma unroll
    for (int kk = 0; kk < 32; ++kk) { const int k = k0 + kk;
#pragma unroll
        for (int j = 0; j < 5; ++j) { const float cv = (j == 0) ? cx[k] : cc[(j - 1) * 1024 + k]; const float sv = cv / (1.0f + __expf(-cv)); acc[j] += wrow[kk] * sv; } }
#pragma unroll
    for (int j = 0; j < 5; ++j) *(f32x4*)(lds + (w * 5 + j) * 256 + lane * 4) = acc[j];
    __syncthreads();
    float* part = (float*)(P.ws + WS_MODP) + (size_t)kc * 61440;
    for (int e = tid; e < 1280; e += 512) { const int j = e >> 8, col = e & 255; float sm = 0.f;
#pragma unroll
        for (int ww = 0; ww < 8; ++ww) sm += lds[(ww * 5 + j) * 256 + col];
        part[(l * 5 + j) * 6144 + cgp * 256 + col] = sm; }
    __syncthreads();
}

DI void ssmconst_task(const Params& P, int task, int wv) {
    const int idx = task * 512 + ltid(wv); const int p = idx & 63, ldg = idx >> 6;
    const double dt = exp((double)P.in[16][ldg]); const double ar = (double)P.in[14][ldg * 64 + p], ai = (double)P.in[15][ldg * 64 + p];
    const double mag = exp(ar * dt); double sn, cs; sincos(ai * dt, &sn, &cs);
    const double lr = mag * cs, li = mag * sn, den = ar * ar + ai * ai;
    const double zr = ((lr - 1.0) * ar + li * ai) / den, zi = (li * ar - (lr - 1.0) * ai) / den;
    float* lam = (float*)(P.ws + WS_SSML); lam[(ldg * 64 + p) * 2] = (float)lr; lam[(ldg * 64 + p) * 2 + 1] = (float)li;
    bf16_t* Bm = (bf16_t*)(P.ws + WS_SSMB); bf16_t* Cm = (bf16_t*)(P.ws + WS_SSMC);
    const float* bre = P.in[17] + ((size_t)ldg * 64 + p) * 16; const float* bim = P.in[18] + ((size_t)ldg * 64 + p) * 16;
    const int ntb = (p >= 32) ? 2 : 0;
    for (int h = 0; h < 16; ++h) { const double br = bre[h], bi = bim[h]; const float bbr = (float)(zr * br - zi * bi), bbi = (float)(zr * bi + zi * br);
        const int ln = (p & 31) + 32 * (h >> 3), j = h & 7;
        Bm[(((size_t)ldg * 4 + ntb) * 64 + ln) * 8 + j] = (bf16_t)(pk2(bbr, 0.f) & 0xffffu);
        Bm[(((size_t)ldg * 4 + ntb + 1) * 64 + ln) * 8 + j] = (bf16_t)(pk2(bbi, 0.f) & 0xffffu); }
    for (int hp = 0; hp < 16; ++hp) { const float cr = P.in[19][((size_t)ldg * 16 + hp) * 64 + p], ci = P.in[20][((size_t)ldg * 16 + hp) * 64 + p];
#pragma unroll
        for (int ri = 0; ri < 2; ++ri) { const int pp = 2 * p + ri, ks = pp >> 5, kq = (pp >> 3) & 3, j = pp & 7;
            Cm[(((size_t)ldg * 4 + ks) * 64 + kq * 16 + hp) * 8 + j] = (bf16_t)(pk2(ri ? -ci : cr, 0.f) & 0xffffu); } }
}

DI void phase0(const Params& P, unsigned char* shm, int wv) {
    float* lds = (float*)shm;
    constexpr int T_ADA = 192, T_W = 5504, T_V = 128, T_K = 128, T_S = 16, T_R = 128;
    constexpr int T_TOTAL = T_ADA + T_W + T_V + T_K + T_S + T_R;
    for (int rep = 0; rep < REP_P0; ++rep)
    for (int t = blockIdx.x; t < T_TOTAL; t += gridDim.x) {
        int r = t;
        if (r < T_ADA) { adaln_task(P, r, lds, wv); continue; }
        r -= T_ADA;
        if (r < T_W) { wconv_task(P, r, lds, wv); continue; }
        r -= T_W;
        if (r < T_V) { const int s8 = r & 7, kvh = (r >> 3) & 1, b = (r >> 4) & 3, l = r >> 6;
            tconv_tile(P.in[3] + (((size_t)(b * 2 + l) * 512 + s8 * 64) * 2 + kvh) * 64, 128, 0, 32,
                       (bf16_t*)(P.ws + WS_VLAT + l * SZ_KLAT) + ((size_t)(b * 2 + kvh) * 64) * 2560 + s8 * 64, 2560, lds, wv); continue; }
        r -= T_V;
        if (r < T_K) { const int idx = r * 4096 + ltid(wv) * 8; const int d = idx & 63, s = (idx >> 6) & 511, kvh = (idx >> 15) & 1, b = (idx >> 16) & 3, l = idx >> 18;
            const float* src = P.in[2] + ((((size_t)(b * 2 + l) * 512 + s) * 2 + kvh) * 64 + d);
            const f32x4 a = *(const f32x4*)src, c = *(const f32x4*)(src + 4);
            u32x4 w; w.x = pk2(a[0], a[1]); w.y = pk2(a[2], a[3]); w.z = pk2(c[0], c[1]); w.w = pk2(c[2], c[3]);
            *(u32x4*)((bf16_t*)(P.ws + WS_KLAT + l * SZ_KLAT) + ((size_t)(b * 2 + kvh) * 2560 + s) * 64 + d) = w; continue; }
        r -= T_K;
        if (r < T_S) { ssmconst_task(P, r, wv); continue; }
        r -= T_S;
        { const int idx = r * 512 + ltid(wv); const int tt = idx >> 5, i = idx & 31; const int pos = (i < 16) ? (tt >> 6) : (tt & 63); const int f = i & 15;
          const double inv = pow(10000.0, -(2.0 * f) / 32.0); double sn, cs; sincos((double)pos * inv, &sn, &cs);
          ((float*)(P.ws + WS_ROPEC))[idx] = (float)cs; ((float*)(P.ws + WS_ROPES))[idx] = (float)sn; }
    }
}

DI float wave_sum(float v, int lane) {
    v += shx(v, 32, lane); v += shx(v, 16, lane); v += shx(v, 8, lane); v += shx(v, 4, lane); v += shx(v, 2, lane); v += shx(v, 1, lane); return v; }

DI void norm_phase(const float* __restrict__ xa, const float* __restrict__ xb, const bf16_t* __restrict__ xh, const float* __restrict__ gw, const float* mbase, int jstride, int sh_off, int sc_off, bf16_t* __restrict__ H, int wv) {
    const int tidl = ltid(wv); const int lane = tidl & 63, w = tidl >> 6;
    for (int base = (blockIdx.x * 8 + w) * 8; base < NTOK; base += gridDim.x * 64) {
        const int j = base < NCTX ? 0 : 1 + ((base - NCTX) >> 11);
        f32x4 wv4[4], sh4[4];
#pragma unroll
        for (int i = 0; i < 4; ++i) { const int col = i * 256 + lane * 4;
            const f32x4 g4 = ldg16f(gw + col), sc = *(const f32x4*)(mbase + j * jstride + sc_off + col); sh4[i] = *(const f32x4*)(mbase + j * jstride + sh_off + col); wv4[i] = g4 * (sc + 1.0f); }
#pragma unroll
        for (int hb = 0; hb < 2; ++hb) {
            f32x4 v[4][4]; float ss[4];
            if (xh) { u32x2 t[4][4];
#pragma unroll
                for (int r = 0; r < 4; ++r)
#pragma unroll
                    for (int i = 0; i < 4; ++i) t[r][i] = ldg8(xh + (size_t)(base + hb * 4 + r) * 1024 + i * 256 + lane * 4);
#pragma unroll
                for (int r = 0; r < 4; ++r)
#pragma unroll
                    for (int i = 0; i < 4; ++i) v[r][i] = (f32x4){bflo(t[r][i].x), bfhi(t[r][i].x), bflo(t[r][i].y), bfhi(t[r][i].y)};
            } else { const float* xr = base < NCTX ? xa + (size_t)(base + hb * 4) * 1024 : xb + (size_t)(base + hb * 4 - NCTX) * 1024;
#pragma unroll
                for (int r = 0; r < 4; ++r)
#pragma unroll
                    for (int i = 0; i < 4; ++i) v[r][i] = ldg16f(xr + (size_t)r * 1024 + i * 256 + lane * 4); }
#pragma unroll
            for (int r = 0; r < 4; ++r) { float a = 0.f;
#pragma unroll
                for (int i = 0; i < 4; ++i) a += v[r][i][0] * v[r][i][0] + v[r][i][1] * v[r][i][1] + v[r][i][2] * v[r][i][2] + v[r][i][3] * v[r][i][3];
                ss[r] = a; }
#pragma unroll
            for (int mk = 32; mk >= 1; mk >>= 1)
#pragma unroll
                for (int r = 0; r < 4; ++r) ss[r] += shx(ss[r], mk, lane);
#pragma unroll
            for (int r = 0; r < 4; ++r) { const float rstd = rsqrtf(ss[r] * (1.0f / 1024.0f) + 1e-6f);
#pragma unroll
                for (int i = 0; i < 4; ++i) { const f32x4 o = v[r][i] * rstd * wv4[i] + sh4[i];
                    u32x2 pw; pw.x = pk2(o[0], o[1]); pw.y = pk2(o[2], o[3]); stg8(H + (size_t)(base + hb * 4 + r) * 1024 + i * 256 + lane * 4, pw); } }
        }
    }
}

DI void final_norm_phase(const bf16_t* __restrict__ xh, float* __restrict__ Y, const float* __restrict__ gw, int wv) {
    const int tidl = ltid(wv); const int lane = tidl & 63, w = tidl >> 6;
    for (int base = (blockIdx.x * 8 + w) * 8; base < NTOK; base += gridDim.x * 64) {
        f32x4 g4[4];
#pragma unroll
        for (int i = 0; i < 4; ++i) g4[i] = ldg16f(gw + i * 256 + lane * 4);
#pragma unroll
        for (int hb = 0; hb < 2; ++hb) {
            u32x2 t[4][4]; float ss[4];
#pragma unroll
            for (int r = 0; r < 4; ++r)
#pragma unroll
                for (int i = 0; i < 4; ++i) t[r][i] = ldg8(xh + (size_t)(base + hb * 4 + r) * 1024 + i * 256 + lane * 4);
            f32x4 v[4][4];
#pragma unroll
            for (int r = 0; r < 4; ++r) { float a = 0.f;
#pragma unroll
                for (int i = 0; i < 4; ++i) { v[r][i] = (f32x4){bflo(t[r][i].x), bfhi(t[r][i].x), bflo(t[r][i].y), bfhi(t[r][i].y)}; a += v[r][i][0] * v[r][i][0] + v[r][i][1] * v[r][i][1] + v[r][i][2] * v[r][i][2] + v[r][i][3] * v[r][i][3]; }
                ss[r] = a; }
#pragma unroll
            for (int mk = 32; mk >= 1; mk >>= 1)
#pragma unroll
                for (int r = 0; r < 4; ++r) ss[r] += shx(ss[r], mk, lane);
#pragma unroll
            for (int r = 0; r < 4; ++r) { const float rstd = rsqrtf(ss[r] * (1.0f / 1024.0f) + 1e-6f);
#pragma unroll
                for (int i = 0; i < 4; ++i) stg16f(Y + (size_t)(base + hb * 4 + r) * 1024 + i * 256 + lane * 4, v[r][i] * rstd * g4[i]); }
        }
    }
}

struct EpiIn {
    static constexpr bool PERM = false, AFTER_DRAIN = false;
    int layer; const float* qn; const float* kn; const float* ropec; const float* ropes;
    bf16_t* Q; bf16_t* U; bf16_t* Kctx; bf16_t* Vctx; bf16_t* Klat; bf16_t* Vlat; float* outk; float* outv;
    DI void operator()(const f32x4 (&acc)[2][2][4][2], const pg8::Unit& u, int wr, int wc, int fr, int fq) const {
        asm volatile("" : "+v"(fr), "+v"(fq));
        const bool lat = u.pm >= 32; const int pn = u.pn;
        if (pn >= 3) {
#pragma unroll
            for (int ai = 0; ai < 2; ++ai)
#pragma unroll
                for (int m = 0; m < 4; ++m) { const int row = u.pm * 256 + ai * 128 + wr * 64 + m * 16 + fr;
#pragma unroll
                    for (int bj = 0; bj < 2; ++bj)
#pragma unroll
                        for (int n = 0; n < 2; ++n) { const int col = (pn - 3) * 256 + 64 * wc + 32 * bj + 16 * n + 4 * fq; const f32x4 a = acc[ai][bj][m][n];
                            u32x2 pw; pw.x = pk2(a[0], a[1]); pw.y = pk2(a[2], a[3]); stg8(U + (size_t)row * 512 + col, pw); } }
            return;
        }
        if (pn == 2 && wc >= 2) {
            const int kvh = wc - 2;
#pragma unroll
            for (int ai = 0; ai < 2; ++ai)
#pragma unroll
                for (int m = 0; m < 4; ++m) { const int row = u.pm * 256 + ai * 128 + wr * 64 + m * 16 + fr;
                    if (!lat) { const int b = row >> 8, t = row & 255; float* ov = outv + (((size_t)(b * 2 + layer) * 256 + t) * 2 + kvh) * 64; bf16_t* vt = Vctx + ((size_t)(b * 2 + kvh) * 64) * 256 + t;
#pragma unroll
                        for (int bj = 0; bj < 2; ++bj)
#pragma unroll
                            for (int n = 0; n < 2; ++n) { const int d = 32 * bj + 16 * n + 4 * fq; const f32x4 a = acc[ai][bj][m][n]; stg16f(ov + d, a);
                                const unsigned p0 = pk2(a[0], a[1]), p1 = pk2(a[2], a[3]);
                                vt[(size_t)(d + 0) * 256] = (bf16_t)(p0 & 0xffffu); vt[(size_t)(d + 1) * 256] = (bf16_t)(p0 >> 16); vt[(size_t)(d + 2) * 256] = (bf16_t)(p1 & 0xffffu); vt[(size_t)(d + 3) * 256] = (bf16_t)(p1 >> 16); } }
                    else { const int rl = row - NCTX, b = rl >> 11, t = rl & 2047; bf16_t* vt = Vlat + ((size_t)(b * 2 + kvh) * 64) * 2560 + 512 + t;
#pragma unroll
                        for (int bj = 0; bj < 2; ++bj)
#pragma unroll
                            for (int n = 0; n < 2; ++n) { const int d = 32 * bj + 16 * n + 4 * fq; const f32x4 a = acc[ai][bj][m][n];
                                const unsigned p0 = pk2(a[0], a[1]), p1 = pk2(a[2], a[3]);
                                vt[(size_t)(d + 0) * 2560] = (bf16_t)(p0 & 0xffffu); vt[(size_t)(d + 1) * 2560] = (bf16_t)(p0 >> 16); vt[(size_t)(d + 2) * 2560] = (bf16_t)(p1 & 0xffffu); vt[(size_t)(d + 3) * 2560] = (bf16_t)(p1 >> 16); } } }
            return;
        }
        const bool isq = pn < 2; const float* nw = isq ? qn : kn;
        f32x4 w4[2][2];
#pragma unroll
        for (int bj = 0; bj < 2; ++bj)
#pragma unroll
            for (int n = 0; n < 2; ++n) w4[bj][n] = *(const f32x4*)(nw + 32 * bj + 16 * n + 4 * fq);
        const float qscale = isq ? 0.125f * 1.4426950408889634f : 1.0f;
        f32x2 rc[2][2], rsn[2][2], cc[4][2], csn[4][2];
        if (lat) { const int T0 = (u.pm * 256 - NCTX) & 2047;
#pragma unroll
            for (int ai = 0; ai < 2; ++ai)
#pragma unroll
                for (int n = 0; n < 2; ++n) { const int o = (T0 + 128 * ai + 64 * wr) * 32 + 8 * n + 2 * fq; rc[ai][n] = ldg8f(ropec + o); rsn[ai][n] = ldg8f(ropes + o); }
#pragma unroll
            for (int m = 0; m < 4; ++m)
#pragma unroll
                for (int n = 0; n < 2; ++n) { const int o = (16 * m + fr) * 32 + 16 + 8 * n + 2 * fq; cc[m][n] = ldg8f(ropec + o); csn[m][n] = ldg8f(ropes + o); } }
#pragma unroll
        for (int ai = 0; ai < 2; ++ai)
#pragma unroll
            for (int m = 0; m < 4; ++m) { const int row = u.pm * 256 + ai * 128 + wr * 64 + m * 16 + fr;
                float ss = 0.f;
#pragma unroll
                for (int bj = 0; bj < 2; ++bj)
#pragma unroll
                    for (int n = 0; n < 2; ++n) { const f32x4 a = acc[ai][bj][m][n]; ss += a[0] * a[0] + a[1] * a[1] + a[2] * a[2] + a[3] * a[3]; }
                ss += shx(ss, 16, fq * 16 + fr); ss += shx(ss, 32, fq * 16 + fr);
                const float rstd = rsqrtf(ss * (1.0f / 64.0f) + 1e-6f);
                f32x4 v[2][2];
#pragma unroll
                for (int bj = 0; bj < 2; ++bj)
#pragma unroll
                    for (int n = 0; n < 2; ++n) v[bj][n] = acc[ai][bj][m][n] * rstd * w4[bj][n];
                if (!lat) {
                    const int b = row >> 8, t = row & 255;
                    if (isq) { bf16_t* qp = Q + (size_t)row * 512 + (pn * 4 + wc) * 64;
#pragma unroll
                        for (int bj = 0; bj < 2; ++bj)
#pragma unroll
                            for (int n = 0; n < 2; ++n) { const f32x4 a = v[bj][n] * qscale; u32x2 pw; pw.x = pk2(a[0], a[1]); pw.y = pk2(a[2], a[3]); stg8(qp + 32 * bj + 16 * n + 4 * fq, pw); } }
                    else { const int kvh = wc; float* ok = outk + (((size_t)(b * 2 + layer) * 256 + t) * 2 + kvh) * 64; bf16_t* kp = Kctx + ((size_t)(b * 2 + kvh) * 256 + t) * 64;
#pragma unroll
                        for (int bj = 0; bj < 2; ++bj)
#pragma unroll
                            for (int n = 0; n < 2; ++n) { const int d = 32 * bj + 16 * n + 4 * fq; const f32x4 a = v[bj][n]; stg16f(ok + d, a);
                                u32x2 pw; pw.x = pk2(a[0], a[1]); pw.y = pk2(a[2], a[3]); stg8(kp + d, pw); } }
                } else {
                    const int rl = row - NCTX, b = rl >> 11, t = rl & 2047;
                    bf16_t* dst = isq ? Q + (size_t)row * 512 + (pn * 4 + wc) * 64 : Klat + ((size_t)(b * 2 + wc) * 2560 + 512 + t) * 64;
#pragma unroll
                    for (int bj = 0; bj < 2; ++bj)
#pragma unroll
                        for (int n = 0; n < 2; ++n) { const int d = 32 * bj + 16 * n + 4 * fq; const int pi = d >> 1;
                            const f32x2 c2 = bj == 0 ? rc[ai][n] : cc[m][n], s2 = bj == 0 ? rsn[ai][n] : csn[m][n]; const f32x4 a = v[bj][n];
                            const float o0 = (a[0] * c2[0] - a[1] * s2[0]) * qscale, o1 = (a[0] * s2[0] + a[1] * c2[0]) * qscale, o2 = (a[2] * c2[1] - a[3] * s2[1]) * qscale, o3 = (a[2] * s2[1] + a[3] * c2[1]) * qscale;
                            u32x2 pw; pw.x = pk2(o0, o1); pw.y = pk2(o2, o3); stg8(dst + d, pw); }
                }
            }
    }
};

struct EpiGlu {
    static constexpr bool PERM = true, AFTER_DRAIN = false;
    const bf16_t* G; const float* bias; bf16_t* MIX;
    DI void operator()(const f32x4 (&acc)[2][2][4][2], const pg8::Unit& u, int wr, int wc, int fr, int fq) const {
        asm volatile("" : "+v"(fr), "+v"(fq));
        const int cb = u.pn * 256 + 32 * wc + 8 * fq, rb = u.pm * 256 + wr * 64 + fr;
        f32x4 bv[2][2]; u32x4 gw[2][4][2];
#pragma unroll
        for (int bj = 0; bj < 2; ++bj) { bv[bj][0] = ldg16f(bias + cb + 128 * bj); bv[bj][1] = ldg16f(bias + cb + 128 * bj + 4); }
#pragma unroll
        for (int ai = 0; ai < 2; ++ai)
#pragma unroll
            for (int m = 0; m < 4; ++m)
#pragma unroll
                for (int bj = 0; bj < 2; ++bj) gw[ai][m][bj] = ldg16(G + (size_t)(rb + 128 * ai + 16 * m) * 512 + cb + 128 * bj);
#pragma unroll
        for (int ai = 0; ai < 2; ++ai)
#pragma unroll
            for (int m = 0; m < 4; ++m)
#pragma unroll
                for (int bj = 0; bj < 2; ++bj) { const u32x4 g4 = gw[ai][m][bj];
                    const f32x4 v0 = acc[ai][bj][m][0] + bv[bj][0], v1 = acc[ai][bj][m][1] + bv[bj][1];
                    u32x4 o;
                    o.x = pk2(bflo(g4.x) * sigmoidf_(v0[0]), bfhi(g4.x) * sigmoidf_(v0[1])); o.y = pk2(bflo(g4.y) * sigmoidf_(v0[2]), bfhi(g4.y) * sigmoidf_(v0[3]));
                    o.z = pk2(bflo(g4.z) * sigmoidf_(v1[0]), bfhi(g4.z) * sigmoidf_(v1[1])); o.w = pk2(bflo(g4.w) * sigmoidf_(v1[2]), bfhi(g4.w) * sigmoidf_(v1[3]));
                    stg16(MIX + (size_t)(rb + 128 * ai + 16 * m) * 1024 + 512 + cb + 128 * bj, o); }
    }
};

struct EpiRes {
    static constexpr bool PERM = false, AFTER_DRAIN = false;
    const float* xa; const float* xb; const bf16_t* xh; bf16_t* Xo; const float* gate;
    DI void operator()(const f32x4 (&acc)[2][2][4][2], const pg8::Unit& u, int wr, int wc, int fr, int fq) const {
        asm volatile("" : "+v"(fr), "+v"(fq));
        const int j = u.pm < 32 ? 0 : 1 + ((u.pm - 32) >> 3);
        const int cb = u.pn * 256 + 32 * wc + 4 * fq, rb = u.pm * 256 + wr * 64 + fr;
        const float* gt = gate + j * 6144 + cb;
        f32x4 gv[2][2];
#pragma unroll
        for (int bj = 0; bj < 2; ++bj)
#pragma unroll
            for (int n = 0; n < 2; ++n) gv[bj][n] = ldg16f(gt + 128 * bj + 16 * n);
        if (xh) {
            u32x2 xr[2][4][2][2];
#pragma unroll
            for (int ai = 0; ai < 2; ++ai)
#pragma unroll
                for (int m = 0; m < 4; ++m)
#pragma unroll
                    for (int bj = 0; bj < 2; ++bj)
#pragma unroll
                        for (int n = 0; n < 2; ++n) xr[ai][m][bj][n] = ldg8(xh + (size_t)(rb + 128 * ai + 16 * m) * 1024 + cb + 128 * bj + 16 * n);
#pragma unroll
            for (int ai = 0; ai < 2; ++ai)
#pragma unroll
                for (int m = 0; m < 4; ++m)
#pragma unroll
                    for (int bj = 0; bj < 2; ++bj)
#pragma unroll
                        for (int n = 0; n < 2; ++n) { const u32x2 t = xr[ai][m][bj][n]; const f32x4 xv = (f32x4){bflo(t.x), bfhi(t.x), bflo(t.y), bfhi(t.y)};
                            const f32x4 xn = xv + gv[bj][n] * acc[ai][bj][m][n];
                            u32x2 pw; pw.x = pk2(xn[0], xn[1]); pw.y = pk2(xn[2], xn[3]); stg8(Xo + (size_t)(rb + 128 * ai + 16 * m) * 1024 + cb + 128 * bj + 16 * n, pw); }
        } else {
            const float* xs = u.pm < 32 ? xa + (size_t)rb * 1024 : xb + (size_t)(rb - NCTX) * 1024;
#pragma unroll
            for (int ai = 0; ai < 2; ++ai) {
                f32x4 xr[4][2][2];
#pragma unroll
                for (int m = 0; m < 4; ++m)
#pragma unroll
                    for (int bj = 0; bj < 2; ++bj)
#pragma unroll
                        for (int n = 0; n < 2; ++n) xr[m][bj][n] = ldg16f(xs + (size_t)(128 * ai + 16 * m) * 1024 + cb + 128 * bj + 16 * n);
#pragma unroll
                for (int m = 0; m < 4; ++m)
#pragma unroll
                    for (int bj = 0; bj < 2; ++bj)
#pragma unroll
                        for (int n = 0; n < 2; ++n) { const f32x4 xn = xr[m][bj][n] + gv[bj][n] * acc[ai][bj][m][n];
                            u32x2 pw; pw.x = pk2(xn[0], xn[1]); pw.y = pk2(xn[2], xn[3]); stg8(Xo + (size_t)(rb + 128 * ai + 16 * m) * 1024 + cb + 128 * bj + 16 * n, pw); }
            }
        }
    }
};

struct EpiFfn1 {
    static constexpr bool PERM = true, AFTER_DRAIN = false;
    bf16_t* ACT;
    DI void operator()(const f32x4 (&acc)[2][2][4][2], const pg8::Unit& u, int wr, int wc, int fr, int fq) const {
        asm volatile("" : "+v"(fr), "+v"(fq));
#pragma unroll
        for (int ai = 0; ai < 2; ++ai)
#pragma unroll
            for (int m = 0; m < 4; ++m) { const int row = u.pm * 256 + ai * 128 + wr * 64 + m * 16 + fr; const int a0 = u.pn * 128 + 32 * wc + 8 * fq;
                const f32x4 g0 = acc[ai][0][m][0], g1 = acc[ai][0][m][1], u0 = acc[ai][1][m][0], u1 = acc[ai][1][m][1];
                u32x4 o;
                o.x = pk2(g0[0] * sigmoidf_(g0[0]) * u0[0], g0[1] * sigmoidf_(g0[1]) * u0[1]); o.y = pk2(g0[2] * sigmoidf_(g0[2]) * u0[2], g0[3] * sigmoidf_(g0[3]) * u0[3]);
                o.z = pk2(g1[0] * sigmoidf_(g1[0]) * u1[0], g1[1] * sigmoidf_(g1[1]) * u1[1]); o.w = pk2(g1[2] * sigmoidf_(g1[2]) * u1[2], g1[3] * sigmoidf_(g1[3]) * u1[3]);
                stg16(ACT + (size_t)row * 2816 + a0, o); }
    }
};

struct ListOrder {
    int count, G, c, mode;
    DI bool next(int i, pg8::Unit& u) const {
        const int L0 = i * G + c; if (L0 >= count) return false;
        const int L = (L0 & 7) * (count >> 3) + (L0 >> 3);
        if (mode == 0) { const int pm = L >> 2, vn = L & 3; if (vn < 3) { u.pm = pm; u.pn = vn; } else { u.pm = 32 + (pm >> 1); u.pn = 3 + (pm & 1); } }
        else { u.pm = L >> 1; u.pn = 3 + (L & 1); }
        return true;
    }
    DI void a_ready(const pg8::Unit&) const {}
    DI void done(const pg8::Unit&) const {}
};

template <class Epi> DI void run_gemm(unsigned char* shm, const bf16_t* A, const bf16_t* Bt, int N, int K, const Epi& E, int wv) {
    pg8::Gemm g; g.A = A; g.Bt = Bt; g.M = NTOK; g.N = N; g.K = K;
    pg8::StaticOrder S; S.init(NTOK, N, (int)gridDim.x, (int)blockIdx.x);
    pg8::gemm_phase<Epi, pg8::StaticOrder, false>((PG8_LAS unsigned char*)shm, g, S, E, nullptr, wv);
}

DI void attn_item(const bf16_t* __restrict__ Q, const bf16_t* __restrict__ Kp, const bf16_t* __restrict__ Vp, int vld, int nkeys, int qtok0, int kvh, bf16_t* __restrict__ MIX, unsigned char* lds, int wv) {
    const int tid = ltid(wv), w = tid >> 6, lane = tid & 63, c = lane & 31, hh = lane >> 5;
    const int hq = kvh * 4 + (w & 3), qtok = qtok0 + 32 * (w >> 2) + c;
    bf16x8 qf[4];
#pragma unroll
    for (int s = 0; s < 4; ++s) qf[s] = __builtin_bit_cast(bf16x8, ldg16(Q + (size_t)qtok * 512 + hq * 64 + 16 * s + 8 * hh));
    unsigned char* Kb = lds; unsigned char* Vb = lds + 2 * 9216;
    const int srow = tid >> 3, sseg = tid & 7;
    const bf16_t* kg = Kp + (size_t)srow * 64 + sseg * 8;
    const bf16_t* vg = Vp + (size_t)srow * vld + sseg * 8;
    u32x4 kr = ldg16(kg), vr = ldg16(vg);
    *(u32x4*)(Kb + srow * 144 + sseg * 16) = kr;
    { u32x2* d = (u32x2*)(Vb + srow * 136 + sseg * 16); u32x2 a; a.x = vr.x; a.y = vr.y; u32x2 b; b.x = vr.z; b.y = vr.w; d[0] = a; d[1] = b; }
    __syncthreads();
    f32x16 ot[2];
#pragma unroll
    for (int i = 0; i < 16; ++i) { ot[0][i] = 0.f; ot[1][i] = 0.f; }
    float mrun = -1e30f, lsum = 0.f;
    const int nt = nkeys >> 6;
    for (int it = 0; it < nt; ++it) {
        const int cur = it & 1;
        if (it + 1 < nt) { kr = ldg16(kg + (size_t)(it + 1) * 4096); vr = ldg16(vg + (it + 1) * 64); }
        const unsigned char* kb = Kb + cur * 9216; const unsigned char* vb = Vb + cur * 8704;
        f32x16 st[2]; bf16x8 kf[2][4];
#pragma unroll
        for (int kt = 0; kt < 2; ++kt)
#pragma unroll
            for (int s = 0; s < 4; ++s) kf[kt][s] = *(const PG8_LAS bf16x8*)(const PG8_LAS unsigned char*)(kb + (32 * kt + c) * 144 + (16 * s + 8 * hh) * 2);
#pragma unroll
        for (int kt = 0; kt < 2; ++kt) {
#pragma unroll
            for (int i = 0; i < 16; ++i) st[kt][i] = 0.f;
#pragma unroll
            for (int s = 0; s < 4; ++s) st[kt] = mfma32p(kf[kt][s], qf[s], st[kt]); }
        float mx = fmaxf(fmaxf(st[0][0], st[0][1]), st[0][2]);
#pragma unroll
        for (int i = 3; i < 15; i += 2) mx = fmaxf(fmaxf(mx, st[0][i]), st[0][i + 1]);
        mx = fmaxf(mx, st[0][15]);
#pragma unroll
        for (int i = 0; i < 16; i += 2) mx = fmaxf(fmaxf(mx, st[1][i]), st[1][i + 1]);
        mx = fmaxf(mx, shx(mx, 32, lane));
        const float mnew = fmaxf(mrun, mx), alpha = __builtin_amdgcn_exp2f(mrun - mnew); mrun = mnew;
        f32x2 ps2 = (f32x2){0.f, 0.f}; const f32x2 mn2 = (f32x2){mnew, mnew};
#pragma unroll
        for (int kt = 0; kt < 2; ++kt)
#pragma unroll
            for (int i = 0; i < 16; i += 2) { f32x2 d = (f32x2){st[kt][i], st[kt][i + 1]} - mn2; f32x2 pp; pp.x = __builtin_amdgcn_exp2f(d.x); pp.y = __builtin_amdgcn_exp2f(d.y); st[kt][i] = pp.x; st[kt][i + 1] = pp.y; ps2 += pp; }
        const float ps = ps2.x + ps2.y;
        lsum = lsum * alpha + ps;
        if (__builtin_amdgcn_ballot_w64(alpha != 1.0f) != 0ull) {
#pragma unroll
            for (int i = 0; i < 16; ++i) { ot[0][i] *= alpha; ot[1][i] *= alpha; } }
        s16x4 vlo[2][2][2], vhi[2][2][2];
#pragma unroll
        for (int kt = 0; kt < 2; ++kt)
#pragma unroll
            for (int sp = 0; sp < 2; ++sp)
#pragma unroll
                for (int dt = 0; dt < 2; ++dt) { const PG8_LAS unsigned char* vrow = (const PG8_LAS unsigned char*)(vb + (32 * dt + c) * 136 + (32 * kt + 16 * sp + 4 * hh) * 2);
                    vlo[kt][sp][dt] = *(const PG8_LAS s16x4*)vrow; vhi[kt][sp][dt] = *(const PG8_LAS s16x4*)(vrow + 16); }
#pragma unroll
        for (int kt = 0; kt < 2; ++kt)
#pragma unroll
            for (int sp = 0; sp < 2; ++sp) {
                const bf16x8 pk = pack8(st[kt][8 * sp], st[kt][8 * sp + 1], st[kt][8 * sp + 2], st[kt][8 * sp + 3], st[kt][8 * sp + 4], st[kt][8 * sp + 5], st[kt][8 * sp + 6], st[kt][8 * sp + 7]);
#pragma unroll
                for (int dt = 0; dt < 2; ++dt) { const bf16x8 va = __builtin_shufflevector(vlo[kt][sp][dt], vhi[kt][sp][dt], 0, 1, 2, 3, 4, 5, 6, 7); ot[dt] = mfma32p(va, pk, ot[dt]); } }
        if (it + 1 < nt) { const int nx = cur ^ 1;
            *(u32x4*)(Kb + nx * 9216 + srow * 144 + sseg * 16) = kr;
            u32x2* d = (u32x2*)(Vb + nx * 8704 + srow * 136 + sseg * 16); u32x2 a; a.x = vr.x; a.y = vr.y; u32x2 b; b.x = vr.z; b.y = vr.w; d[0] = a; d[1] = b; }
        __syncthreads();
    }
    const float ltot = lsum + shx(lsum, 32, lane); const float inv = 1.0f / ltot;
    bf16_t* op = MIX + (size_t)qtok * 1024 + hq * 64;
#pragma unroll
    for (int dt = 0; dt < 2; ++dt)
#pragma unroll
        for (int g4 = 0; g4 < 4; ++g4) { u32x2 pw; pw.x = pk2(ot[dt][4 * g4] * inv, ot[dt][4 * g4 + 1] * inv); pw.y = pk2(ot[dt][4 * g4 + 2] * inv, ot[dt][4 * g4 + 3] * inv);
            stg8(op + 32 * dt + 8 * g4 + 4 * hh, pw); }
}

template <int DIR, bool FULL>
DI void ssm_pass(int layer, int pr, int g, const bf16_t* __restrict__ U, const bf16x8* __restrict__ Bm, const bf16x8* __restrict__ Cm, const float* __restrict__ lam,
                 const float* __restrict__ state_in, const float* sseg_r, float* sseg_w, float* YF, bf16_t* __restrict__ G, const float* __restrict__ dskip,
                 float* __restrict__ out_state, unsigned char* hl, int wv) {
    const int lane = ltid(wv) & 63, c = lane & 31, hh = lane >> 5, fr = lane & 15, kq = lane >> 4;
    const int ldg = (layer * 2 + DIR) * 32 + g;
    bf16x8 bm[4], cm[4];
#pragma unroll
    for (int i = 0; i < 4; ++i) { bm[i] = Bm[(ldg * 4 + i) * 64 + lane]; if (FULL) cm[i] = Cm[(ldg * 4 + i) * 64 + lane]; }
    const float l0r = lam[(ldg * 64 + c) * 2], l0i = lam[(ldg * 64 + c) * 2 + 1], l1r = lam[(ldg * 64 + 32 + c) * 2], l1i = lam[(ldg * 64 + 32 + c) * 2 + 1];
    const int s = 2 * pr + hh;
    float h0r = 0.f, h0i = 0.f, h1r = 0.f, h1i = 0.f;
    if (FULL && pr >= 16) {
        const int sl = s - 32, b = sl >> 3, seg = sl & 7;
        float a0r = l0r, a0i = l0i, a1r = l1r, a1i = l1i;
#pragma unroll
        for (int i = 0; i < 8; ++i) { const float t0 = a0r * a0r - a0i * a0i, t1 = 2.f * a0r * a0i; a0r = t0; a0i = t1; const float t2 = a1r * a1r - a1i * a1i, t3 = 2.f * a1r * a1i; a1r = t2; a1i = t3; }
        const float* si = state_in + ((((size_t)(b * 2 + layer) * 2 + DIR) * 2) * 32 + g) * 64;
        h0r = si[c]; h0i = si[2048 + c]; h1r = si[32 + c]; h1i = si[2048 + 32 + c];
        const int n = DIR == 0 ? seg : 7 - seg;
        f32x2 sa[7], sb[7];
#pragma unroll
        for (int jj = 0; jj < 7; ++jj) { const int j = DIR == 0 ? jj : 7 - jj;
            const float* sp = sseg_r + ((((size_t)(b * 8 + j) * 2 + DIR) * 32 + g) * 64) * 2;
            sa[jj] = ldg8f(sp + c * 2); sb[jj] = ldg8f(sp + (32 + c) * 2); }
#pragma unroll
        for (int jj = 0; jj < 7; ++jj) { const bool on = jj < n;
            const float n0r = a0r * h0r - a0i * h0i + sa[jj].x, n0i = a0r * h0i + a0i * h0r + sa[jj].y;
            const float n1r = a1r * h1r - a1i * h1i + sb[jj].x, n1i = a1r * h1i + a1i * h1r + sb[jj].y;
            h0r = on ? n0r : h0r; h0i = on ? n0i : h0i; h1r = on ? n1r : h1r; h1i = on ? n1i : h1i; }
    }
    const int seq_r = (c >> 2) & 1, q_r = (c & 3) + 4 * (c >> 3);
    const bf16_t* ua_ptr = U + ((size_t)((2 * pr + seq_r) * 256 + q_r)) * 512 + g * 16 + 8 * hh;
    f32x16 zero16;
#pragma unroll
    for (int i = 0; i < 16; ++i) zero16[i] = 0.f;
    auto ldu = [&](int ch) -> bf16x8 { return __builtin_bit_cast(bf16x8, ldg16(ua_ptr + (size_t)(DIR ? 240 - 16 * ch : 16 * ch) * 512)); };
    auto body = [&](const bf16x8 ua, int ch) {
        const int cb = DIR ? 240 - 16 * ch : 16 * ch;
        f32x16 x[4];
#pragma unroll
        for (int i = 0; i < 4; ++i) x[i] = mfma32(ua, bm[i], zero16);
#pragma unroll
        for (int i = 0; i < 16; ++i) { const int reg = DIR ? 15 - i : i;
            const float n0r = __builtin_fmaf(l0r, h0r, __builtin_fmaf(-l0i, h0i, x[0][reg])), n0i = __builtin_fmaf(l0r, h0i, __builtin_fmaf(l0i, h0r, x[1][reg])); h0r = n0r; h0i = n0i;
            const float n1r = __builtin_fmaf(l1r, h1r, __builtin_fmaf(-l1i, h1i, x[2][reg])), n1i = __builtin_fmaf(l1r, h1i, __builtin_fmaf(l1i, h1r, x[3][reg])); h1r = n1r; h1i = n1i;
            if (FULL) { unsigned* hrow = (unsigned*)(hl + (hh * 16 + reg) * 272); hrow[c] = pk2(h0r, h0i); hrow[32 + c] = pk2(h1r, h1i); } }
        if (FULL) {
#pragma unroll
            for (int sq = 0; sq < 2; ++sq) { f32x4 y = (f32x4){0.f, 0.f, 0.f, 0.f};
#pragma unroll
                for (int ks = 0; ks < 4; ++ks) { const bf16x8 af = *(const bf16x8*)(hl + (sq * 16 + fr) * 272 + (32 * ks + 8 * kq) * 2); y = mfma16(cm[ks], af, y); }
                { u32x2 pw; pw.x = pk2(y[0], y[1]); pw.y = pk2(y[2], y[3]); stg8((bf16_t*)YF + ((size_t)((2 * pr + sq) * 256 + cb + fr)) * 512 + g * 16 + 4 * kq, pw); } }
        }
    };
    bf16x8 u0 = ldu(0), u1 = ldu(1), u2 = ldu(2), u3 = ldu(3);
#pragma unroll 1
    for (int c4 = 0; c4 < 16; c4 += 4) {
        const bool more = c4 + 4 < 16;
        body(u0, c4);     if (more) u0 = ldu(c4 + 4);
        body(u1, c4 + 1); if (more) u1 = ldu(c4 + 5);
        body(u2, c4 + 2); if (more) u2 = ldu(c4 + 6);
        body(u3, c4 + 3); if (more) u3 = ldu(c4 + 7);
    }
    if (FULL) { if (pr < 16) { float* os = out_state + ((((size_t)(s * 2 + layer) * 2 + DIR) * 2) * 32 + g) * 64; os[c] = h0r; os[2048 + c] = h0i; os[32 + c] = h1r; os[2048 + 32 + c] = h1i; } }
    else { float* sw = sseg_w + ((((size_t)(s - 32) * 2 + DIR) * 32 + g) * 64) * 2; sw[c * 2] = h0r; sw[c * 2 + 1] = h0i; sw[(32 + c) * 2] = h1r; sw[(32 + c) * 2 + 1] = h1i; }
}

#define XB_TMO      128
#define XB_XCNT(j)  (256  + 64 * (j))
#define XB_XSUB(j)  (1280 + 64 * (j))
#define XB_XGEN(j)  (2304 + 64 * (j))
#define XB_TOP      3328
#define XB_TOPGEN   3392
#define XCD_BAR_WORDS 3456
#define XB_SPIN_CAP (1u << 18)
#define LAS __attribute__((address_space(3)))

__device__ __forceinline__ unsigned xb_ld(unsigned* p)              { return __hip_atomic_load(p, __ATOMIC_RELAXED, __HIP_MEMORY_SCOPE_AGENT); }
__device__ __forceinline__ unsigned xb_add(unsigned* p, unsigned v) { return __hip_atomic_fetch_add(p, v, __ATOMIC_RELAXED, __HIP_MEMORY_SCOPE_AGENT); }
__device__ __forceinline__ unsigned xb_xcc_id() { return (unsigned)__builtin_amdgcn_s_getreg((3 << 11) | 20) & 0xFu; }
#define XB_SPIN(cond, bar) do { unsigned _sp = 0; while (cond) { __builtin_amdgcn_s_sleep(1); \
    if ((++_sp & 255u) == 0u) { if (xb_ld(&(bar)[XB_TMO])) break; if (_sp > XB_SPIN_CAP) { atomicAdd(&(bar)[XB_TMO], 1u); break; } } } } while (0)

struct XcdBarrier {
    unsigned* bar; unsigned x;
    volatile LAS unsigned* st;
};

__device__ __forceinline__ XcdBarrier xcd_barrier_post(unsigned* bar, volatile LAS unsigned* st) {
    XcdBarrier b; b.bar = bar; b.x = xb_xcc_id(); b.st = st;
    if (threadIdx.x == 0) (void)xb_add(&bar[XB_XCNT(b.x)], 1u);
    return b;
}
__device__ __forceinline__ void xcd_barrier_complete(unsigned* bar, unsigned x, unsigned& nloc, unsigned& nx) {
    const unsigned G = gridDim.x * gridDim.y * gridDim.z;
    unsigned sum, cnt, mine, sp = 0u;
    for (;;) {
        sum = 0u; cnt = 0u; mine = 0u;
#pragma unroll
        for (unsigned j = 0; j < 16; ++j) { const unsigned c = xb_ld(&bar[XB_XCNT(j)]); sum += c; cnt += (c > 0u) ? 1u : 0u; mine = (j == x) ? c : mine; }
        if (sum == G) break;
        __builtin_amdgcn_s_sleep(1);
        if ((++sp & 255u) == 0u) { if (xb_ld(&bar[XB_TMO])) break; if (sp > XB_SPIN_CAP) { atomicAdd(&bar[XB_TMO], 1u); break; } }
    }
    nloc = mine > 0u ? mine : 1u; nx = cnt > 0u ? cnt : 1u;
}

__device__ __forceinline__ void xcd_barrier(const XcdBarrier& b) {
    asm volatile("s_waitcnt vmcnt(0)" ::: "memory");
    __syncthreads();
    if (threadIdx.x == 0) {
        unsigned* bar = b.bar;
        __builtin_amdgcn_s_waitcnt(0);
        unsigned nloc = b.st[0], nx = b.st[1];
        if (nloc == 0u) { xcd_barrier_complete(bar, b.x, nloc, nx); b.st[0] = nloc; b.st[1] = nx; }
        const unsigned old = xb_add(&bar[XB_XSUB(b.x)], 1u);
        const unsigned gen = old / nloc;
        if (old + 1u == (gen + 1u) * nloc) {
            __builtin_amdgcn_fence(__ATOMIC_RELEASE, "agent");
            asm volatile("s_waitcnt vmcnt(0)" ::: "memory");
            const unsigned og = xb_add(&bar[XB_TOP], 1u);
            const unsigned tg = og / nx;
            if (og + 1u == (tg + 1u) * nx) xb_add(&bar[XB_TOPGEN], 1u);
            else XB_SPIN(xb_ld(&bar[XB_TOPGEN]) == tg, bar);
            __builtin_amdgcn_fence(__ATOMIC_ACQUIRE, "agent");
            xb_add(&bar[XB_XGEN(b.x)], 1u);
            asm volatile("s_waitcnt vmcnt(0)" ::: "memory");
        } else {
            XB_SPIN(xb_ld(&bar[XB_XGEN(b.x)]) == gen, bar);
            __builtin_amdgcn_fence(__ATOMIC_ACQUIRE, "agent");
            asm volatile("s_waitcnt vmcnt(0)" ::: "memory");
        }
    }
    __syncthreads();
}


typedef const __attribute__((address_space(4))) Params* KParamsPtr;
DI KParamsPtr kparams() { KParamsPtr p = (KParamsPtr)__builtin_amdgcn_kernarg_segment_ptr(); asm volatile("" : "+s"(p)); return p; }
#define PKP (kparams())
__global__ __launch_bounds__(512, 2) void mega_fwd(Params P) {
    extern __shared__ __attribute__((aligned(16))) unsigned char shm[];
    cg::grid_group grid = cg::this_grid();
#define WSP_ (opaque_ptr(PKP->ws))
#define XP_ ((float*)opaque_ptr((unsigned char*)PKP->out))
#define MODS_ ((const float*)(WSP_ + WS_MODS))
#define HB_ ((bf16_t*)(WSP_ + WS_H))
#define YFP_ ((float*)(WSP_ + WS_H))
#define QB_ ((bf16_t*)(WSP_ + WS_Q))
#define UB_ ((bf16_t*)(WSP_ + WS_U))
#define MIXB_ ((bf16_t*)(WSP_ + WS_MIX))
#define GB_ ((bf16_t*)(WSP_ + WS_G))
#define ACTB_ ((bf16_t*)(WSP_ + WS_ACT))
#define KCTX_ ((bf16_t*)(WSP_ + WS_KCTX))
#define VCTX_ ((bf16_t*)(WSP_ + WS_VCTX))
    const int w = __builtin_amdgcn_readfirstlane(threadIdx.x >> 6);
    if (PKP->ws == nullptr) grid.sync();
    if (threadIdx.x == 0) { ((volatile LAS unsigned*)(shm + 131072))[0] = 0u; ((volatile LAS unsigned*)(shm + 131072))[1] = 0u; }
    __syncthreads();
    (void)xcd_barrier_post((unsigned*)(WSP_ + WS_BAR), (volatile LAS unsigned*)(shm + 131072));
#define GSYNC() do { XcdBarrier b_; b_.bar = (unsigned*)(opaque_ptr(PKP->ws) + WS_BAR); b_.x = xb_xcc_id(); b_.st = (volatile LAS unsigned*)(shm + 131072); xcd_barrier(b_); } while (0)

    { Params Pl; for (int i = 0; i < 28; ++i) Pl.in[i] = PKP->in[i]; Pl.out = PKP->out; Pl.ws = PKP->ws; phase0(Pl, shm, w); }
    GSYNC();
#pragma unroll 1
    for (int l = 0; l < 2; ++l) {
#define MODSL_ (MODS_ + l * 5 * 6144)
#define XA_ (PKP->in[0])
#define XH_ ((bf16_t*)(WSP_ + WS_XB))
#define XB_ (PKP->in[1])
#define KLAT_ ((bf16_t*)(WSP_ + WS_KLAT + l * SZ_KLAT))
#define VLAT_ ((bf16_t*)(WSP_ + WS_VLAT + l * SZ_KLAT))
        if (l == 0) {
            const int tid = ltid(w); const float* part = (const float*)(WSP_ + WS_MODP); const float* bm_ = PKP->in[8]; float* mw = (float*)(WSP_ + WS_MODS); float* ldsf = (float*)shm;
            for (int idx = blockIdx.x * 512 + tid; idx < 61440; idx += gridDim.x * 512) { const int ll = idx / 30720, n = idx % 6144;
                mw[idx] = part[idx] + part[61440 + idx] + part[2 * 61440 + idx] + part[3 * 61440 + idx] + bm_[ll * 6144 + n]; }
            for (int e = tid; e < 10240; e += 512) { const int j = e >> 11, r = e & 2047; const int idx = j * 6144 + r;
                ldsf[e] = part[idx] + part[61440 + idx] + part[2 * 61440 + idx] + part[3 * 61440 + idx] + bm_[r]; }
            __syncthreads();
            for (int rep = 0; rep < REP_NORM; ++rep) norm_phase(XA_, XB_, nullptr, PKP->in[9], ldsf, 2048, 0, 1024, HB_, w);
        } else
        for (int rep = 0; rep < REP_NORM; ++rep) norm_phase(XA_, XB_, XH_, PKP->in[9] + l * 1024, MODSL_, 6144, 0, 1024, HB_, w);
        GSYNC();
        { EpiIn E; E.layer = l; E.qn = PKP->in[12] + l * 64; E.kn = PKP->in[13] + l * 64; E.ropec = (const float*)(WSP_ + WS_ROPEC); E.ropes = (const float*)(WSP_ + WS_ROPES);
          E.Q = QB_; E.U = UB_; E.Kctx = KCTX_; E.Vctx = VCTX_; E.Klat = KLAT_; E.Vlat = VLAT_; E.outk = PKP->out + OUT_K; E.outv = PKP->out + OUT_V;
          { pg8::Gemm g; g.A = HB_; g.Bt = (const bf16_t*)(WSP_ + WS_WIN + l * SZ_WIN); g.M = NTOK; g.N = 1280; g.K = 1024;
            ListOrder S; S.count = 256; S.G = (int)gridDim.x; S.c = (int)blockIdx.x; S.mode = 0;
            pg8::gemm_phase<EpiIn, ListOrder, false>((PG8_LAS unsigned char*)shm, g, S, E, nullptr, w); }
          GSYNC();
          { pg8::Gemm g; g.A = HB_; g.Bt = (const bf16_t*)(WSP_ + WS_WIN + l * SZ_WIN); g.M = NTOK; g.N = 1280; g.K = 1024;
            ListOrder S; S.count = 64; S.G = (int)gridDim.x; S.c = (int)blockIdx.x; S.mode = 1;
            pg8::gemm_phase<EpiIn, ListOrder, false>((PG8_LAS unsigned char*)shm, g, S, E, nullptr, w); } }
        { const int nb = gridDim.x > 64 ? 64 : 0;
          if ((int)blockIdx.x >= nb)
          for (int it = blockIdx.x - nb; it < 384; it += gridDim.x - nb) {
            __syncthreads();
            if (it < 256) { const int qc = it & 3, kvh = (it >> 2) & 1, b = it >> 3;
                attn_item(QB_, KCTX_ + ((size_t)(b * 2 + kvh) * 256) * 64, VCTX_ + ((size_t)(b * 2 + kvh) * 64) * 256, 256, 256, b * 256 + qc * 64, kvh, MIXB_, shm, w); }
            else { const int wi = (it - 256) * 8 + w; const int dir = wi & 1, g = (wi >> 1) & 31, pr = 16 + (wi >> 6);
                if (dir == 0) ssm_pass<0, false>(l, pr, g, UB_, (const bf16x8*)(WSP_ + WS_SSMB), (const bf16x8*)(WSP_ + WS_SSMC), (const float*)(WSP_ + WS_SSML), PKP->in[4], nullptr, (float*)(WSP_ + WS_SSEG), nullptr, nullptr, nullptr, nullptr, nullptr, w);
                else ssm_pass<1, false>(l, pr, g, UB_, (const bf16x8*)(WSP_ + WS_SSMB), (const bf16x8*)(WSP_ + WS_SSMC), (const float*)(WSP_ + WS_SSML), PKP->in[4], nullptr, (float*)(WSP_ + WS_SSEG), nullptr, nullptr, nullptr, nullptr, nullptr, w); }
          } }
        GSYNC();
        for (int rep = 0; rep < REP_ATT4; ++rep)
        for (int it = blockIdx.x; it < 512; it += gridDim.x) {
            __syncthreads();
            if (it < 256) { const int qc = it >> 3, kvh = it & 1, b = (it >> 1) & 3;
                attn_item(QB_, KLAT_ + ((size_t)(b * 2 + kvh) * 2560) * 64, VLAT_ + ((size_t)(b * 2 + kvh) * 64) * 2560, 2560, 2560, NCTX + b * 2048 + qc * 64, kvh, MIXB_, shm, w); }
            else { const int si = it - 256, pr = si >> 3, gq = si & 7, g = gq * 4 + (w & 3);
                if (w < 4) ssm_pass<0, true>(l, pr, g, UB_, (const bf16x8*)(WSP_ + WS_SSMB), (const bf16x8*)(WSP_ + WS_SSMC), (const float*)(WSP_ + WS_SSML), PKP->in[4], (const float*)(WSP_ + WS_SSEG), nullptr, YFP_, nullptr, nullptr, PKP->out + OUT_S, shm + w * 8704, w);
                else ssm_pass<1, true>(l, pr, g, UB_, (const bf16x8*)(WSP_ + WS_SSMB), (const bf16x8*)(WSP_ + WS_SSMC), (const float*)(WSP_ + WS_SSML), PKP->in[4], (const float*)(WSP_ + WS_SSEG), nullptr, (float*)(WSP_ + WS_YB), nullptr, nullptr, PKP->out + OUT_S, shm + w * 8704, w);
                __syncthreads();
                { const int tid = ltid(w); const float* YBp = (const float*)(WSP_ + WS_YB); const float* dsk = PKP->in[21] + l * 512;
#pragma unroll 4
                  for (int i = 0; i < 16; ++i) { const int idx = i * 512 + tid, tk = pr * 512 + (idx >> 4), ch = gq * 64 + (idx & 15) * 4; const size_t o = (size_t)tk * 512 + ch;
                      const u32x2 yfw = *(const u32x2*)((const bf16_t*)YFP_ + o), ybw = *(const u32x2*)((const bf16_t*)YBp + o); const f32x4 dd = *(const f32x4*)(dsk + ch); const u32x2 uw = *(const u32x2*)(UB_ + o);
                      const f32x4 yf = (f32x4){bflo(yfw.x), bfhi(yfw.x), bflo(yfw.y), bfhi(yfw.y)}, yb = (f32x4){bflo(ybw.x), bfhi(ybw.x), bflo(ybw.y), bfhi(ybw.y)};
                      f32x4 v; v[0] = yf[0] + yb[0] + dd[0] * bflo(uw.x); v[1] = yf[1] + yb[1] + dd[1] * bfhi(uw.x); v[2] = yf[2] + yb[2] + dd[2] * bflo(uw.y); v[3] = yf[3] + yb[3] + dd[3] * bfhi(uw.y);
                      const f32x2 ga = gelu_pk((f32x2){v[0], v[1]}), gb = gelu_pk((f32x2){v[2], v[3]});
                      u32x2 pw; pw.x = pk2(ga.x, ga.y); pw.y = pk2(gb.x, gb.y); *(u32x2*)(GB_ + o) = pw; } } }
        }
        GSYNC();
        { EpiGlu E; E.G = GB_; E.bias = PKP->in[23] + l * 512; E.MIX = MIXB_; for (int rep = 0; rep < REP_GLU; ++rep) run_gemm(shm, GB_, (const bf16_t*)(WSP_ + WS_WGLU + l * SZ_WGLU), 512, 512, E, w); }
        GSYNC();
        { EpiRes E; E.xa = XA_; E.xb = XB_; E.xh = l == 0 ? nullptr : XH_; E.Xo = XH_; E.gate = MODSL_ + 2 * 1024; run_gemm(shm, MIXB_, (const bf16_t*)(WSP_ + WS_WOUT + l * SZ_WOUT), 1024, 1024, E, w); }
        GSYNC();
        for (int rep = 0; rep < REP_NORM; ++rep) norm_phase(XA_, XB_, XH_, PKP->in[10] + l * 1024, MODSL_, 6144, 3 * 1024, 4 * 1024, HB_, w);
        GSYNC();
        { EpiFfn1 E; E.ACT = ACTB_; for (int rep = 0; rep < REP_F1; ++rep) run_gemm(shm, HB_, (const bf16_t*)(WSP_ + WS_WF1 + l * SZ_WF1), 5632, 1024, E, w); }
        GSYNC();
        { EpiRes E; E.xa = XA_; E.xb = XB_; E.xh = XH_; E.Xo = XH_; E.gate = MODSL_ + 5 * 1024; run_gemm(shm, ACTB_, (const bf16_t*)(WSP_ + WS_WF2 + l * SZ_WF2), 1024, 2816, E, w); }
        GSYNC();
    }
    final_norm_phase(XH_, XP_, PKP->in[27], w);
}
#undef WSP_
#undef XP_
#undef MODS_
#undef HB_
#undef YFP_
#undef QB_
#undef UB_
#undef MIXB_
#undef GB_
#undef ACTB_
#undef KCTX_
#undef VCTX_
#undef MODSL_
#undef XA_
#undef XH_
#undef XB_
#undef KLAT_
#undef VLAT_

extern "C" void kernel_launch(void* const* d_in, const int* in_sizes, int n_in, void* d_out, int out_size, void* d_ws, size_t ws_size, hipStream_t stream) {
    static int grid_blocks = 0;
    if (grid_blocks == 0) {
        if (n_in < 28 || ws_size < WS_END) { fprintf(stderr, "kernel_launch: need 28 inputs and %zu bytes of workspace (got %d, %zu)\n", (size_t)WS_END, n_in, ws_size); grid_blocks = -1; return; }
        int dev = 0, cus = 0, per_cu = 0;
        (void)hipGetDevice(&dev);
        (void)hipDeviceGetAttribute(&cus, hipDeviceAttributeMultiprocessorCount, dev);
        if (hipFuncSetAttribute((const void*)mega_fwd, hipFuncAttributeMaxDynamicSharedMemorySize, LDS_BYTES) != hipSuccess) fprintf(stderr, "kernel_launch: hipFuncSetAttribute failed\n");
        if (hipOccupancyMaxActiveBlocksPerMultiprocessor(&per_cu, (const void*)mega_fwd, 512, LDS_BYTES) != hipSuccess || per_cu < 1) { per_cu = 1; (void)hipGetLastError(); }
        if (per_cu > 1) per_cu = 1;
        grid_blocks = cus * per_cu;
    }
    if (grid_blocks < 0) return;
    (void)hipMemsetAsync((unsigned char*)d_ws + WS_BAR, 0, SZ_BAR, stream);
    Params p{};
    for (int i = 0; i < 28; ++i) p.in[i] = (const float*)d_in[i];
    p.out = (float*)d_out; p.ws = (unsigned char*)d_ws;
    void* args[] = {&p};
    hipError_t e = hipLaunchCooperativeKernel((const void*)mega_fwd, dim3(grid_blocks), dim3(512), args, LDS_BYTES, stream);
    if (e != hipSuccess) fprintf(stderr, "cooperative launch failed: %s (grid %d)\n", hipGetErrorString(e), grid_blocks);
}
```

```cpp
#include <hip/hip_runtime.h>
#include <hip/hip_cooperative_groups.h>
#include <cstdio>
namespace cg = cooperative_groups;
#define DI __device__ __forceinline__
DI unsigned char* opaque_ptr(unsigned char* p) { asm volatile("" : "+s"(p)); return p; }
DI float shx(float v, int m, int lane) { return __int_as_float(__builtin_amdgcn_ds_bpermute((lane ^ m) << 2, __float_as_int(v))); }
DI int lane_now() { int l; asm volatile("v_mbcnt_lo_u32_b32 %0, -1, 0\n\tv_mbcnt_hi_u32_b32 %0, -1, %0" : "=v"(l)); return l; }
DI int ltid(int wv) { return wv * 64 + lane_now(); }

namespace pg8 {
#define PG8_LAS __attribute__((address_space(3)))
typedef unsigned short bf16_t;
typedef short bf16x8 __attribute__((ext_vector_type(8)));
typedef float f32x4 __attribute__((ext_vector_type(4)));
typedef unsigned u32x4 __attribute__((ext_vector_type(4)));
constexpr int BM = 256, BK = 64, HALF = 128, HTB = HALF * BK * 2  , STAGE_BYTES = 8 * HTB, NXCD = 8, WGM = 1;

__host__ __device__ __forceinline__ int lds_byte(int r, int c) { const int st = (r >> 4) * 2 + (c >> 5), rr = r & 15, cc = c & 31, ob = rr * 64 + cc * 2; return st * 1024 + (ob ^ (((ob >> 9) & 1) << 5)); }
__host__ __device__ __forceinline__ void stage_rc(int b, int& R, int& C) { const int st = b / 1024, sb = b % 1024, swz = sb ^ (((sb >> 9) & 1) << 5); R = (st >> 1) * 16 + swz / 64; C = (st & 1) * 32 + (swz % 64) / 2; }
__host__ __device__ __forceinline__ int perm32(int rho) { const int n = rho >> 4, i = rho & 15; return 8 * (i >> 2) + 4 * n + (i & 3); }

struct Unit { int pm, pn; };
struct Gemm { const bf16_t* A; const bf16_t* Bt; int M, N, K; };

struct StaticOrder {
    int nM, nN, nwg, G, c;
    __host__ __device__ void init(int M, int N, int G_, int c_) { nM = M / BM; nN = N / BM; nwg = nM * nN; G = G_; c = c_; }
    __host__ __device__ bool next(int i, Unit& u) const {
        const long L = (long)i * G + c; if (L >= nwg) return false;
        int wgid = (int)L; { const int q = nwg / NXCD, r = nwg % NXCD, xcd = wgid % NXCD, off = wgid / NXCD; wgid = (xcd < r ? xcd * (q + 1) : r * (q + 1) + (xcd - r) * q) + off; }
        const int nig = WGM * nN, gid = wgid / nig, fm = gid * WGM, gsz = (nM - fm) < WGM ? (nM - fm) : WGM;
        u.pm = fm + ((wgid % nig) % gsz); u.pn = (wgid % nig) / gsz; return true;
    }
    __device__ __forceinline__ void a_ready(const Unit&) const {}
    __device__ __forceinline__ void done(const Unit&) const {}
};

template <class Epi, class Sched, bool STAMP = false>
__device__ __forceinline__ void gemm_phase(PG8_LAS unsigned char* lds, const Gemm g, const Sched& S, const Epi& E, unsigned long long* stamps, int wv) {
    int tid_l; asm volatile("v_mbcnt_lo_u32_b32 %0, -1, 0\n\tv_mbcnt_hi_u32_b32 %0, -1, %0" : "=v"(tid_l)); tid_l += wv * 64;
    const int tid = tid_l, wid = __builtin_amdgcn_readfirstlane(tid >> 6), lane = tid & 63, wr = wid >> 2, wc = wid & 3, fr = lane & 15, fq = lane >> 4;
    const int K = g.K, nt = K / BK;
    int ts_lo = 0, ts_hi = 0, nts = 0; const unsigned long long rt_entry = STAMP ? (unsigned long long)wall_clock64() : 0ull;
#define PG8_STAMP() do { if (STAMP && wid == 0 && nts < 64) { const unsigned long long _c = (unsigned long long)clock64(); \
        ts_lo = (lane == nts) ? (int)(unsigned)_c : ts_lo; ts_hi = (lane == nts) ? (int)(unsigned)(_c >> 32) : ts_hi; ++nts; } } while (0)
    PG8_STAMP();
    unsigned voffA[2], voffB[2];
#pragma unroll
    for (int i = 0; i < 2; ++i) { int R, C; stage_rc(tid * 16 + i * 8192, R, C); const int Rb = Epi::PERM ? ((R & ~31) + perm32(R & 31)) : R;
        voffA[i] = (unsigned)(R * K + C) * 2u; voffB[i] = (unsigned)(Rb * K + C) * 2u; }
    const size_t kstep = (size_t)(BK * 2);
    const size_t hstep = (size_t)HALF * K * 2;
    const size_t tstep = 2 * hstep;
    const unsigned ldsw = (unsigned)wid * 1024u;
    const int aoff = lds_byte(wr * 64 + fr, fq * 8), boff = lds_byte(wc * 32 + fr, fq * 8);
#define PG8_SA(b, h) (((b) * 2 + (h)) * HTB)
#define PG8_SB(b, h) ((4 + (b) * 2 + (h)) * HTB)
#define PG8_STAGE(bufoff, gbase, voff) do { _Pragma("unroll") for (int _i = 0; _i < 2; ++_i) \
        __builtin_amdgcn_global_load_lds((const unsigned*)((const char*)(gbase) + (voff)[_i]), (PG8_LAS unsigned*)(lds + (bufoff) + ldsw + _i * 8192), 16, 0, 0); } while (0)
#define PG8_LDA(dst, b, h) do { _Pragma("unroll") for (int m = 0; m < 4; ++m) _Pragma("unroll") for (int k = 0; k < 2; ++k) dst[m][k] = *(const PG8_LAS bf16x8*)(lds + PG8_SA(b, h) + aoff + m * 2048 + k * 1024); } while (0)
#define PG8_LDB(dst, b, h) do { _Pragma("unroll") for (int n = 0; n < 2; ++n) _Pragma("unroll") for (int k = 0; k < 2; ++k) dst[n][k] = *(const PG8_LAS bf16x8*)(lds + PG8_SB(b, h) + boff + n * 2048 + k * 1024); } while (0)
#define PG8_MMA(ai, bj, At, Bt) do { __builtin_amdgcn_s_setprio(1); _Pragma("unroll") for (int m = 0; m < 4; ++m) _Pragma("unroll") for (int n = 0; n < 2; ++n) _Pragma("unroll") for (int k = 0; k < 2; ++k) \
        acc[ai][bj][m][n] = __builtin_amdgcn_mfma_f32_16x16x32_bf16(Bt[n][k], At[m][k], acc[ai][bj][m][n], 0, 0, 0); __builtin_amdgcn_s_setprio(0); } while (0)
#define PG8_WAIT_V(n) asm volatile("s_waitcnt vmcnt(" #n ")" ::: "memory")
#define PG8_WAIT_L(n) asm volatile("s_waitcnt lgkmcnt(" #n ")" ::: "memory")
#define PG8_BAR __builtin_amdgcn_s_barrier()
#define PG8_SCHED __builtin_amdgcn_sched_barrier(0)
    Unit cur, nxt; int ui = 0;
    if (!S.next(0, cur)) return;
    f32x4 acc[2][2][4][2];
#pragma unroll
    for (int a = 0; a < 2; ++a)
#pragma unroll
        for (int b = 0; b < 2; ++b)
#pragma unroll
            for (int m = 0; m < 4; ++m)
#pragma unroll
                for (int n = 0; n < 2; ++n) acc[a][b][m][n] = (f32x4){0.f, 0.f, 0.f, 0.f};
    bf16x8 At[4][2], B0[2][2], B1[2][2];
    const char* cA = (const char*)g.A + (size_t)cur.pm * tstep; const char* cB = (const char*)g.Bt + (size_t)cur.pn * tstep;
    S.a_ready(cur);
    PG8_STAGE(PG8_SB(0, 0), cB, voffB); PG8_STAGE(PG8_SA(0, 0), cA, voffA); PG8_STAGE(PG8_SB(0, 1), cB + hstep, voffB); PG8_STAGE(PG8_SA(0, 1), cA + hstep, voffA);
    if (wr == 1) PG8_BAR;
    PG8_WAIT_V(4); PG8_BAR;
    PG8_STAGE(PG8_SB(1, 0), cB + kstep, voffB); PG8_STAGE(PG8_SA(1, 0), cA + kstep, voffA); PG8_STAGE(PG8_SB(1, 1), cB + hstep + kstep, voffB);
    PG8_WAIT_V(6); PG8_BAR;
    PG8_STAMP();
    for (;;) {
        const bool has_next = S.next(ui + 1, nxt);
        const char* nA = has_next ? (const char*)g.A + (size_t)nxt.pm * tstep : cA; const char* nB = has_next ? (const char*)g.Bt + (size_t)nxt.pn * tstep : cB;
        for (int t = 0; t < nt; t += 2) {
            const bool last = (t == nt - 2);
            const char* a1 = cA + (size_t)(t + 1) * kstep;
            const char* a2 = last ? nA : cA + (size_t)(t + 2) * kstep; const char* b2 = last ? nB : cB + (size_t)(t + 2) * kstep;
            const char* a3 = a2 + kstep; const char* b3 = b2 + kstep;
            if (last && has_next) S.a_ready(nxt);
            PG8_LDB(B0, 0, 0); PG8_SCHED; PG8_LDA(At, 0, 0); PG8_STAGE(PG8_SA(1, 1), a1 + hstep, voffA);
            PG8_WAIT_L(8); PG8_BAR; PG8_WAIT_L(0); PG8_MMA(0, 0, At, B0); PG8_BAR; PG8_SCHED;
            PG8_LDB(B1, 0, 1); PG8_STAGE(PG8_SB(0, 0), b2, voffB);
            PG8_BAR; PG8_WAIT_L(0); PG8_MMA(0, 1, At, B1); PG8_BAR;
            PG8_LDA(At, 0, 1); PG8_STAGE(PG8_SA(0, 0), a2, voffA);
            PG8_BAR; PG8_WAIT_L(0); PG8_MMA(1, 0, At, B0); PG8_BAR; PG8_SCHED;
            PG8_STAGE(PG8_SB(0, 1), b2 + hstep, voffB);
            PG8_WAIT_V(6); PG8_BAR; PG8_MMA(1, 1, At, B1); PG8_BAR;
            PG8_LDB(B0, 1, 0); PG8_SCHED; PG8_LDA(At, 1, 0); PG8_STAGE(PG8_SA(0, 1), a2 + hstep, voffA);
            PG8_WAIT_L(8); PG8_BAR; PG8_WAIT_L(0); PG8_MMA(0, 0, At, B0); PG8_BAR; PG8_SCHED;
            PG8_LDB(B1, 1, 1); PG8_STAGE(PG8_SB(1, 0), b3, voffB);
            PG8_BAR; PG8_WAIT_L(0); PG8_MMA(0, 1, At, B1); PG8_BAR;
            PG8_LDA(At, 1, 1); PG8_STAGE(PG8_SA(1, 0), a3, voffA);
            PG8_BAR; PG8_WAIT_L(0); PG8_MMA(1, 0, At, B0); PG8_BAR; PG8_SCHED;
            PG8_STAGE(PG8_SB(1, 1), b3 + hstep, voffB);
            PG8_WAIT_V(6); PG8_BAR; PG8_MMA(1, 1, At, B1); PG8_BAR;
        }
        PG8_STAMP();
        if constexpr (!Epi::AFTER_DRAIN) { E(acc, cur, wr, wc, fr, fq); S.done(cur); }
        PG8_STAMP();
        if (!has_next) break;
#pragma unroll
        for (int a = 0; a < 2; ++a)
#pragma unroll
            for (int b = 0; b < 2; ++b)
#pragma unroll
                for (int m = 0; m < 4; ++m)
#pragma unroll
                    for (int n = 0; n < 2; ++n) acc[a][b][m][n] = (f32x4){0.f, 0.f, 0.f, 0.f};
        cur = nxt; cA = nA; cB = nB; ++ui;
    }
    PG8_WAIT_V(0);
    if (wr == 0) PG8_BAR;
    PG8_BAR;
    if constexpr (Epi::AFTER_DRAIN) { E.fused(acc, cur, wr, wc, fr, fq, lds, wid, lane); S.done(cur); }
    PG8_STAMP();
    if (STAMP && wid == 0) { stamps[lane] = lane < nts ? (((unsigned long long)(unsigned)ts_hi << 32) | (unsigned)ts_lo) : 0ull;
        if (lane == 62) stamps[62] = rt_entry; if (lane == 63) stamps[63] = (unsigned long long)wall_clock64(); }
#undef PG8_STAMP
#undef PG8_SA
#undef PG8_SB
#undef PG8_STAGE
#undef PG8_LDA
#undef PG8_LDB
#undef PG8_MMA
#undef PG8_WAIT_V
#undef PG8_WAIT_L
#undef PG8_BAR
#undef PG8_SCHED
}
}

typedef unsigned short bf16_t;
typedef short bf16x8 __attribute__((ext_vector_type(8)));
typedef short s16x4 __attribute__((ext_vector_type(4)));
typedef float f32x4 __attribute__((ext_vector_type(4)));
typedef float f32x2 __attribute__((ext_vector_type(2)));
typedef float f32x16 __attribute__((ext_vector_type(16)));
typedef unsigned u32x4 __attribute__((ext_vector_type(4)));
typedef unsigned u32x2 __attribute__((ext_vector_type(2)));
typedef __bf16 bf16x2_t __attribute__((ext_vector_type(2)));

constexpr int NTOK = 16384, DM = 1024, NCTX = 8192;
constexpr size_t SZ_WIN = (size_t)1280 * 1024 * 2, SZ_WGLU = (size_t)512 * 512 * 2, SZ_WOUT = (size_t)1024 * 1024 * 2, SZ_WF1 = (size_t)5632 * 1024 * 2, SZ_WF2 = (size_t)1024 * 2816 * 2;
constexpr size_t WS_WIN = 0, WS_WGLU = WS_WIN + 2 * SZ_WIN, WS_WOUT = WS_WGLU + 2 * SZ_WGLU, WS_WF1 = WS_WOUT + 2 * SZ_WOUT, WS_WF2 = WS_WF1 + 2 * SZ_WF1;
constexpr size_t WS_H = WS_WF2 + 2 * SZ_WF2;
constexpr size_t WS_Q = WS_H + (size_t)NTOK * 1024 * 2;
constexpr size_t WS_U = WS_Q + (size_t)NTOK * 512 * 2;
constexpr size_t WS_MIX = WS_U + (size_t)NTOK * 512 * 2;
constexpr size_t WS_G = WS_MIX + (size_t)NTOK * 1024 * 2;
constexpr size_t WS_ACT = WS_Q;
constexpr size_t WS_KLAT = WS_ACT + (size_t)NTOK * 2816 * 2;
constexpr size_t SZ_KLAT = (size_t)4 * 2 * 2560 * 64 * 2;
constexpr size_t WS_VLAT = WS_KLAT + 2 * SZ_KLAT;
constexpr size_t WS_KCTX = WS_VLAT + 2 * SZ_KLAT;
constexpr size_t SZ_KCTX = (size_t)32 * 2 * 256 * 64 * 2;
constexpr size_t WS_VCTX = WS_KCTX + SZ_KCTX;
constexpr size_t WS_MODS = WS_VCTX + SZ_KCTX;
constexpr size_t SZ_MODS = (size_t)2 * 5 * 6144 * 4;
constexpr size_t WS_BAR = WS_MODS + SZ_MODS;
constexpr size_t SZ_BAR = (size_t)3456 * 4;
constexpr size_t WS_ROPEC = WS_BAR + SZ_BAR;
constexpr size_t WS_ROPES = WS_ROPEC + (size_t)2048 * 32 * 4;
constexpr size_t WS_SSMB = WS_ROPES + (size_t)2048 * 32 * 4;
constexpr size_t WS_SSMC = WS_SSMB + (size_t)128 * 4096;
constexpr size_t WS_SSML = WS_SSMC + (size_t)128 * 4096;
constexpr size_t WS_SSEG = WS_SSML + (size_t)128 * 512;
constexpr size_t WS_YB = WS_SSEG + (size_t)32 * 2 * 32 * 64 * 2 * 4;
constexpr size_t WS_MODP = WS_YB + (size_t)NTOK * 512 * 4;
constexpr size_t WS_XB = WS_MODP + (size_t)4 * 61440 * 4;
constexpr size_t WS_END = WS_XB + (size_t)NTOK * 1024 * 2;
constexpr size_t OUT_K = (size_t)2 * 8388608, OUT_V = OUT_K + 2097152, OUT_S = OUT_V + 2097152;
constexpr int LDS_BYTES = 131072 + 16;

#ifndef REP_NORM
#define REP_NORM 1
#endif
#ifndef REP_IN
#define REP_IN 1
#endif
#ifndef REP_ATT3
#define REP_ATT3 1
#endif
#ifndef REP_ATT4
#define REP_ATT4 1
#endif
#ifndef REP_GLU
#define REP_GLU 1
#endif
#ifndef REP_F1
#define REP_F1 1
#endif
#ifndef REP_P0
#define REP_P0 1
#endif
struct Params { const float* in[28]; float* out; unsigned char* ws; };

DI unsigned pk2(float lo, float hi) { f32x2 v = {lo, hi}; return __builtin_bit_cast(unsigned, __builtin_convertvector(v, bf16x2_t)); }
DI float bf2f(bf16_t b) { return __uint_as_float(((unsigned)b) << 16); }
DI float bflo(unsigned w) { return __uint_as_float(w << 16); }
DI float bfhi(unsigned w) { return __uint_as_float(w & 0xffff0000u); }
DI bf16x8 pack8(float a0, float a1, float a2, float a3, float a4, float a5, float a6, float a7) {
    u32x4 p; p.x = pk2(a0, a1); p.y = pk2(a2, a3); p.z = pk2(a4, a5); p.w = pk2(a6, a7); return __builtin_bit_cast(bf16x8, p); }
DI f32x16 mfma32(bf16x8 a, bf16x8 b, f32x16 c) { return __builtin_amdgcn_mfma_f32_32x32x16_bf16(a, b, c, 0, 0, 0); }
DI f32x16 mfma32p(bf16x8 a, bf16x8 b, f32x16 c) { __builtin_amdgcn_s_setprio(1); f32x16 r = __builtin_amdgcn_mfma_f32_32x32x16_bf16(a, b, c, 0, 0, 0); __builtin_amdgcn_s_setprio(0); return r; }
DI f32x4 mfma16(bf16x8 a, bf16x8 b, f32x4 c) { return __builtin_amdgcn_mfma_f32_16x16x32_bf16(a, b, c, 0, 0, 0); }
DI f32x2 gelu_pk(f32x2 v) {
    const f32x2 av = __builtin_elementwise_abs(v), d = av * 0.2316418882f + 1.0f;
    f32x2 t; t.x = __builtin_amdgcn_rcpf(d.x); t.y = __builtin_amdgcn_rcpf(d.y);
    f32x2 q = t * 0.5307027145f + (-0.7265760135f); q = q * t + 0.7107068705f; q = q * t + (-0.142248368f); q = q * t + 0.127414796f; q = q * t;
    const f32x2 sq = (v * v) * (-0.72134752044f);
    f32x2 e; e.x = __builtin_amdgcn_exp2f(sq.x); e.y = __builtin_amdgcn_exp2f(sq.y);
    const f32x2 m = v * (q * e), r = v - m;
    f32x2 o; o.x = v.x < 0.f ? m.x : r.x; o.y = v.y < 0.f ? m.y : r.y; return o;
}
#define GAS __attribute__((address_space(1)))
DI u32x2 ldg8(const void* p) { return *(const GAS u32x2*)p; }
DI u32x4 ldg16(const void* p) { return *(const GAS u32x4*)p; }
DI f32x4 ldg16f(const void* p) { return *(const GAS f32x4*)p; }
DI f32x2 ldg8f(const void* p) { return *(const GAS f32x2*)p; }
DI void stg8(void* p, u32x2 v) { *(GAS u32x2*)p = v; }
DI void stg16(void* p, u32x4 v) { *(GAS u32x4*)p = v; }
DI void stg16f(void* p, f32x4 v) { *(GAS f32x4*)p = v; }
DI float sigmoidf_(float x) { return __builtin_amdgcn_rcpf(1.0f + __expf(-x)); }

DI void tconv_tile(const float* __restrict__ src, size_t sld, int ca, int cb, bf16_t* __restrict__ dst, size_t dld, float* lds, int wv) {
    const int tid = ltid(wv);
#pragma unroll
    for (int i = 0; i < 8; ++i) { const int idx = i * 512 + tid, kk = idx >> 6, nn = idx & 63; const int col = nn < 32 ? ca + nn : cb + nn - 32;
        lds[nn * 65 + kk] = src[(size_t)kk * sld + col]; }
    __syncthreads();
    { const int nn = tid >> 3, k8 = (tid & 7) * 8; const float* r = lds + nn * 65 + k8;
      u32x4 w; w.x = pk2(r[0], r[1]); w.y = pk2(r[2], r[3]); w.z = pk2(r[4], r[5]); w.w = pk2(r[6], r[7]);
      *(u32x4*)(dst + (size_t)nn * dld + k8) = w; }
    __syncthreads();
}
DI int srccol_in(int np) { const int pn = np >> 8, cpos = np & 255, bj = cpos >> 7, wc = (cpos >> 5) & 3, w = cpos & 31; return pn * 256 + wc * 64 + bj * 32 + w; }
DI int srccol_f1(int np) { const int tile = np >> 8, bj = (np >> 7) & 1, i = np & 127; return bj * 2816 + tile * 128 + i; }

struct TcArgs { const float* src; size_t sld; int ca, cb; bf16_t* dst; size_t dld; };
DI TcArgs wconv_args(const Params& P, int t) {
    const int l = t / 2752; int r = t % 2752; unsigned char* ws = P.ws; TcArgs a;
    if (r < 320) { const int kt = r & 15, ntl = r >> 4, n0 = ntl * 64, k0 = kt * 64;
        a.src = P.in[11] + ((size_t)l * 1024 + k0) * 1280; a.sld = 1280; a.ca = srccol_in(n0); a.cb = srccol_in(n0 + 32); a.dst = (bf16_t*)(ws + WS_WIN + l * SZ_WIN) + (size_t)n0 * 1024 + k0; a.dld = 1024; return a; }
    r -= 320;
    if (r < 64) { const int kt = r & 7, ntl = r >> 3, n0 = ntl * 64, k0 = kt * 64;
        a.src = P.in[22] + ((size_t)l * 512 + k0) * 512; a.sld = 512; a.ca = n0; a.cb = n0 + 32; a.dst = (bf16_t*)(ws + WS_WGLU + l * SZ_WGLU) + (size_t)n0 * 512 + k0; a.dld = 512; return a; }
    r -= 64;
    if (r < 256) { const int kt = r & 15, ntl = r >> 4, n0 = ntl * 64, k0 = kt * 64;
        a.src = P.in[24] + ((size_t)l * 1024 + k0) * 1024; a.sld = 1024; a.ca = n0; a.cb = n0 + 32; a.dst = (bf16_t*)(ws + WS_WOUT + l * SZ_WOUT) + (size_t)n0 * 1024 + k0; a.dld = 1024; return a; }
    r -= 256;
    if (r < 1408) { const int kt = r & 15, ntl = r >> 4, n0 = ntl * 64, k0 = kt * 64;
        a.src = P.in[25] + ((size_t)l * 1024 + k0) * 5632; a.sld = 5632; a.ca = srccol_f1(n0); a.cb = srccol_f1(n0 + 32); a.dst = (bf16_t*)(ws + WS_WF1 + l * SZ_WF1) + (size_t)n0 * 1024 + k0; a.dld = 1024; return a; }
    r -= 1408;
    { const int kt = r % 44, ntl = r / 44, n0 = ntl * 64, k0 = kt * 64;
        a.src = P.in[26] + ((size_t)l * 2816 + k0) * 1024; a.sld = 1024; a.ca = n0; a.cb = n0 + 32; a.dst = (bf16_t*)(ws + WS_WF2 + l * SZ_WF2) + (size_t)n0 * 2816 + k0; a.dld = 2816; return a; }
}
DI void tc_load(const TcArgs& a, float (&v)[8], int tid) {
#pragma unroll
    for (int i = 0; i < 8; ++i) { const int idx = i * 512 + tid, kk = idx >> 6, nn = idx & 63; const int col = nn < 32 ? a.ca + nn : a.cb + nn - 32;
        v[i] = *(const GAS float*)(a.src + (size_t)kk * a.sld + col); }
}
DI void tc_store(const TcArgs& a, const float (&v)[8], float* lds, int tid) {
#pragma unroll
    for (int i = 0; i < 8; ++i) { const int idx = i * 512 + tid, kk = idx >> 6, nn = idx & 63; lds[nn * 65 + kk] = v[i]; }
    __syncthreads();
    { const int nn = tid >> 3, k8 = (tid & 7) * 8; const float* r = lds + nn * 65 + k8;
      u32x4 w; w.x = pk2(r[0], r[1]); w.y = pk2(r[2], r[3]); w.z = pk2(r[4], r[5]); w.w = pk2(r[6], r[7]);
      stg16(a.dst + (size_t)nn * a.dld + k8, w); }
    __syncthreads();
}
DI void wconv_all(const Params& P, float* lds, int wv, int ntiles) {
    const int tid = ltid(wv);
    int t = blockIdx.x; if (t >= ntiles) return;
    TcArgs A = wconv_args(P, t); float va[8]; tc_load(A, va, tid);
    for (;;) { const int tn = t + gridDim.x; const bool more = tn < ntiles;
        TcArgs B = A; float vb[8];
#pragma unroll
        for (int i = 0; i < 8; ++i) vb[i] = 0.f;
        if (more) { B = wconv_args(P, tn); tc_load(B, vb, tid); }
        tc_store(A, va, lds, tid);
        if (!more) break;
        A = B;
#pragma unroll
        for (int i = 0; i < 8; ++i) va[i] = vb[i];
        t = tn; }
}

DI void adaln_task(const Params& P, int task, float* lds, int wv) {
    const int tid = ltid(wv), w = tid >> 6, lane = tid & 63;
    const int kc = task & 3, cgp = (task >> 2) % 24, l = task / 96;
    const int n = cgp * 256 + lane * 4;
    const int k0 = kc * 256 + w * 32;
    const float* wm = P.in[7] + ((size_t)l * 1024 + k0) * 6144 + n;
    const float* cc = P.in[5]; const float* cx = P.in[6];
    f32x4 wrow[32];
#pragma unroll
    for (int kk = 0; kk < 32; ++kk) wrow[kk] = *(const f32x4*)(wm + (size_t)kk * 6144);
    f32x4 acc[5];
#pragma unroll
    for (int j = 0; j < 5; ++j) acc[j] = (f32x4){0.f, 0.f, 0.f, 0.f};
#pragma unroll
    for (int kk = 0; kk < 32; ++kk) { const int k = k0 + kk;
#pragma unroll
        for (int j = 0; j < 5; ++j) { const float cv = (j == 0) ? cx[k] : cc[(j - 1) * 1024 + k]; const float sv = cv / (1.0f + __expf(-cv)); acc[j] += wrow[kk] * sv; } }
#pragma unroll
    for (int j = 0; j < 5; ++j) *(f32x4*)(lds + (w * 5 + j) * 256 + lane * 4) = acc[j];
    __syncthreads();
    float* part = (float*)(P.ws + WS_MODP) + (size_t)kc * 61440;
    for (int e = tid; e < 1280; e += 512) { const int j = e >> 8, col = e & 255; float sm = 0.f;
#pragma unroll
        for (int ww = 0; ww < 8; ++ww) sm += lds[(ww * 5 + j) * 256 + col];
        part[(l * 5 + j) * 6144 + cgp * 256 + col] = sm; }
    __syncthreads();
}

DI void ssmconst_task(const Params& P, int task, int wv) {
    const int idx = task * 512 + ltid(wv); const int p = idx & 63, ldg = idx >> 6;
    const double dt = exp((double)P.in[16][ldg]); const double ar = (double)P.in[14][ldg * 64 + p], ai = (double)P.in[15][ldg * 64 + p];
    const double mag = exp(ar * dt); double sn, cs; sincos(ai * dt, &sn, &cs);
    const double lr = mag * cs, li = mag * sn, den = ar * ar + ai * ai;
    const double zr = ((lr - 1.0) * ar + li * ai) / den, zi = (li * ar - (lr - 1.0) * ai) / den;
    float* lam = (float*)(P.ws + WS_SSML); lam[(ldg * 64 + p) * 2] = (float)lr; lam[(ldg * 64 + p) * 2 + 1] = (float)li;
    bf16_t* Bm = (bf16_t*)(P.ws + WS_SSMB); bf16_t* Cm = (bf16_t*)(P.ws + WS_SSMC);
    const float* bre = P.in[17] + ((size_t)ldg * 64 + p) * 16; const float* bim = P.in[18] + ((size_t)ldg * 64 + p) * 16;
    const int ntb = (p >= 32) ? 2 : 0;
    for (int h = 0; h < 16; ++h) { const double br = bre[h], bi = bim[h]; const float bbr = (float)(zr * br - zi * bi), bbi = (float)(zr * bi + zi * br);
        const int ln = (p & 31) + 32 * (h >> 3), j = h & 7;
        Bm[(((size_t)ldg * 4 + ntb) * 64 + ln) * 8 + j] = (bf16_t)(pk2(bbr, 0.f) & 0xffffu);
        Bm[(((size_t)ldg * 4 + ntb + 1) * 64 + ln) * 8 + j] = (bf16_t)(pk2(bbi, 0.f) & 0xffffu); }
    for (int hp = 0; hp < 16; ++hp) { const float cr = P.in[19][((size_t)ldg * 16 + hp) * 64 + p], ci = P.in[20][((size_t)ldg * 16 + hp) * 64 + p];
#pragma unroll
        for (int ri = 0; ri < 2; ++ri) { const int pp = 2 * p + ri, ks = pp >> 5, kq = (pp >> 3) & 3, j = pp & 7;
            Cm[(((size_t)ldg * 4 + ks) * 64 + kq * 16 + hp) * 8 + j] = (bf16_t)(pk2(ri ? -ci : cr, 0.f) & 0xffffu); } }
}

DI void phase0(const Params& P, unsigned char* shm, int wv) {
    float* lds = (float*)shm;
    constexpr int T_ADA = 192, T_W = 5504, T_V = 128, T_K = 128, T_S = 16, T_R = 128;
    constexpr int T_TOTAL = T_ADA + T_V + T_K + T_S + T_R;
    for (int rep = 0; rep < REP_P0; ++rep)
    for (int t = blockIdx.x; t < T_TOTAL; t += gridDim.x) {
        int r = t;
        if (r < T_ADA) { adaln_task(P, r, lds, wv); continue; }
        r -= T_ADA;
        if (r < T_V) { const int s8 = r & 7, kvh = (r >> 3) & 1, b = (r >> 4) & 3, l = r >> 6;
            tconv_tile(P.in[3] + (((size_t)(b * 2 + l) * 512 + s8 * 64) * 2 + kvh) * 64, 128, 0, 32,
                       (bf16_t*)(P.ws + WS_VLAT + l * SZ_KLAT) + ((size_t)(b * 2 + kvh) * 64) * 2560 + s8 * 64, 2560, lds, wv); continue; }
        r -= T_V;
        if (r < T_K) { const int idx = r * 4096 + ltid(wv) * 8; const int d = idx & 63, s = (idx >> 6) & 511, kvh = (idx >> 15) & 1, b = (idx >> 16) & 3, l = idx >> 18;
            const float* src = P.in[2] + ((((size_t)(b * 2 + l) * 512 + s) * 2 + kvh) * 64 + d);
            const f32x4 a = *(const f32x4*)src, c = *(const f32x4*)(src + 4);
            u32x4 w; w.x = pk2(a[0], a[1]); w.y = pk2(a[2], a[3]); w.z = pk2(c[0], c[1]); w.w = pk2(c[2], c[3]);
            *(u32x4*)((bf16_t*)(P.ws + WS_KLAT + l * SZ_KLAT) + ((size_t)(b * 2 + kvh) * 2560 + s) * 64 + d) = w; continue; }
        r -= T_K;
        if (r < T_S) { ssmconst_task(P, r, wv); continue; }
        r -= T_S;
        { const int idx = r * 512 + ltid(wv); const int tt = idx >> 5, i = idx & 31; const int pos = (i < 16) ? (tt >> 6) : (tt & 63); const int f = i & 15;
          const double inv = pow(10000.0, -(2.0 * f) / 32.0); double sn, cs; sincos((double)pos * inv, &sn, &cs);
          ((float*)(P.ws + WS_ROPEC))[idx] = (float)cs; ((float*)(P.ws + WS_ROPES))[idx] = (float)sn; }
    }
    __syncthreads();
    wconv_all(P, lds, wv, T_W);
}

DI float wave_sum(float v, int lane) {
    v += shx(v, 32, lane); v += shx(v, 16, lane); v += shx(v, 8, lane); v += shx(v, 4, lane); v += shx(v, 2, lane); v += shx(v, 1, lane); return v; }

DI void norm_phase(const float* __restrict__ xa, const float* __restrict__ xb, const bf16_t* __restrict__ xh, const float* __restrict__ gw, const float* mbase, int jstride, int sh_off, int sc_off, bf16_t* __restrict__ H, int wv) {
    const int tidl = ltid(wv); const int lane = tidl & 63, w = tidl >> 6;
    for (int base = (blockIdx.x * 8 + w) * 8; base < NTOK; base += gridDim.x * 64) {
        const int j = base < NCTX ? 0 : 1 + ((base - NCTX) >> 11);
        f32x4 wv4[4], sh4[4];
#pragma unroll
        for (int i = 0; i < 4; ++i) { const int col = i * 256 + lane * 4;
            const f32x4 g4 = ldg16f(gw + col), sc = *(const f32x4*)(mbase + j * jstride + sc_off + col); sh4[i] = *(const f32x4*)(mbase + j * jstride + sh_off + col); wv4[i] = g4 * (sc + 1.0f); }
#pragma unroll
        for (int hb = 0; hb < 2; ++hb) {
            f32x4 v[4][4]; float ss[4];
            if (xh) { u32x2 t[4][4];
#pragma unroll
                for (int r = 0; r < 4; ++r)
#pragma unroll
                    for (int i = 0; i < 4; ++i) t[r][i] = ldg8(xh + (size_t)(base + hb * 4 + r) * 1024 + i * 256 + lane * 4);
#pragma unroll
                for (int r = 0; r < 4; ++r)
#pragma unroll
                    for (int i = 0; i < 4; ++i) v[r][i] = (f32x4){bflo(t[r][i].x), bfhi(t[r][i].x), bflo(t[r][i].y), bfhi(t[r][i].y)};
            } else { const float* xr = base < NCTX ? xa + (size_t)(base + hb * 4) * 1024 : xb + (size_t)(base + hb * 4 - NCTX) * 1024;
#pragma unroll
                for (int r = 0; r < 4; ++r)
#pragma unroll
                    for (int i = 0; i < 4; ++i) v[r][i] = ldg16f(xr + (size_t)r * 1024 + i * 256 + lane * 4); }
#pragma unroll
            for (int r = 0; r < 4; ++r) { float a = 0.f;
#pragma unroll
                for (int i = 0; i < 4; ++i) a += v[r][i][0] * v[r][i][0] + v[r][i][1] * v[r][i][1] + v[r][i][2] * v[r][i][2] + v[r][i][3] * v[r][i][3];
                ss[r] = a; }
#pragma unroll
            for (int mk = 32; mk >= 1; mk >>= 1)
#pragma unroll
                for (int r = 0; r < 4; ++r) ss[r] += shx(ss[r], mk, lane);
#pragma unroll
            for (int r = 0; r < 4; ++r) { const float rstd = rsqrtf(ss[r] * (1.0f / 1024.0f) + 1e-6f);
#pragma unroll
                for (int i = 0; i < 4; ++i) { const f32x4 o = v[r][i] * rstd * wv4[i] + sh4[i];
                    u32x2 pw; pw.x = pk2(o[0], o[1]); pw.y = pk2(o[2], o[3]); stg8(H + (size_t)(base + hb * 4 + r) * 1024 + i * 256 + lane * 4, pw); } }
        }
    }
}

DI void final_norm_phase(const bf16_t* __restrict__ xh, float* __restrict__ Y, const float* __restrict__ gw, int wv) {
    const int tidl = ltid(wv); const int lane = tidl & 63, w = tidl >> 6;
    for (int base = (blockIdx.x * 8 + w) * 8; base < NTOK; base += gridDim.x * 64) {
        f32x4 g4[4];
#pragma unroll
        for (int i = 0; i < 4; ++i) g4[i] = ldg16f(gw + i * 256 + lane * 4);
#pragma unroll
        for (int hb = 0; hb < 2; ++hb) {
            u32x2 t[4][4]; float ss[4];
#pragma unroll
            for (int r = 0; r < 4; ++r)
#pragma unroll
                for (int i = 0; i < 4; ++i) t[r][i] = ldg8(xh + (size_t)(base + hb * 4 + r) * 1024 + i * 256 + lane * 4);
            f32x4 v[4][4];
#pragma unroll
            for (int r = 0; r < 4; ++r) { float a = 0.f;
#pragma unroll
                for (int i = 0; i < 4; ++i) { v[r][i] = (f32x4){bflo(t[r][i].x), bfhi(t[r][i].x), bflo(t[r][i].y), bfhi(t[r][i].y)}; a += v[r][i][0] * v[r][i][0] + v[r][i][1] * v[r][i][1] + v[r][i][2] * v[r][i][2] + v[r][i][3] * v[r][i][3]; }
                ss[r] = a; }
#pragma unroll
            for (int mk = 32; mk >= 1; mk >>= 1)
#pragma unroll
                for (int r = 0; r < 4; ++r) ss[r] += shx(ss[r], mk, lane);
#pragma unroll
            for (int r = 0; r < 4; ++r) { const float rstd = rsqrtf(ss[r] * (1.0f / 1024.0f) + 1e-6f);
#pragma unroll
                for (int i = 0; i < 4; ++i) stg16f(Y + (size_t)(base + hb * 4 + r) * 1024 + i * 256 + lane * 4, v[r][i] * rstd * g4[i]); }
        }
    }
}

struct EpiIn {
    static constexpr bool PERM = false, AFTER_DRAIN = false;
    int layer; const float* qn; const float* kn; const float* ropec; const float* ropes;
    bf16_t* Q; bf16_t* U; bf16_t* Kctx; bf16_t* Vctx; bf16_t* Klat; bf16_t* Vlat; float* outk; float* outv;
    DI void operator()(const f32x4 (&acc)[2][2][4][2], const pg8::Unit& u, int wr, int wc, int fr, int fq) const {
        asm volatile("" : "+v"(fr), "+v"(fq));
        const bool lat = u.pm >= 32; const int pn = u.pn;
        if (pn >= 3) {
#pragma unroll
            for (int ai = 0; ai < 2; ++ai)
#pragma unroll
                for (int m = 0; m < 4; ++m) { const int row = u.pm * 256 + ai * 128 + wr * 64 + m * 16 + fr;
#pragma unroll
                    for (int bj = 0; bj < 2; ++bj)
#pragma unroll
                        for (int n = 0; n < 2; ++n) { const int col = (pn - 3) * 256 + 64 * wc + 32 * bj + 16 * n + 4 * fq; const f32x4 a = acc[ai][bj][m][n];
                            u32x2 pw; pw.x = pk2(a[0], a[1]); pw.y = pk2(a[2], a[3]); *(u32x2*)(U + (size_t)row * 512 + col) = pw; } }
            return;
        }
        if (pn == 2 && wc >= 2) {
            const int kvh = wc - 2;
#pragma unroll
            for (int ai = 0; ai < 2; ++ai)
#pragma unroll
                for (int m = 0; m < 4; ++m) { const int row = u.pm * 256 + ai * 128 + wr * 64 + m * 16 + fr;
                    if (!lat) { const int b = row >> 8, t = row & 255; float* ov = outv + (((size_t)(b * 2 + layer) * 256 + t) * 2 + kvh) * 64; bf16_t* vt = Vctx + ((size_t)(b * 2 + kvh) * 64) * 256 + t;
#pragma unroll
                        for (int bj = 0; bj < 2; ++bj)
#pragma unroll
                            for (int n = 0; n < 2; ++n) { const int d = 32 * bj + 16 * n + 4 * fq; const f32x4 a = acc[ai][bj][m][n]; *(f32x4*)(ov + d) = a;
                                const unsigned p0 = pk2(a[0], a[1]), p1 = pk2(a[2], a[3]);
                                vt[(size_t)(d + 0) * 256] = (bf16_t)(p0 & 0xffffu); vt[(size_t)(d + 1) * 256] = (bf16_t)(p0 >> 16); vt[(size_t)(d + 2) * 256] = (bf16_t)(p1 & 0xffffu); vt[(size_t)(d + 3) * 256] = (bf16_t)(p1 >> 16); } }
                    else { const int rl = row - NCTX, b = rl >> 11, t = rl & 2047; bf16_t* vt = Vlat + ((size_t)(b * 2 + kvh) * 64) * 2560 + 512 + t;
#pragma unroll
                        for (int bj = 0; bj < 2; ++bj)
#pragma unroll
                            for (int n = 0; n < 2; ++n) { const int d = 32 * bj + 16 * n + 4 * fq; const f32x4 a = acc[ai][bj][m][n];
                                const unsigned p0 = pk2(a[0], a[1]), p1 = pk2(a[2], a[3]);
                                vt[(size_t)(d + 0) * 2560] = (bf16_t)(p0 & 0xffffu); vt[(size_t)(d + 1) * 2560] = (bf16_t)(p0 >> 16); vt[(size_t)(d + 2) * 2560] = (bf16_t)(p1 & 0xffffu); vt[(size_t)(d + 3) * 2560] = (bf16_t)(p1 >> 16); } } }
            return;
        }
        const bool isq = pn < 2; const float* nw = isq ? qn : kn;
        f32x4 w4[2][2];
#pragma unroll
        for (int bj = 0; bj < 2; ++bj)
#pragma unroll
            for (int n = 0; n < 2; ++n) w4[bj][n] = *(const f32x4*)(nw + 32 * bj + 16 * n + 4 * fq);
        const float qscale = isq ? 0.125f * 1.4426950408889634f : 1.0f;
        f32x2 rc[2][2], rsn[2][2], cc[4][2], csn[4][2];
        if (lat) { const int T0 = (u.pm * 256 - NCTX) & 2047;
#pragma unroll
            for (int ai = 0; ai < 2; ++ai)
#pragma unroll
                for (int n = 0; n < 2; ++n) { const int o = (T0 + 128 * ai + 64 * wr) * 32 + 8 * n + 2 * fq; rc[ai][n] = ldg8f(ropec + o); rsn[ai][n] = ldg8f(ropes + o); }
#pragma unroll
            for (int m = 0; m < 4; ++m)
#pragma unroll
                for (int n = 0; n < 2; ++n) { const int o = (16 * m + fr) * 32 + 16 + 8 * n + 2 * fq; cc[m][n] = ldg8f(ropec + o); csn[m][n] = ldg8f(ropes + o); } }
#pragma unroll
        for (int ai = 0; ai < 2; ++ai)
#pragma unroll
            for (int m = 0; m < 4; ++m) { const int row = u.pm * 256 + ai * 128 + wr * 64 + m * 16 + fr;
                float ss = 0.f;
#pragma unroll
                for (int bj = 0; bj < 2; ++bj)
#pragma unroll
                    for (int n = 0; n < 2; ++n) { const f32x4 a = acc[ai][bj][m][n]; ss += a[0] * a[0] + a[1] * a[1] + a[2] * a[2] + a[3] * a[3]; }
                ss += shx(ss, 16, fq * 16 + fr); ss += shx(ss, 32, fq * 16 + fr);
                const float rstd = rsqrtf(ss * (1.0f / 64.0f) + 1e-6f);
                f32x4 v[2][2];
#pragma unroll
                for (int bj = 0; bj < 2; ++bj)
#pragma unroll
                    for (int n = 0; n < 2; ++n) v[bj][n] = acc[ai][bj][m][n] * rstd * w4[bj][n];
                if (!lat) {
                    const int b = row >> 8, t = row & 255;
                    if (isq) { bf16_t* qp = Q + (size_t)row * 512 + (pn * 4 + wc) * 64;
#pragma unroll
                        for (int bj = 0; bj < 2; ++bj)
#pragma unroll
                            for (int n = 0; n < 2; ++n) { const f32x4 a = v[bj][n] * qscale; u32x2 pw; pw.x = pk2(a[0], a[1]); pw.y = pk2(a[2], a[3]); *(u32x2*)(qp + 32 * bj + 16 * n + 4 * fq) = pw; } }
                    else { const int kvh = wc; float* ok = outk + (((size_t)(b * 2 + layer) * 256 + t) * 2 + kvh) * 64; bf16_t* kp = Kctx + ((size_t)(b * 2 + kvh) * 256 + t) * 64;
#pragma unroll
                        for (int bj = 0; bj < 2; ++bj)
#pragma unroll
                            for (int n = 0; n < 2; ++n) { const int d = 32 * bj + 16 * n + 4 * fq; const f32x4 a = v[bj][n]; *(f32x4*)(ok + d) = a;
                                u32x2 pw; pw.x = pk2(a[0], a[1]); pw.y = pk2(a[2], a[3]); *(u32x2*)(kp + d) = pw; } }
                } else {
                    const int rl = row - NCTX, b = rl >> 11, t = rl & 2047;
                    bf16_t* dst = isq ? Q + (size_t)row * 512 + (pn * 4 + wc) * 64 : Klat + ((size_t)(b * 2 + wc) * 2560 + 512 + t) * 64;
#pragma unroll
                    for (int bj = 0; bj < 2; ++bj)
#pragma unroll
                        for (int n = 0; n < 2; ++n) { const int d = 32 * bj + 16 * n + 4 * fq; const int pi = d >> 1;
                            const f32x2 c2 = bj == 0 ? rc[ai][n] : cc[m][n], s2 = bj == 0 ? rsn[ai][n] : csn[m][n]; const f32x4 a = v[bj][n];
                            const float o0 = (a[0] * c2[0] - a[1] * s2[0]) * qscale, o1 = (a[0] * s2[0] + a[1] * c2[0]) * qscale, o2 = (a[2] * c2[1] - a[3] * s2[1]) * qscale, o3 = (a[2] * s2[1] + a[3] * c2[1]) * qscale;
                            u32x2 pw; pw.x = pk2(o0, o1); pw.y = pk2(o2, o3); *(u32x2*)(dst + d) = pw; }
                }
            }
    }
};

struct EpiGlu {
    static constexpr bool PERM = true, AFTER_DRAIN = false;
    const bf16_t* G; const float* bias; bf16_t* MIX;
    DI void operator()(const f32x4 (&acc)[2][2][4][2], const pg8::Unit& u, int wr, int wc, int fr, int fq) const {
        asm volatile("" : "+v"(fr), "+v"(fq));
        const int cb = u.pn * 256 + 32 * wc + 8 * fq, rb = u.pm * 256 + wr * 64 + fr;
        f32x4 bv[2][2]; u32x4 gw[2][4][2];
#pragma unroll
        for (int bj = 0; bj < 2; ++bj) { bv[bj][0] = ldg16f(bias + cb + 128 * bj); bv[bj][1] = ldg16f(bias + cb + 128 * bj + 4); }
#pragma unroll
        for (int ai = 0; ai < 2; ++ai)
#pragma unroll
            for (int m = 0; m < 4; ++m)
#pragma unroll
                for (int bj = 0; bj < 2; ++bj) gw[ai][m][bj] = ldg16(G + (size_t)(rb + 128 * ai + 16 * m) * 512 + cb + 128 * bj);
#pragma unroll
        for (int ai = 0; ai < 2; ++ai)
#pragma unroll
            for (int m = 0; m < 4; ++m)
#pragma unroll
                for (int bj = 0; bj < 2; ++bj) { const u32x4 g4 = gw[ai][m][bj];
                    const f32x4 v0 = acc[ai][bj][m][0] + bv[bj][0], v1 = acc[ai][bj][m][1] + bv[bj][1];
                    u32x4 o;
                    o.x = pk2(bflo(g4.x) * sigmoidf_(v0[0]), bfhi(g4.x) * sigmoidf_(v0[1])); o.y = pk2(bflo(g4.y) * sigmoidf_(v0[2]), bfhi(g4.y) * sigmoidf_(v0[3]));
                    o.z = pk2(bflo(g4.z) * sigmoidf_(v1[0]), bfhi(g4.z) * sigmoidf_(v1[1])); o.w = pk2(bflo(g4.w) * sigmoidf_(v1[2]), bfhi(g4.w) * sigmoidf_(v1[3]));
                    stg16(MIX + (size_t)(rb + 128 * ai + 16 * m) * 1024 + 512 + cb + 128 * bj, o); }
    }
};

struct EpiRes {
    static constexpr bool PERM = false, AFTER_DRAIN = false;
    const float* xa; const float* xb; const bf16_t* xh; bf16_t* Xo; const float* gate;
    DI void operator()(const f32x4 (&acc)[2][2][4][2], const pg8::Unit& u, int wr, int wc, int fr, int fq) const {
        asm volatile("" : "+v"(fr), "+v"(fq));
        const int j = u.pm < 32 ? 0 : 1 + ((u.pm - 32) >> 3);
        const int cb = u.pn * 256 + 32 * wc + 4 * fq, rb = u.pm * 256 + wr * 64 + fr;
        const float* gt = gate + j * 6144 + cb;
        f32x4 gv[2][2];
#pragma unroll
        for (int bj = 0; bj < 2; ++bj)
#pragma unroll
            for (int n = 0; n < 2; ++n) gv[bj][n] = ldg16f(gt + 128 * bj + 16 * n);
        if (xh) {
            u32x2 xr[2][4][2][2];
#pragma unroll
            for (int ai = 0; ai < 2; ++ai)
#pragma unroll
                for (int m = 0; m < 4; ++m)
#pragma unroll
                    for (int bj = 0; bj < 2; ++bj)
#pragma unroll
                        for (int n = 0; n < 2; ++n) xr[ai][m][bj][n] = ldg8(xh + (size_t)(rb + 128 * ai + 16 * m) * 1024 + cb + 128 * bj + 16 * n);
#pragma unroll
            for (int ai = 0; ai < 2; ++ai)
#pragma unroll
                for (int m = 0; m < 4; ++m)
#pragma unroll
                    for (int bj = 0; bj < 2; ++bj)
#pragma unroll
                        for (int n = 0; n < 2; ++n) { const u32x2 t = xr[ai][m][bj][n]; const f32x4 xv = (f32x4){bflo(t.x), bfhi(t.x), bflo(t.y), bfhi(t.y)};
                            const f32x4 xn = xv + gv[bj][n] * acc[ai][bj][m][n];
                            u32x2 pw; pw.x = pk2(xn[0], xn[1]); pw.y = pk2(xn[2], xn[3]); stg8(Xo + (size_t)(rb + 128 * ai + 16 * m) * 1024 + cb + 128 * bj + 16 * n, pw); }
        } else {
            const float* xs = u.pm < 32 ? xa + (size_t)rb * 1024 : xb + (size_t)(rb - NCTX) * 1024;
#pragma unroll
            for (int ai = 0; ai < 2; ++ai) {
                f32x4 xr[4][2][2];
#pragma unroll
                for (int m = 0; m < 4; ++m)
#pragma unroll
                    for (int bj = 0; bj < 2; ++bj)
#pragma unroll
                        for (int n = 0; n < 2; ++n) xr[m][bj][n] = ldg16f(xs + (size_t)(128 * ai + 16 * m) * 1024 + cb + 128 * bj + 16 * n);
#pragma unroll
                for (int m = 0; m < 4; ++m)
#pragma unroll
                    for (int bj = 0; bj < 2; ++bj)
#pragma unroll
                        for (int n = 0; n < 2; ++n) { const f32x4 xn = xr[m][bj][n] + gv[bj][n] * acc[ai][bj][m][n];
                            u32x2 pw; pw.x = pk2(xn[0], xn[1]); pw.y = pk2(xn[2], xn[3]); stg8(Xo + (size_t)(rb + 128 * ai + 16 * m) * 1024 + cb + 128 * bj + 16 * n, pw); }
            }
        }
    }
};

struct EpiFfn1 {
    static constexpr bool PERM = true, AFTER_DRAIN = false;
    bf16_t* ACT;
    DI void operator()(const f32x4 (&acc)[2][2][4][2], const pg8::Unit& u, int wr, int wc, int fr, int fq) const {
        asm volatile("" : "+v"(fr), "+v"(fq));
#pragma unroll
        for (int ai = 0; ai < 2; ++ai)
#pragma unroll
            for (int m = 0; m < 4; ++m) { const int row = u.pm * 256 + ai * 128 + wr * 64 + m * 16 + fr; const int a0 = u.pn * 128 + 32 * wc + 8 * fq;
                const f32x4 g0 = acc[ai][0][m][0], g1 = acc[ai][0][m][1], u0 = acc[ai][1][m][0], u1 = acc[ai][1][m][1];
                u32x4 o;
                o.x = pk2(g0[0] * sigmoidf_(g0[0]) * u0[0], g0[1] * sigmoidf_(g0[1]) * u0[1]); o.y = pk2(g0[2] * sigmoidf_(g0[2]) * u0[2], g0[3] * sigmoidf_(g0[3]) * u0[3]);
                o.z = pk2(g1[0] * sigmoidf_(g1[0]) * u1[0], g1[1] * sigmoidf_(g1[1]) * u1[1]); o.w = pk2(g1[2] * sigmoidf_(g1[2]) * u1[2], g1[3] * sigmoidf_(g1[3]) * u1[3]);
                *(u32x4*)(ACT + (size_t)row * 2816 + a0) = o; }
    }
};

struct ListOrder {
    int count, G, c, mode;
    DI bool next(int i, pg8::Unit& u) const {
        const int L0 = i * G + c; if (L0 >= count) return false;
        const int L = (L0 & 7) * (count >> 3) + (L0 >> 3);
        if (mode == 0) { const int pm = L >> 2, vn = L & 3; if (vn < 3) { u.pm = pm; u.pn = vn; } else { u.pm = 32 + (pm >> 1); u.pn = 3 + (pm & 1); } }
        else { u.pm = L >> 1; u.pn = 3 + (L & 1); }
        return true;
    }
    DI void a_ready(const pg8::Unit&) const {}
    DI void done(const pg8::Unit&) const {}
};

template <class Epi> DI void run_gemm(unsigned char* shm, const bf16_t* A, const bf16_t* Bt, int N, int K, const Epi& E, int wv) {
    pg8::Gemm g; g.A = A; g.Bt = Bt; g.M = NTOK; g.N = N; g.K = K;
    pg8::StaticOrder S; S.init(NTOK, N, (int)gridDim.x, (int)blockIdx.x);
    pg8::gemm_phase<Epi, pg8::StaticOrder, false>((PG8_LAS unsigned char*)shm, g, S, E, nullptr, wv);
}

DI void attn_item(const bf16_t* __restrict__ Q, const bf16_t* __restrict__ Kp, const bf16_t* __restrict__ Vp, int vld, int nkeys, int qtok0, int kvh, bf16_t* __restrict__ MIX, unsigned char* lds, int wv) {
    const int tid = ltid(wv), w = tid >> 6, lane = tid & 63, c = lane & 31, hh = lane >> 5;
    const int hq = kvh * 4 + (w & 3), qtok = qtok0 + 32 * (w >> 2) + c;
    bf16x8 qf[4];
#pragma unroll
    for (int s = 0; s < 4; ++s) qf[s] = __builtin_bit_cast(bf16x8, ldg16(Q + (size_t)qtok * 512 + hq * 64 + 16 * s + 8 * hh));
    unsigned char* Kb = lds; unsigned char* Vb = lds + 2 * 9216;
    const int srow = tid >> 3, sseg = tid & 7;
    const bf16_t* kg = Kp + (size_t)srow * 64 + sseg * 8;
    const bf16_t* vg = Vp + (size_t)srow * vld + sseg * 8;
    u32x4 kr = ldg16(kg), vr = ldg16(vg);
    *(u32x4*)(Kb + srow * 144 + sseg * 16) = kr;
    { u32x2* d = (u32x2*)(Vb + srow * 136 + sseg * 16); u32x2 a; a.x = vr.x; a.y = vr.y; u32x2 b; b.x = vr.z; b.y = vr.w; d[0] = a; d[1] = b; }
    __syncthreads();
    f32x16 ot[2];
#pragma unroll
    for (int i = 0; i < 16; ++i) { ot[0][i] = 0.f; ot[1][i] = 0.f; }
    float mrun = -1e30f, lsum = 0.f;
    const int nt = nkeys >> 6;
    for (int it = 0; it < nt; ++it) {
        const int cur = it & 1;
        if (it + 1 < nt) { kr = ldg16(kg + (size_t)(it + 1) * 4096); vr = ldg16(vg + (it + 1) * 64); }
        const unsigned char* kb = Kb + cur * 9216; const unsigned char* vb = Vb + cur * 8704;
        f32x16 st[2]; bf16x8 kf[2][4];
#pragma unroll
        for (int kt = 0; kt < 2; ++kt)
#pragma unroll
            for (int s = 0; s < 4; ++s) kf[kt][s] = *(const PG8_LAS bf16x8*)(const PG8_LAS unsigned char*)(kb + (32 * kt + c) * 144 + (16 * s + 8 * hh) * 2);
#pragma unroll
        for (int kt = 0; kt < 2; ++kt) {
#pragma unroll
            for (int i = 0; i < 16; ++i) st[kt][i] = 0.f;
#pragma unroll
            for (int s = 0; s < 4; ++s) st[kt] = mfma32p(kf[kt][s], qf[s], st[kt]); }
        float mx = fmaxf(fmaxf(st[0][0], st[0][1]), st[0][2]);
#pragma unroll
        for (int i = 3; i < 15; i += 2) mx = fmaxf(fmaxf(mx, st[0][i]), st[0][i + 1]);
        mx = fmaxf(mx, st[0][15]);
#pragma unroll
        for (int i = 0; i < 16; i += 2) mx = fmaxf(fmaxf(mx, st[1][i]), st[1][i + 1]);
        mx = fmaxf(mx, shx(mx, 32, lane));
        const float mnew = fmaxf(mrun, mx), alpha = __builtin_amdgcn_exp2f(mrun - mnew); mrun = mnew;
        f32x2 ps2 = (f32x2){0.f, 0.f}; const f32x2 mn2 = (f32x2){mnew, mnew};
#pragma unroll
        for (int kt = 0; kt < 2; ++kt)
#pragma unroll
            for (int i = 0; i < 16; i += 2) { f32x2 d = (f32x2){st[kt][i], st[kt][i + 1]} - mn2; f32x2 pp; pp.x = __builtin_amdgcn_exp2f(d.x); pp.y = __builtin_amdgcn_exp2f(d.y); st[kt][i] = pp.x; st[kt][i + 1] = pp.y; ps2 += pp; }
        const float ps = ps2.x + ps2.y;
        lsum = lsum * alpha + ps;
        if (__builtin_amdgcn_ballot_w64(alpha != 1.0f) != 0ull) {
#pragma unroll
            for (int i = 0; i < 16; ++i) { ot[0][i] *= alpha; ot[1][i] *= alpha; } }
        s16x4 vlo[2][2][2], vhi[2][2][2];
#pragma unroll
        for (int kt = 0; kt < 2; ++kt)
#pragma unroll
            for (int sp = 0; sp < 2; ++sp)
#pragma unroll
                for (int dt = 0; dt < 2; ++dt) { const PG8_LAS unsigned char* vrow = (const PG8_LAS unsigned char*)(vb + (32 * dt + c) * 136 + (32 * kt + 16 * sp + 4 * hh) * 2);
                    vlo[kt][sp][dt] = *(const PG8_LAS s16x4*)vrow; vhi[kt][sp][dt] = *(const PG8_LAS s16x4*)(vrow + 16); }
#pragma unroll
        for (int kt = 0; kt < 2; ++kt)
#pragma unroll
            for (int sp = 0; sp < 2; ++sp) {
                const bf16x8 pk = pack8(st[kt][8 * sp], st[kt][8 * sp + 1], st[kt][8 * sp + 2], st[kt][8 * sp + 3], st[kt][8 * sp + 4], st[kt][8 * sp + 5], st[kt][8 * sp + 6], st[kt][8 * sp + 7]);
#pragma unroll
                for (int dt = 0; dt < 2; ++dt) { const bf16x8 va = __builtin_shufflevector(vlo[kt][sp][dt], vhi[kt][sp][dt], 0, 1, 2, 3, 4, 5, 6, 7); ot[dt] = mfma32p(va, pk, ot[dt]); } }
        if (it + 1 < nt) { const int nx = cur ^ 1;
            *(u32x4*)(Kb + nx * 9216 + srow * 144 + sseg * 16) = kr;
            u32x2* d = (u32x2*)(Vb + nx * 8704 + srow * 136 + sseg * 16); u32x2 a; a.x = vr.x; a.y = vr.y; u32x2 b; b.x = vr.z; b.y = vr.w; d[0] = a; d[1] = b; }
        __syncthreads();
    }
    const float ltot = lsum + shx(lsum, 32, lane); const float inv = 1.0f / ltot;
    bf16_t* op = MIX + (size_t)qtok * 1024 + hq * 64;
#pragma unroll
    for (int dt = 0; dt < 2; ++dt)
#pragma unroll
        for (int g4 = 0; g4 < 4; ++g4) { u32x2 pw; pw.x = pk2(ot[dt][4 * g4] * inv, ot[dt][4 * g4 + 1] * inv); pw.y = pk2(ot[dt][4 * g4 + 2] * inv, ot[dt][4 * g4 + 3] * inv);
            stg8(op + 32 * dt + 8 * g4 + 4 * hh, pw); }
}

template <int DIR, bool FULL>
DI void ssm_pass(int layer, int pr, int g, const bf16_t* __restrict__ U, const bf16x8* __restrict__ Bm, const bf16x8* __restrict__ Cm, const float* __restrict__ lam,
                 const float* __restrict__ state_in, const float* sseg_r, float* sseg_w, float* YF, bf16_t* __restrict__ G, const float* __restrict__ dskip,
                 float* __restrict__ out_state, unsigned char* hl, int wv) {
    const int lane = ltid(wv) & 63, c = lane & 31, hh = lane >> 5, fr = lane & 15, kq = lane >> 4;
    const int ldg = (layer * 2 + DIR) * 32 + g;
    bf16x8 bm[4], cm[4];
#pragma unroll
    for (int i = 0; i < 4; ++i) { bm[i] = Bm[(ldg * 4 + i) * 64 + lane]; if (FULL) cm[i] = Cm[(ldg * 4 + i) * 64 + lane]; }
    const float l0r = lam[(ldg * 64 + c) * 2], l0i = lam[(ldg * 64 + c) * 2 + 1], l1r = lam[(ldg * 64 + 32 + c) * 2], l1i = lam[(ldg * 64 + 32 + c) * 2 + 1];
    const int s = 2 * pr + hh;
    float h0r = 0.f, h0i = 0.f, h1r = 0.f, h1i = 0.f;
    if (FULL && pr >= 16) {
        const int sl = s - 32, b = sl >> 3, seg = sl & 7;
        float a0r = l0r, a0i = l0i, a1r = l1r, a1i = l1i;
#pragma unroll
        for (int i = 0; i < 8; ++i) { const float t0 = a0r * a0r - a0i * a0i, t1 = 2.f * a0r * a0i; a0r = t0; a0i = t1; const float t2 = a1r * a1r - a1i * a1i, t3 = 2.f * a1r * a1i; a1r = t2; a1i = t3; }
        const float* si = state_in + ((((size_t)(b * 2 + layer) * 2 + DIR) * 2) * 32 + g) * 64;
        h0r = si[c]; h0i = si[2048 + c]; h1r = si[32 + c]; h1i = si[2048 + 32 + c];
        const int n = DIR == 0 ? seg : 7 - seg;
        for (int jj = 0; jj < n; ++jj) { const int j = DIR == 0 ? jj : 7 - jj;
            const float* sp = sseg_r + ((((size_t)(b * 8 + j) * 2 + DIR) * 32 + g) * 64) * 2;
            const float s0r = sp[c * 2], s0i = sp[c * 2 + 1], s1r = sp[(32 + c) * 2], s1i = sp[(32 + c) * 2 + 1];
            const float n0r = a0r * h0r - a0i * h0i + s0r, n0i = a0r * h0i + a0i * h0r + s0i; h0r = n0r; h0i = n0i;
            const float n1r = a1r * h1r - a1i * h1i + s1r, n1i = a1r * h1i + a1i * h1r + s1i; h1r = n1r; h1i = n1i; }
    }
    const int seq_r = (c >> 2) & 1, q_r = (c & 3) + 4 * (c >> 3);
    const bf16_t* ua_ptr = U + ((size_t)((2 * pr + seq_r) * 256 + q_r)) * 512 + g * 16 + 8 * hh;
    f32x16 zero16;
#pragma unroll
    for (int i = 0; i < 16; ++i) zero16[i] = 0.f;
    auto ldu = [&](int ch) -> bf16x8 { return __builtin_bit_cast(bf16x8, ldg16(ua_ptr + (size_t)(DIR ? 240 - 16 * ch : 16 * ch) * 512)); };
    auto body = [&](const bf16x8 ua, int ch) {
        const int cb = DIR ? 240 - 16 * ch : 16 * ch;
        f32x16 x[4];
#pragma unroll
        for (int i = 0; i < 4; ++i) x[i] = mfma32(ua, bm[i], zero16);
#pragma unroll
        for (int i = 0; i < 16; ++i) { const int reg = DIR ? 15 - i : i;
            const float n0r = __builtin_fmaf(l0r, h0r, __builtin_fmaf(-l0i, h0i, x[0][reg])), n0i = __builtin_fmaf(l0r, h0i, __builtin_fmaf(l0i, h0r, x[1][reg])); h0r = n0r; h0i = n0i;
            const float n1r = __builtin_fmaf(l1r, h1r, __builtin_fmaf(-l1i, h1i, x[2][reg])), n1i = __builtin_fmaf(l1r, h1i, __builtin_fmaf(l1i, h1r, x[3][reg])); h1r = n1r; h1i = n1i;
            if (FULL) { unsigned* hrow = (unsigned*)(hl + (hh * 16 + reg) * 272); hrow[c] = pk2(h0r, h0i); hrow[32 + c] = pk2(h1r, h1i); } }
        if (FULL) {
#pragma unroll
            for (int sq = 0; sq < 2; ++sq) { f32x4 y = (f32x4){0.f, 0.f, 0.f, 0.f};
#pragma unroll
                for (int ks = 0; ks < 4; ++ks) { const bf16x8 af = *(const bf16x8*)(hl + (sq * 16 + fr) * 272 + (32 * ks + 8 * kq) * 2); y = mfma16(cm[ks], af, y); }
                { u32x2 pw; pw.x = pk2(y[0], y[1]); pw.y = pk2(y[2], y[3]); stg8((bf16_t*)YF + ((size_t)((2 * pr + sq) * 256 + cb + fr)) * 512 + g * 16 + 4 * kq, pw); } }
        }
    };
    bf16x8 u0 = ldu(0), u1 = ldu(1), u2 = ldu(2), u3 = ldu(3);
#pragma unroll 1
    for (int c4 = 0; c4 < 16; c4 += 4) {
        const bool more = c4 + 4 < 16;
        body(u0, c4);     if (more) u0 = ldu(c4 + 4);
        body(u1, c4 + 1); if (more) u1 = ldu(c4 + 5);
        body(u2, c4 + 2); if (more) u2 = ldu(c4 + 6);
        body(u3, c4 + 3); if (more) u3 = ldu(c4 + 7);
    }
    if (FULL) { if (pr < 16) { float* os = out_state + ((((size_t)(s * 2 + layer) * 2 + DIR) * 2) * 32 + g) * 64; os[c] = h0r; os[2048 + c] = h0i; os[32 + c] = h1r; os[2048 + 32 + c] = h1i; } }
    else { float* sw = sseg_w + ((((size_t)(s - 32) * 2 + DIR) * 32 + g) * 64) * 2; sw[c * 2] = h0r; sw[c * 2 + 1] = h0i; sw[(32 + c) * 2] = h1r; sw[(32 + c) * 2 + 1] = h1i; }
}

#define XB_TMO      128
#define XB_XCNT(j)  (256  + 64 * (j))
#define XB_XSUB(j)  (1280 + 64 * (j))
#define XB_XGEN(j)  (2304 + 64 * (j))
#define XB_TOP      3328
#define XB_TOPGEN   3392
#define XCD_BAR_WORDS 3456
#define XB_SPIN_CAP (1u << 18)
#define LAS __attribute__((address_space(3)))

__device__ __forceinline__ unsigned xb_ld(unsigned* p)              { return __hip_atomic_load(p, __ATOMIC_RELAXED, __HIP_MEMORY_SCOPE_AGENT); }
__device__ __forceinline__ unsigned xb_add(unsigned* p, unsigned v) { return __hip_atomic_fetch_add(p, v, __ATOMIC_RELAXED, __HIP_MEMORY_SCOPE_AGENT); }
__device__ __forceinline__ unsigned xb_xcc_id() { return (unsigned)__builtin_amdgcn_s_getreg((3 << 11) | 20) & 0xFu; }
#define XB_SPIN(cond, bar) do { unsigned _sp = 0; while (cond) { __builtin_amdgcn_s_sleep(1); \
    if ((++_sp & 255u) == 0u) { if (xb_ld(&(bar)[XB_TMO])) break; if (_sp > XB_SPIN_CAP) { atomicAdd(&(bar)[XB_TMO], 1u); break; } } } } while (0)

struct XcdBarrier {
    unsigned* bar; unsigned x;
    volatile LAS unsigned* st;
};

__device__ __forceinline__ XcdBarrier xcd_barrier_post(unsigned* bar, volatile LAS unsigned* st) {
    XcdBarrier b; b.bar = bar; b.x = xb_xcc_id(); b.st = st;
    if (threadIdx.x == 0) (void)xb_add(&bar[XB_XCNT(b.x)], 1u);
    return b;
}
__device__ __forceinline__ void xcd_barrier_complete(unsigned* bar, unsigned x, unsigned& nloc, unsigned& nx) {
    const unsigned G = gridDim.x * gridDim.y * gridDim.z;
    unsigned sum, cnt, mine, sp = 0u;
    for (;;) {
        sum = 0u; cnt = 0u; mine = 0u;
#pragma unroll
        for (unsigned j = 0; j < 16; ++j) { const unsigned c = xb_ld(&bar[XB_XCNT(j)]); sum += c; cnt += (c > 0u) ? 1u : 0u; mine = (j == x) ? c : mine; }
        if (sum == G) break;
        __builtin_amdgcn_s_sleep(1);
        if ((++sp & 255u) == 0u) { if (xb_ld(&bar[XB_TMO])) break; if (sp > XB_SPIN_CAP) { atomicAdd(&bar[XB_TMO], 1u); break; } }
    }
    nloc = mine > 0u ? mine : 1u; nx = cnt > 0u ? cnt : 1u;
}

__device__ __forceinline__ void xcd_barrier(const XcdBarrier& b) {
    asm volatile("s_waitcnt vmcnt(0)" ::: "memory");
    __syncthreads();
    if (threadIdx.x == 0) {
        unsigned* bar = b.bar;
        __builtin_amdgcn_s_waitcnt(0);
        unsigned nloc = b.st[0], nx = b.st[1];
        if (nloc == 0u) { xcd_barrier_complete(bar, b.x, nloc, nx); b.st[0] = nloc; b.st[1] = nx; }
        const unsigned old = xb_add(&bar[XB_XSUB(b.x)], 1u);
        const unsigned gen = old / nloc;
        if (old + 1u == (gen + 1u) * nloc) {
            __builtin_amdgcn_fence(__ATOMIC_RELEASE, "agent");
            asm volatile("s_waitcnt vmcnt(0)" ::: "memory");
            const unsigned og = xb_add(&bar[XB_TOP], 1u);
            const unsigned tg = og / nx;
            if (og + 1u == (tg + 1u) * nx) xb_add(&bar[XB_TOPGEN], 1u);
            else XB_SPIN(xb_ld(&bar[XB_TOPGEN]) == tg, bar);
            __builtin_amdgcn_fence(__ATOMIC_ACQUIRE, "agent");
            xb_add(&bar[XB_XGEN(b.x)], 1u);
            asm volatile("s_waitcnt vmcnt(0)" ::: "memory");
        } else {
            XB_SPIN(xb_ld(&bar[XB_XGEN(b.x)]) == gen, bar);
            __builtin_amdgcn_fence(__ATOMIC_ACQUIRE, "agent");
            asm volatile("s_waitcnt vmcnt(0)" ::: "memory");
        }
    }
    __syncthreads();
}


typedef const __attribute__((address_space(4))) Params* KParamsPtr;
DI KParamsPtr kparams() { KParamsPtr p = (KParamsPtr)__builtin_amdgcn_kernarg_segment_ptr(); asm volatile("" : "+s"(p)); return p; }
#define PKP (kparams())
__global__ __launch_bounds__(512, 2) void mega_fwd(Params P) {
    extern __shared__ __attribute__((aligned(16))) unsigned char shm[];
    cg::grid_group grid = cg::this_grid();
#define WSP_ (opaque_ptr(PKP->ws))
#define XP_ ((float*)opaque_ptr((unsigned char*)PKP->out))
#define MODS_ ((const float*)(WSP_ + WS_MODS))
#define HB_ ((bf16_t*)(WSP_ + WS_H))
#define YFP_ ((float*)(WSP_ + WS_H))
#define QB_ ((bf16_t*)(WSP_ + WS_Q))
#define UB_ ((bf16_t*)(WSP_ + WS_U))
#define MIXB_ ((bf16_t*)(WSP_ + WS_MIX))
#define GB_ ((bf16_t*)(WSP_ + WS_G))
#define ACTB_ ((bf16_t*)(WSP_ + WS_ACT))
#define KCTX_ ((bf16_t*)(WSP_ + WS_KCTX))
#define VCTX_ ((bf16_t*)(WSP_ + WS_VCTX))
    const int w = __builtin_amdgcn_readfirstlane(threadIdx.x >> 6);
    if (PKP->ws == nullptr) grid.sync();
    if (threadIdx.x == 0) { ((volatile LAS unsigned*)(shm + 131072))[0] = 0u; ((volatile LAS unsigned*)(shm + 131072))[1] = 0u; }
    __syncthreads();
    (void)xcd_barrier_post((unsigned*)(WSP_ + WS_BAR), (volatile LAS unsigned*)(shm + 131072));
#define GSYNC() do { XcdBarrier b_; b_.bar = (unsigned*)(opaque_ptr(PKP->ws) + WS_BAR); b_.x = xb_xcc_id(); b_.st = (volatile LAS unsigned*)(shm + 131072); xcd_barrier(b_); } while (0)

    { Params Pl; for (int i = 0; i < 28; ++i) Pl.in[i] = PKP->in[i]; Pl.out = PKP->out; Pl.ws = PKP->ws; phase0(Pl, shm, w); }
    GSYNC();
#pragma unroll 1
    for (int l = 0; l < 2; ++l) {
#define MODSL_ (MODS_ + l * 5 * 6144)
#define XA_ (PKP->in[0])
#define XH_ ((bf16_t*)(WSP_ + WS_XB))
#define XB_ (PKP->in[1])
#define KLAT_ ((bf16_t*)(WSP_ + WS_KLAT + l * SZ_KLAT))
#define VLAT_ ((bf16_t*)(WSP_ + WS_VLAT + l * SZ_KLAT))
        if (l == 0) {
            const int tid = ltid(w); const float* part = (const float*)(WSP_ + WS_MODP); const float* bm_ = PKP->in[8]; float* mw = (float*)(WSP_ + WS_MODS); float* ldsf = (float*)shm;
            for (int idx = blockIdx.x * 512 + tid; idx < 61440; idx += gridDim.x * 512) { const int ll = idx / 30720, n = idx % 6144;
                mw[idx] = part[idx] + part[61440 + idx] + part[2 * 61440 + idx] + part[3 * 61440 + idx] + bm_[ll * 6144 + n]; }
            for (int e = tid; e < 10240; e += 512) { const int j = e >> 11, r = e & 2047; const int idx = j * 6144 + r;
                ldsf[e] = part[idx] + part[61440 + idx] + part[2 * 61440 + idx] + part[3 * 61440 + idx] + bm_[r]; }
            __syncthreads();
            for (int rep = 0; rep < REP_NORM; ++rep) norm_phase(XA_, XB_, nullptr, PKP->in[9], ldsf, 2048, 0, 1024, HB_, w);
        } else
        for (int rep = 0; rep < REP_NORM; ++rep) norm_phase(XA_, XB_, XH_, PKP->in[9] + l * 1024, MODSL_, 6144, 0, 1024, HB_, w);
        GSYNC();
        { EpiIn E; E.layer = l; E.qn = PKP->in[12] + l * 64; E.kn = PKP->in[13] + l * 64; E.ropec = (const float*)(WSP_ + WS_ROPEC); E.ropes = (const float*)(WSP_ + WS_ROPES);
          E.Q = QB_; E.U = UB_; E.Kctx = KCTX_; E.Vctx = VCTX_; E.Klat = KLAT_; E.Vlat = VLAT_; E.outk = PKP->out + OUT_K; E.outv = PKP->out + OUT_V;
          { pg8::Gemm g; g.A = HB_; g.Bt = (const bf16_t*)(WSP_ + WS_WIN + l * SZ_WIN); g.M = NTOK; g.N = 1280; g.K = 1024;
            ListOrder S; S.count = 256; S.G = (int)gridDim.x; S.c = (int)blockIdx.x; S.mode = 0;
            pg8::gemm_phase<EpiIn, ListOrder, false>((PG8_LAS unsigned char*)shm, g, S, E, nullptr, w); }
          GSYNC();
          { pg8::Gemm g; g.A = HB_; g.Bt = (const bf16_t*)(WSP_ + WS_WIN + l * SZ_WIN); g.M = NTOK; g.N = 1280; g.K = 1024;
            ListOrder S; S.count = 64; S.G = (int)gridDim.x; S.c = (int)blockIdx.x; S.mode = 1;
            pg8::gemm_phase<EpiIn, ListOrder, false>((PG8_LAS unsigned char*)shm, g, S, E, nullptr, w); } }
        { const int nb = gridDim.x > 64 ? 64 : 0;
          if ((int)blockIdx.x >= nb)
          for (int it = blockIdx.x - nb; it < 384; it += gridDim.x - nb) {
            __syncthreads();
            if (it < 256) { const int qc = it & 3, kvh = (it >> 2) & 1, b = it >> 3;
                attn_item(QB_, KCTX_ + ((size_t)(b * 2 + kvh) * 256) * 64, VCTX_ + ((size_t)(b * 2 + kvh) * 64) * 256, 256, 256, b * 256 + qc * 64, kvh, MIXB_, shm, w); }
            else { const int wi = (it - 256) * 8 + w; const int dir = wi & 1, g = (wi >> 1) & 31, pr = 16 + (wi >> 6);
                if (dir == 0) ssm_pass<0, false>(l, pr, g, UB_, (const bf16x8*)(WSP_ + WS_SSMB), (const bf16x8*)(WSP_ + WS_SSMC), (const float*)(WSP_ + WS_SSML), PKP->in[4], nullptr, (float*)(WSP_ + WS_SSEG), nullptr, nullptr, nullptr, nullptr, nullptr, w);
                else ssm_pass<1, false>(l, pr, g, UB_, (const bf16x8*)(WSP_ + WS_SSMB), (const bf16x8*)(WSP_ + WS_SSMC), (const float*)(WSP_ + WS_SSML), PKP->in[4], nullptr, (float*)(WSP_ + WS_SSEG), nullptr, nullptr, nullptr, nullptr, nullptr, w); }
          } }
        GSYNC();
        for (int rep = 0; rep < REP_ATT4; ++rep)
        for (int it = blockIdx.x; it < 512; it += gridDim.x) {
            __syncthreads();
            if (it < 256) { const int qc = it >> 3, kvh = it & 1, b = (it >> 1) & 3;
                attn_item(QB_, KLAT_ + ((size_t)(b * 2 + kvh) * 2560) * 64, VLAT_ + ((size_t)(b * 2 + kvh) * 64) * 2560, 2560, 2560, NCTX + b * 2048 + qc * 64, kvh, MIXB_, shm, w); }
            else { const int si = it - 256, pr = si >> 3, gq = si & 7, g = gq * 4 + (w & 3);
                if (w < 4) ssm_pass<0, true>(l, pr, g, UB_, (const bf16x8*)(WSP_ + WS_SSMB), (const bf16x8*)(WSP_ + WS_SSMC), (const float*)(WSP_ + WS_SSML), PKP->in[4], (const float*)(WSP_ + WS_SSEG), nullptr, YFP_, nullptr, nullptr, PKP->out + OUT_S, shm + w * 8704, w);
                else ssm_pass<1, true>(l, pr, g, UB_, (const bf16x8*)(WSP_ + WS_SSMB), (const bf16x8*)(WSP_ + WS_SSMC), (const float*)(WSP_ + WS_SSML), PKP->in[4], (const float*)(WSP_ + WS_SSEG), nullptr, (float*)(WSP_ + WS_YB), nullptr, nullptr, PKP->out + OUT_S, shm + w * 8704, w);
                __syncthreads();
                { const int tid = ltid(w); const float* YBp = (const float*)(WSP_ + WS_YB); const float* dsk = PKP->in[21] + l * 512;
#pragma unroll 4
                  for (int i = 0; i < 16; ++i) { const int idx = i * 512 + tid, tk = pr * 512 + (idx >> 4), ch = gq * 64 + (idx & 15) * 4; const size_t o = (size_t)tk * 512 + ch;
                      const u32x2 yfw = *(const u32x2*)((const bf16_t*)YFP_ + o), ybw = *(const u32x2*)((const bf16_t*)YBp + o); const f32x4 dd = *(const f32x4*)(dsk + ch); const u32x2 uw = *(const u32x2*)(UB_ + o);
                      const f32x4 yf = (f32x4){bflo(yfw.x), bfhi(yfw.x), bflo(yfw.y), bfhi(yfw.y)}, yb = (f32x4){bflo(ybw.x), bfhi(ybw.x), bflo(ybw.y), bfhi(ybw.y)};
                      f32x4 v; v[0] = yf[0] + yb[0] + dd[0] * bflo(uw.x); v[1] = yf[1] + yb[1] + dd[1] * bfhi(uw.x); v[2] = yf[2] + yb[2] + dd[2] * bflo(uw.y); v[3] = yf[3] + yb[3] + dd[3] * bfhi(uw.y);
                      const f32x2 ga = gelu_pk((f32x2){v[0], v[1]}), gb = gelu_pk((f32x2){v[2], v[3]});
                      u32x2 pw; pw.x = pk2(ga.x, ga.y); pw.y = pk2(gb.x, gb.y); *(u32x2*)(GB_ + o) = pw; } } }
        }
        GSYNC();
        { EpiGlu E; E.G = GB_; E.bias = PKP->in[23] + l * 512; E.MIX = MIXB_; for (int rep = 0; rep < REP_GLU; ++rep) run_gemm(shm, GB_, (const bf16_t*)(WSP_ + WS_WGLU + l * SZ_WGLU), 512, 512, E, w); }
        GSYNC();
        { EpiRes E; E.xa = XA_; E.xb = XB_; E.xh = l == 0 ? nullptr : XH_; E.Xo = XH_; E.gate = MODSL_ + 2 * 1024; run_gemm(shm, MIXB_, (const bf16_t*)(WSP_ + WS_WOUT + l * SZ_WOUT), 1024, 1024, E, w); }
        GSYNC();
        for (int rep = 0; rep < REP_NORM; ++rep) norm_phase(XA_, XB_, XH_, PKP->in[10] + l * 1024, MODSL_, 6144, 3 * 1024, 4 * 1024, HB_, w);
        GSYNC();
        { EpiFfn1 E; E.ACT = ACTB_; for (int rep = 0; rep < REP_F1; ++rep) run_gemm(shm, HB_, (const bf16_t*)(WSP_ + WS_WF1 + l * SZ_WF1), 5632, 1024, E, w); }
        GSYNC();
        { EpiRes E; E.xa = XA_; E.xb = XB_; E.xh = XH_; E.Xo = XH_; E.gate = MODSL_ + 5 * 1024; run_gemm(shm, ACTB_, (const bf16_t*)(WSP_ + WS_WF2 + l * SZ_WF2), 1024, 2816, E, w); }
        GSYNC();
    }
    final_norm_phase(XH_, XP_, PKP->in[27], w);
}
#undef WSP_
#undef XP_
#undef MODS_
#undef HB_
#undef YFP_
#undef QB_
#undef UB_
#undef MIXB_
#undef GB_
#undef ACTB_
#undef KCTX_
#undef VCTX_
#undef MODSL_
#undef XA_
#undef XH_
#undef XB_
#undef KLAT_
#undef VLAT_

extern "C" void kernel_launch(void* const* d_in, const int* in_sizes, int n_in, void* d_out, int out_size, void* d_ws, size_t ws_size, hipStream_t stream) {
    static int grid_blocks = 0;
    if (grid_blocks == 0) {
        if (n_in < 28 || ws_size < WS_END) { fprintf(stderr, "kernel_launch: need 28 inputs and %zu bytes of workspace (got %d, %zu)\n", (size_t)WS_END, n_in, ws_size); grid_blocks = -1; return; }
        int dev = 0, cus = 0, per_cu = 0;
        (void)hipGetDevice(&dev);
        (void)hipDeviceGetAttribute(&cus, hipDeviceAttributeMultiprocessorCount, dev);
        if (hipFuncSetAttribute((const void*)mega_fwd, hipFuncAttributeMaxDynamicSharedMemorySize, LDS_BYTES) != hipSuccess) fprintf(stderr, "kernel_launch: hipFuncSetAttribute failed\n");
        if (hipOccupancyMaxActiveBlocksPerMultiprocessor(&per_cu, (const void*)mega_fwd, 512, LDS_BYTES) != hipSuccess || per_cu < 1) { per_cu = 1; (void)hipGetLastError(); }
        if (per_cu > 1) per_cu = 1;
        grid_blocks = cus * per_cu;
    }
    if (grid_blocks < 0) return;
    (void)hipMemsetAsync((unsigned char*)d_ws + WS_BAR, 0, SZ_BAR, stream);
    Params p{};
    for (int i = 0; i < 28; ++i) p.in[i] = (const float*)d_in[i];
    p.out = (float*)d_out; p.ws = (unsigned char*)d_ws;
    void* args[] = {&p};
    hipError_t e = hipLaunchCooperativeKernel((const void*)mega_fwd, dim3(grid_blocks), dim3(512), args, LDS_BYTES, stream);
    if (e != hipSuccess) fprintf(stderr, "cooperative launch failed: %s (grid %d)\n", hipGetErrorString(e), grid_blocks);
}
```

```cpp
#include <hip/hip_runtime.h>
#include <hip/hip_cooperative_groups.h>
#include <cstdio>
namespace cg = cooperative_groups;
#define DI __device__ __forceinline__
DI unsigned char* opaque_ptr(unsigned char* p) { asm volatile("" : "+s"(p)); return p; }
DI float shx(float v, int m, int lane) { return __int_as_float(__builtin_amdgcn_ds_bpermute((lane ^ m) << 2, __float_as_int(v))); }
DI int lane_now() { int l; asm volatile("v_mbcnt_lo_u32_b32 %0, -1, 0\n\tv_mbcnt_hi_u32_b32 %0, -1, %0" : "=v"(l)); return l; }
DI int ltid(int wv) { return wv * 64 + lane_now(); }

namespace pg8 {
#define PG8_LAS __attribute__((address_space(3)))
typedef unsigned short bf16_t;
typedef short bf16x8 __attribute__((ext_vector_type(8)));
typedef float f32x4 __attribute__((ext_vector_type(4)));
typedef unsigned u32x4 __attribute__((ext_vector_type(4)));
constexpr int BM = 256, BK = 64, HALF = 128, HTB = HALF * BK * 2  , STAGE_BYTES = 8 * HTB, NXCD = 8, WGM = 1;

__host__ __device__ __forceinline__ int lds_byte(int r, int c) { const int st = (r >> 4) * 2 + (c >> 5), rr = r & 15, cc = c & 31, ob = rr * 64 + cc * 2; return st * 1024 + (ob ^ (((ob >> 9) & 1) << 5)); }
__host__ __device__ __forceinline__ void stage_rc(int b, int& R, int& C) { const int st = b / 1024, sb = b % 1024, swz = sb ^ (((sb >> 9) & 1) << 5); R = (st >> 1) * 16 + swz / 64; C = (st & 1) * 32 + (swz % 64) / 2; }
__host__ __device__ __forceinline__ int perm32(int rho) { const int n = rho >> 4, i = rho & 15; return 8 * (i >> 2) + 4 * n + (i & 3); }

struct Unit { int pm, pn; };
struct Gemm { const bf16_t* A; const bf16_t* Bt; int M, N, K; };

struct StaticOrder {
    int nM, nN, nwg, G, c;
    __host__ __device__ void init(int M, int N, int G_, int c_) { nM = M / BM; nN = N / BM; nwg = nM * nN; G = G_; c = c_; }
    __host__ __device__ bool next(int i, Unit& u) const {
        const long L = (long)i * G + c; if (L >= nwg) return false;
        int wgid = (int)L; { const int q = nwg / NXCD, r = nwg % NXCD, xcd = wgid % NXCD, off = wgid / NXCD; wgid = (xcd < r ? xcd * (q + 1) : r * (q + 1) + (xcd - r) * q) + off; }
        const int nig = WGM * nN, gid = wgid / nig, fm = gid * WGM, gsz = (nM - fm) < WGM ? (nM - fm) : WGM;
        u.pm = fm + ((wgid % nig) % gsz); u.pn = (wgid % nig) / gsz; return true;
    }
    __device__ __forceinline__ void a_ready(const Unit&) const {}
    __device__ __forceinline__ void done(const Unit&) const {}
};

template <class Epi, class Sched, bool STAMP = false>
__device__ __forceinline__ void gemm_phase(PG8_LAS unsigned char* lds, const Gemm g, const Sched& S, const Epi& E, unsigned long long* stamps, int wv) {
    int tid_l; asm volatile("v_mbcnt_lo_u32_b32 %0, -1, 0\n\tv_mbcnt_hi_u32_b32 %0, -1, %0" : "=v"(tid_l)); tid_l += wv * 64;
    const int tid = tid_l, wid = __builtin_amdgcn_readfirstlane(tid >> 6), lane = tid & 63, wr = wid >> 2, wc = wid & 3, fr = lane & 15, fq = lane >> 4;
    const int K = g.K, nt = K / BK;
    int ts_lo = 0, ts_hi = 0, nts = 0; const unsigned long long rt_entry = STAMP ? (unsigned long long)wall_clock64() : 0ull;
#define PG8_STAMP() do { if (STAMP && wid == 0 && nts < 64) { const unsigned long long _c = (unsigned long long)clock64(); \
        ts_lo = (lane == nts) ? (int)(unsigned)_c : ts_lo; ts_hi = (lane == nts) ? (int)(unsigned)(_c >> 32) : ts_hi; ++nts; } } while (0)
    PG8_STAMP();
    unsigned voffA[2], voffB[2];
#pragma unroll
    for (int i = 0; i < 2; ++i) { int R, C; stage_rc(tid * 16 + i * 8192, R, C); const int Rb = Epi::PERM ? ((R & ~31) + perm32(R & 31)) : R;
        voffA[i] = (unsigned)(R * K + C) * 2u; voffB[i] = (unsigned)(Rb * K + C) * 2u; }
    const size_t kstep = (size_t)(BK * 2);
    const size_t hstep = (size_t)HALF * K * 2;
    const size_t tstep = 2 * hstep;
    const unsigned ldsw = (unsigned)wid * 1024u;
    const int aoff = lds_byte(wr * 64 + fr, fq * 8), boff = lds_byte(wc * 32 + fr, fq * 8);
#define PG8_SA(b, h) (((b) * 2 + (h)) * HTB)
#define PG8_SB(b, h) ((4 + (b) * 2 + (h)) * HTB)
#define PG8_STAGE(bufoff, gbase, voff) do { _Pragma("unroll") for (int _i = 0; _i < 2; ++_i) \
        __builtin_amdgcn_global_load_lds((const unsigned*)((const char*)(gbase) + (voff)[_i]), (PG8_LAS unsigned*)(lds + (bufoff) + ldsw + _i * 8192), 16, 0, 0); } while (0)
#define PG8_LDA(dst, b, h) do { _Pragma("unroll") for (int m = 0; m < 4; ++m) _Pragma("unroll") for (int k = 0; k < 2; ++k) dst[m][k] = *(const PG8_LAS bf16x8*)(lds + PG8_SA(b, h) + aoff + m * 2048 + k * 1024); } while (0)
#define PG8_LDB(dst, b, h) do { _Pragma("unroll") for (int n = 0; n < 2; ++n) _Pragma("unroll") for (int k = 0; k < 2; ++k) dst[n][k] = *(const PG8_LAS bf16x8*)(lds + PG8_SB(b, h) + boff + n * 2048 + k * 1024); } while (0)
#define PG8_MMA(ai, bj, At, Bt) do { __builtin_amdgcn_s_setprio(1); _Pragma("unroll") for (int m = 0; m < 4; ++m) _Pragma("unroll") for (int n = 0; n < 2; ++n) _Pragma("unroll") for (int k = 0; k < 2; ++k) \
        acc[ai][bj][m][n] = __builtin_amdgcn_mfma_f32_16x16x32_bf16(Bt[n][k], At[m][k], acc[ai][bj][m][n], 0, 0, 0); __builtin_amdgcn_s_setprio(0); } while (0)
#define PG8_WAIT_V(n) asm volatile("s_waitcnt vmcnt(" #n ")" ::: "memory")
#define PG8_WAIT_L(n) asm volatile("s_waitcnt lgkmcnt(" #n ")" ::: "memory")
#define PG8_BAR __builtin_amdgcn_s_barrier()
#define PG8_SCHED __builtin_amdgcn_sched_barrier(0)
    Unit cur, nxt; int ui = 0;
    if (!S.next(0, cur)) return;
    f32x4 acc[2][2][4][2];
#pragma unroll
    for (int a = 0; a < 2; ++a)
#pragma unroll
        for (int b = 0; b < 2; ++b)
#pragma unroll
            for (int m = 0; m < 4; ++m)
#pragma unroll
                for (int n = 0; n < 2; ++n) acc[a][b][m][n] = (f32x4){0.f, 0.f, 0.f, 0.f};
    bf16x8 At[4][2], B0[2][2], B1[2][2];
    const char* cA = (const char*)g.A + (size_t)cur.pm * tstep; const char* cB = (const char*)g.Bt + (size_t)cur.pn * tstep;
    S.a_ready(cur);
    PG8_STAGE(PG8_SB(0, 0), cB, voffB); PG8_STAGE(PG8_SA(0, 0), cA, voffA); PG8_STAGE(PG8_SB(0, 1), cB + hstep, voffB); PG8_STAGE(PG8_SA(0, 1), cA + hstep, voffA);
    if (wr == 1) PG8_BAR;
    PG8_WAIT_V(4); PG8_BAR;
    PG8_STAGE(PG8_SB(1, 0), cB + kstep, voffB); PG8_STAGE(PG8_SA(1, 0), cA + kstep, voffA); PG8_STAGE(PG8_SB(1, 1), cB + hstep + kstep, voffB);
    PG8_WAIT_V(6); PG8_BAR;
    PG8_STAMP();
    for (;;) {
        const bool has_next = S.next(ui + 1, nxt);
        const char* nA = has_next ? (const char*)g.A + (size_t)nxt.pm * tstep : cA; const char* nB = has_next ? (const char*)g.Bt + (size_t)nxt.pn * tstep : cB;
        for (int t = 0; t < nt; t += 2) {
            const bool last = (t == nt - 2);
            const char* a1 = cA + (size_t)(t + 1) * kstep;
            const char* a2 = last ? nA : cA + (size_t)(t + 2) * kstep; const char* b2 = last ? nB : cB + (size_t)(t + 2) * kstep;
            const char* a3 = a2 + kstep; const char* b3 = b2 + kstep;
            if (last && has_next) S.a_ready(nxt);
            PG8_LDB(B0, 0, 0); PG8_SCHED; PG8_LDA(At, 0, 0); PG8_STAGE(PG8_SA(1, 1), a1 + hstep, voffA);
            PG8_WAIT_L(8); PG8_BAR; PG8_WAIT_L(0); PG8_MMA(0, 0, At, B0); PG8_BAR; PG8_SCHED;
            PG8_LDB(B1, 0, 1); PG8_STAGE(PG8_SB(0, 0), b2, voffB);
            PG8_BAR; PG8_WAIT_L(0); PG8_MMA(0, 1, At, B1); PG8_BAR;
            PG8_LDA(At, 0, 1); PG8_STAGE(PG8_SA(0, 0), a2, voffA);
            PG8_BAR; PG8_WAIT_L(0); PG8_MMA(1, 0, At, B0); PG8_BAR; PG8_SCHED;
            PG8_STAGE(PG8_SB(0, 1), b2 + hstep, voffB);
            PG8_WAIT_V(6); PG8_BAR; PG8_MMA(1, 1, At, B1); PG8_BAR;
            PG8_LDB(B0, 1, 0); PG8_SCHED; PG8_LDA(At, 1, 0); PG8_STAGE(PG8_SA(0, 1), a2 + hstep, voffA);
            PG8_WAIT_L(8); PG8_BAR; PG8_WAIT_L(0); PG8_MMA(0, 0, At, B0); PG8_BAR; PG8_SCHED;
            PG8_LDB(B1, 1, 1); PG8_STAGE(PG8_SB(1, 0), b3, voffB);
            PG8_BAR; PG8_WAIT_L(0); PG8_MMA(0, 1, At, B1); PG8_BAR;
            PG8_LDA(At, 1, 1); PG8_STAGE(PG8_SA(1, 0), a3, voffA);
            PG8_BAR; PG8_WAIT_L(0); PG8_MMA(1, 0, At, B0); PG8_BAR; PG8_SCHED;
            PG8_STAGE(PG8_SB(1, 1), b3 + hstep, voffB);
            PG8_WAIT_V(6); PG8_BAR; PG8_MMA(1, 1, At, B1); PG8_BAR;
        }
        PG8_STAMP();
        if constexpr (!Epi::AFTER_DRAIN) { E(acc, cur, wr, wc, fr, fq); S.done(cur); }
        PG8_STAMP();
        if (!has_next) break;
#pragma unroll
        for (int a = 0; a < 2; ++a)
#pragma unroll
            for (int b = 0; b < 2; ++b)
#pragma unroll
                for (int m = 0; m < 4; ++m)
#pragma unroll
                    for (int n = 0; n < 2; ++n) acc[a][b][m][n] = (f32x4){0.f, 0.f, 0.f, 0.f};
        cur = nxt; cA = nA; cB = nB; ++ui;
    }
    PG8_WAIT_V(0);
    if (wr == 0) PG8_BAR;
    PG8_BAR;
    if constexpr (Epi::AFTER_DRAIN) { E.fused(acc, cur, wr, wc, fr, fq, lds, wid, lane); S.done(cur); }
    PG8_STAMP();
    if (STAMP && wid == 0) { stamps[lane] = lane < nts ? (((unsigned long long)(unsigned)ts_hi << 32) | (unsigned)ts_lo) : 0ull;
        if (lane == 62) stamps[62] = rt_entry; if (lane == 63) stamps[63] = (unsigned long long)wall_clock64(); }
#undef PG8_STAMP
#undef PG8_SA
#undef PG8_SB
#undef PG8_STAGE
#undef PG8_LDA
#undef PG8_LDB
#undef PG8_MMA
#undef PG8_WAIT_V
#undef PG8_WAIT_L
#undef PG8_BAR
#undef PG8_SCHED
}
}

typedef unsigned short bf16_t;
typedef short bf16x8 __attribute__((ext_vector_type(8)));
typedef short s16x4 __attribute__((ext_vector_type(4)));
typedef float f32x4 __attribute__((ext_vector_type(4)));
typedef float f32x2 __attribute__((ext_vector_type(2)));
typedef float f32x16 __attribute__((ext_vector_type(16)));
typedef unsigned u32x4 __attribute__((ext_vector_type(4)));
typedef unsigned u32x2 __attribute__((ext_vector_type(2)));
typedef __bf16 bf16x2_t __attribute__((ext_vector_type(2)));

constexpr int NTOK = 16384, DM = 1024, NCTX = 8192;
constexpr size_t SZ_WIN = (size_t)1280 * 1024 * 2, SZ_WGLU = (size_t)512 * 512 * 2, SZ_WOUT = (size_t)1024 * 1024 * 2, SZ_WF1 = (size_t)5632 * 1024 * 2, SZ_WF2 = (size_t)1024 * 2816 * 2;
constexpr size_t WS_WIN = 0, WS_WGLU = WS_WIN + 2 * SZ_WIN, WS_WOUT = WS_WGLU + 2 * SZ_WGLU, WS_WF1 = WS_WOUT + 2 * SZ_WOUT, WS_WF2 = WS_WF1 + 2 * SZ_WF1;
constexpr size_t WS_H = WS_WF2 + 2 * SZ_WF2;
constexpr size_t WS_Q = WS_H + (size_t)NTOK * 1024 * 2;
constexpr size_t WS_U = WS_Q + (size_t)NTOK * 512 * 2;
constexpr size_t WS_MIX = WS_U + (size_t)NTOK * 512 * 2;
constexpr size_t WS_G = WS_MIX + (size_t)NTOK * 1024 * 2;
constexpr size_t WS_ACT = WS_Q;
constexpr size_t WS_KLAT = WS_ACT + (size_t)NTOK * 2816 * 2;
constexpr size_t SZ_KLAT = (size_t)4 * 2 * 2560 * 64 * 2;
constexpr size_t WS_VLAT = WS_KLAT + 2 * SZ_KLAT;
constexpr size_t WS_KCTX = WS_VLAT + 2 * SZ_KLAT;
constexpr size_t SZ_KCTX = (size_t)32 * 2 * 256 * 64 * 2;
constexpr size_t WS_VCTX = WS_KCTX + SZ_KCTX;
constexpr size_t WS_MODS = WS_VCTX + SZ_KCTX;
constexpr size_t SZ_MODS = (size_t)2 * 5 * 6144 * 4;
constexpr size_t WS_BAR = WS_MODS + SZ_MODS;
constexpr size_t SZ_BAR = (size_t)3456 * 4;
constexpr size_t WS_ROPEC = WS_BAR + SZ_BAR;
constexpr size_t WS_ROPES = WS_ROPEC + (size_t)2048 * 32 * 4;
constexpr size_t WS_SSMB = WS_ROPES + (size_t)2048 * 32 * 4;
constexpr size_t WS_SSMC = WS_SSMB + (size_t)128 * 4096;
constexpr size_t WS_SSML = WS_SSMC + (size_t)128 * 4096;
constexpr size_t WS_SSEG = WS_SSML + (size_t)128 * 512;
constexpr size_t WS_YB = WS_SSEG + (size_t)32 * 2 * 32 * 64 * 2 * 4;
constexpr size_t WS_MODP = WS_YB + (size_t)NTOK * 512 * 4;
constexpr size_t WS_XB = WS_MODP + (size_t)4 * 61440 * 4;
constexpr size_t WS_END = WS_XB + (size_t)NTOK * 1024 * 2;
constexpr size_t OUT_K = (size_t)2 * 8388608, OUT_V = OUT_K + 2097152, OUT_S = OUT_V + 2097152;
constexpr int LDS_BYTES = 131072 + 16;

#ifndef REP_NORM
#define REP_NORM 1
#endif
#ifndef REP_IN
#define REP_IN 1
#endif
#ifndef REP_ATT3
#define REP_ATT3 1
#endif
#ifndef REP_ATT4
#define REP_ATT4 1
#endif
#ifndef REP_GLU
#define REP_GLU 1
#endif
#ifndef REP_F1
#define REP_F1 1
#endif
#ifndef REP_P0
#define REP_P0 1
#endif
struct Params { const float* in[28]; float* out; unsigned char* ws; };

DI unsigned pk2(float lo, float hi) { f32x2 v = {lo, hi}; return __builtin_bit_cast(unsigned, __builtin_convertvector(v, bf16x2_t)); }
DI float bf2f(bf16_t b) { return __uint_as_float(((unsigned)b) << 16); }
DI float bflo(unsigned w) { return __uint_as_float(w << 16); }
DI float bfhi(unsigned w) { return __uint_as_float(w & 0xffff0000u); }
DI bf16x8 pack8(float a0, float a1, float a2, float a3, float a4, float a5, float a6, float a7) {
    u32x4 p; p.x = pk2(a0, a1); p.y = pk2(a2, a3); p.z = pk2(a4, a5); p.w = pk2(a6, a7); return __builtin_bit_cast(bf16x8, p); }
DI f32x16 mfma32(bf16x8 a, bf16x8 b, f32x16 c) { return __builtin_amdgcn_mfma_f32_32x32x16_bf16(a, b, c, 0, 0, 0); }
DI f32x16 mfma32p(bf16x8 a, bf16x8 b, f32x16 c) { __builtin_amdgcn_s_setprio(1); f32x16 r = __builtin_amdgcn_mfma_f32_32x32x16_bf16(a, b, c, 0, 0, 0); __builtin_amdgcn_s_setprio(0); return r; }
DI f32x4 mfma16(bf16x8 a, bf16x8 b, f32x4 c) { return __builtin_amdgcn_mfma_f32_16x16x32_bf16(a, b, c, 0, 0, 0); }
DI f32x2 gelu_pk(f32x2 v) {
    const f32x2 av = __builtin_elementwise_abs(v), d = av * 0.2316418882f + 1.0f;
    f32x2 t; t.x = __builtin_amdgcn_rcpf(d.x); t.y = __builtin_amdgcn_rcpf(d.y);
    f32x2 q = t * 0.5307027145f + (-0.7265760135f); q = q * t + 0.7107068705f; q = q * t + (-0.142248368f); q = q * t + 0.127414796f; q = q * t;
    const f32x2 sq = (v * v) * (-0.72134752044f);
    f32x2 e; e.x = __builtin_amdgcn_exp2f(sq.x); e.y = __builtin_amdgcn_exp2f(sq.y);
    const f32x2 m = v * (q * e), r = v - m;
    f32x2 o; o.x = v.x < 0.f ? m.x : r.x; o.y = v.y < 0.f ? m.y : r.y; return o;
}
#define GAS __attribute__((address_space(1)))
DI u32x2 ldg8(const void* p) { return *(const GAS u32x2*)p; }
DI u32x4 ldg16(const void* p) { return *(const GAS u32x4*)p; }
DI f32x4 ldg16f(const void* p) { return *(const GAS f32x4*)p; }
DI f32x2 ldg8f(const void* p) { return *(const GAS f32x2*)p; }
DI void stg8(void* p, u32x2 v) { *(GAS u32x2*)p = v; }
DI void stg16(void* p, u32x4 v) { *(GAS u32x4*)p = v; }
DI void stg16f(void* p, f32x4 v) { *(GAS f32x4*)p = v; }
DI float sigmoidf_(float x) { return __builtin_amdgcn_rcpf(1.0f + __expf(-x)); }

DI void tconv_tile(const float* __restrict__ src, size_t sld, int ca, int cb, bf16_t* __restrict__ dst, size_t dld, float* lds, int wv) {
    const int tid = ltid(wv);
#pragma unroll
    for (int i = 0; i < 8; ++i) { const int idx = i * 512 + tid, kk = idx >> 6, nn = idx & 63; const int col = nn < 32 ? ca + nn : cb + nn - 32;
        lds[nn * 65 + kk] = src[(size_t)kk * sld + col]; }
    __syncthreads();
    { const int nn = tid >> 3, k8 = (tid & 7) * 8; const float* r = lds + nn * 65 + k8;
      u32x4 w; w.x = pk2(r[0], r[1]); w.y = pk2(r[2], r[3]); w.z = pk2(r[4], r[5]); w.w = pk2(r[6], r[7]);
      *(u32x4*)(dst + (size_t)nn * dld + k8) = w; }
    __syncthreads();
}
DI int srccol_in(int np) { const int pn = np >> 8, cpos = np & 255, bj = cpos >> 7, wc = (cpos >> 5) & 3, w = cpos & 31; return pn * 256 + wc * 64 + bj * 32 + w; }
DI int srccol_f1(int np) { const int tile = np >> 8, bj = (np >> 7) & 1, i = np & 127; return bj * 2816 + tile * 128 + i; }

DI void wconv_task(const Params& P, int t, float* lds, int wv) {
    const int l = t / 2752; int r = t % 2752;
    unsigned char* ws = P.ws;
    if (r < 320) { const int kt = r & 15, ntl = r >> 4, n0 = ntl * 64, k0 = kt * 64;
        tconv_tile(P.in[11] + ((size_t)l * 1024 + k0) * 1280, 1280, srccol_in(n0), srccol_in(n0 + 32), (bf16_t*)(ws + WS_WIN + l * SZ_WIN) + (size_t)n0 * 1024 + k0, 1024, lds, wv); return; }
    r -= 320;
    if (r < 64) { const int kt = r & 7, ntl = r >> 3, n0 = ntl * 64, k0 = kt * 64;
        tconv_tile(P.in[22] + ((size_t)l * 512 + k0) * 512, 512, n0, n0 + 32, (bf16_t*)(ws + WS_WGLU + l * SZ_WGLU) + (size_t)n0 * 512 + k0, 512, lds, wv); return; }
    r -= 64;
    if (r < 256) { const int kt = r & 15, ntl = r >> 4, n0 = ntl * 64, k0 = kt * 64;
        tconv_tile(P.in[24] + ((size_t)l * 1024 + k0) * 1024, 1024, n0, n0 + 32, (bf16_t*)(ws + WS_WOUT + l * SZ_WOUT) + (size_t)n0 * 1024 + k0, 1024, lds, wv); return; }
    r -= 256;
    if (r < 1408) { const int kt = r & 15, ntl = r >> 4, n0 = ntl * 64, k0 = kt * 64;
        tconv_tile(P.in[25] + ((size_t)l * 1024 + k0) * 5632, 5632, srccol_f1(n0), srccol_f1(n0 + 32), (bf16_t*)(ws + WS_WF1 + l * SZ_WF1) + (size_t)n0 * 1024 + k0, 1024, lds, wv); return; }
    r -= 1408;
    { const int kt = r % 44, ntl = r / 44, n0 = ntl * 64, k0 = kt * 64;
        tconv_tile(P.in[26] + ((size_t)l * 2816 + k0) * 1024, 1024, n0, n0 + 32, (bf16_t*)(ws + WS_WF2 + l * SZ_WF2) + (size_t)n0 * 2816 + k0, 2816, lds, wv); }
}

DI void adaln_task(const Params& P, int task, float* lds, int wv) {
    const int tid = ltid(wv), w = tid >> 6, lane = tid & 63;
    const int kc = task & 3, cgp = (task >> 2) % 24, l = task / 96;
    const int n = cgp * 256 + lane * 4;
    const int k0 = kc * 256 + w * 32;
    const float* wm = P.in[7] + ((size_t)l * 1024 + k0) * 6144 + n;
    const float* cc = P.in[5]; const float* cx = P.in[6];
    f32x4 wrow[32];
#pragma unroll
    for (int kk = 0; kk < 32; ++kk) wrow[kk] = *(const f32x4*)(wm + (size_t)kk * 6144);
    f32x4 acc[5];
#pragma unroll
    for (int j = 0; j < 5; ++j) acc[j] = (f32x4){0.f, 0.f, 0.f, 0.f};
#pragma unroll
    for (int kk = 0; kk < 32; ++kk) { const int k = k0 + kk;
#pragma unroll
        for (int j = 0; j < 5; ++j) { const float cv = (j == 0) ? cx[k] : cc[(j - 1) * 1024 + k]; const float sv = cv / (1.0f + __expf(-cv)); acc[j] += wrow[kk] * sv; } }
#pragma unroll
    for (int j = 0; j < 5; ++j) *(f32x4*)(lds + (w * 5 + j) * 256 + lane * 4) = acc[j];
    __syncthreads();
    float* part = (float*)(P.ws + WS_MODP) + (size_t)kc * 61440;
    for (int e = tid; e < 1280; e += 512) { const int j = e >> 8, col = e & 255; float sm = 0.f;
#pragma unroll
        for (int ww = 0; ww < 8; ++ww) sm += lds[(ww * 5 + j) * 256 + col];
        part[(l * 5 + j) * 6144 + cgp * 256 + col] = sm; }
    __syncthreads();
}

DI void ssmconst_task(const Params& P, int task, int wv) {
    const int idx = task * 512 + ltid(wv); const int p = idx & 63, ldg = idx >> 6;
    const double dt = exp((double)P.in[16][ldg]); const double ar = (double)P.in[14][ldg * 64 + p], ai = (double)P.in[15][ldg * 64 + p];
    const double mag = exp(ar * dt); double sn, cs; sincos(ai * dt, &sn, &cs);
    const double lr = mag * cs, li = mag * sn, den = ar * ar + ai * ai;
    const double zr = ((lr - 1.0) * ar + li * ai) / den, zi = (li * ar - (lr - 1.0) * ai) / den;
    float* lam = (float*)(P.ws + WS_SSML); lam[(ldg * 64 + p) * 2] = (float)lr; lam[(ldg * 64 + p) * 2 + 1] = (float)li;
    bf16_t* Bm = (bf16_t*)(P.ws + WS_SSMB); bf16_t* Cm = (bf16_t*)(P.ws + WS_SSMC);
    const float* bre = P.in[17] + ((size_t)ldg * 64 + p) * 16; const float* bim = P.in[18] + ((size_t)ldg * 64 + p) * 16;
    const int ntb = (p >= 32) ? 2 : 0;
    for (int h = 0; h < 16; ++h) { const double br = bre[h], bi = bim[h]; const float bbr = (float)(zr * br - zi * bi), bbi = (float)(zr * bi + zi * br);
        const int ln = (p & 31) + 32 * (h >> 3), j = h & 7;
        Bm[(((size_t)ldg * 4 + ntb) * 64 + ln) * 8 + j] = (bf16_t)(pk2(bbr, 0.f) & 0xffffu);
        Bm[(((size_t)ldg * 4 + ntb + 1) * 64 + ln) * 8 + j] = (bf16_t)(pk2(bbi, 0.f) & 0xffffu); }
    for (int hp = 0; hp < 16; ++hp) { const float cr = P.in[19][((size_t)ldg * 16 + hp) * 64 + p], ci = P.in[20][((size_t)ldg * 16 + hp) * 64 + p];
#pragma unroll
        for (int ri = 0; ri < 2; ++ri) { const int pp = 2 * p + ri, ks = pp >> 5, kq = (pp >> 3) & 3, j = pp & 7;
            Cm[(((size_t)ldg * 4 + ks) * 64 + kq * 16 + hp) * 8 + j] = (bf16_t)(pk2(ri ? -ci : cr, 0.f) & 0xffffu); } }
}

DI void phase0(const Params& P, unsigned char* shm, int wv) {
    float* lds = (float*)shm;
    constexpr int T_ADA = 192, T_W = 5504, T_V = 128, T_K = 128, T_S = 16, T_R = 128;
    constexpr int T_TOTAL = T_ADA + T_W + T_V + T_K + T_S + T_R;
    for (int rep = 0; rep < REP_P0; ++rep)
    for (int t = blockIdx.x; t < T_TOTAL; t += gridDim.x) {
        int r = t;
        if (r < T_ADA) { adaln_task(P, r, lds, wv); continue; }
        r -= T_ADA;
        if (r < T_W) { wconv_task(P, r, lds, wv); continue; }
        r -= T_W;
        if (r < T_V) { const int s8 = r & 7, kvh = (r >> 3) & 1, b = (r >> 4) & 3, l = r >> 6;
            tconv_tile(P.in[3] + (((size_t)(b * 2 + l) * 512 + s8 * 64) * 2 + kvh) * 64, 128, 0, 32,
                       (bf16_t*)(P.ws + WS_VLAT + l * SZ_KLAT) + ((size_t)(b * 2 + kvh) * 64) * 2560 + s8 * 64, 2560, lds, wv); continue; }
        r -= T_V;
        if (r < T_K) { const int idx = r * 4096 + ltid(wv) * 8; const int d = idx & 63, s = (idx >> 6) & 511, kvh = (idx >> 15) & 1, b = (idx >> 16) & 3, l = idx >> 18;
            const float* src = P.in[2] + ((((size_t)(b * 2 + l) * 512 + s) * 2 + kvh) * 64 + d);
            const f32x4 a = *(const f32x4*)src, c = *(const f32x4*)(src + 4);
            u32x4 w; w.x = pk2(a[0], a[1]); w.y = pk2(a[2], a[3]); w.z = pk2(c[0], c[1]); w.w = pk2(c[2], c[3]);
            *(u32x4*)((bf16_t*)(P.ws + WS_KLAT + l * SZ_KLAT) + ((size_t)(b * 2 + kvh) * 2560 + s) * 64 + d) = w; continue; }
        r -= T_K;
        if (r < T_S) { ssmconst_task(P, r, wv); continue; }
        r -= T_S;
        { const int idx = r * 512 + ltid(wv); const int tt = idx >> 5, i = idx & 31; const int pos = (i < 16) ? (tt >> 6) : (tt & 63); const int f = i & 15;
          const double inv = pow(10000.0, -(2.0 * f) / 32.0); double sn, cs; sincos((double)pos * inv, &sn, &cs);
          ((float*)(P.ws + WS_ROPEC))[idx] = (float)cs; ((float*)(P.ws + WS_ROPES))[idx] = (float)sn; }
    }
}

DI float wave_sum(float v, int lane) {
    v += shx(v, 32, lane); v += shx(v, 16, lane); v += shx(v, 8, lane); v += shx(v, 4, lane); v += shx(v, 2, lane); v += shx(v, 1, lane); return v; }

DI void norm_phase(const float* __restrict__ xa, const float* __restrict__ xb, const bf16_t* __restrict__ xh, const float* __restrict__ gw, const float* mbase, int jstride, int sh_off, int sc_off, bf16_t* __restrict__ H, int wv) {
    const int tidl = ltid(wv); const int lane = tidl & 63, w = tidl >> 6;
    for (int base = (blockIdx.x * 8 + w) * 8; base < NTOK; base += gridDim.x * 64) {
        const int j = base < NCTX ? 0 : 1 + ((base - NCTX) >> 11);
        f32x4 wv4[4], sh4[4];
#pragma unroll
        for (int i = 0; i < 4; ++i) { const int col = i * 256 + lane * 4;
            const f32x4 g4 = ldg16f(gw + col), sc = *(const f32x4*)(mbase + j * jstride + sc_off + col); sh4[i] = *(const f32x4*)(mbase + j * jstride + sh_off + col); wv4[i] = g4 * (sc + 1.0f); }
#pragma unroll
        for (int hb = 0; hb < 2; ++hb) {
            f32x4 v[4][4]; float ss[4];
            if (xh) { u32x2 t[4][4];
#pragma unroll
                for (int r = 0; r < 4; ++r)
#pragma unroll
                    for (int i = 0; i < 4; ++i) t[r][i] = ldg8(xh + (size_t)(base + hb * 4 + r) * 1024 + i * 256 + lane * 4);
#pragma unroll
                for (int r = 0; r < 4; ++r)
#pragma unroll
                    for (int i = 0; i < 4; ++i) v[r][i] = (f32x4){bflo(t[r][i].x), bfhi(t[r][i].x), bflo(t[r][i].y), bfhi(t[r][i].y)};
            } else { const float* xr = base < NCTX ? xa + (size_t)(base + hb * 4) * 1024 : xb + (size_t)(base + hb * 4 - NCTX) * 1024;
#pragma unroll
                for (int r = 0; r < 4; ++r)
#pragma unroll
                    for (int i = 0; i < 4; ++i) v[r][i] = ldg16f(xr + (size_t)r * 1024 + i * 256 + lane * 4); }
#pragma unroll
            for (int r = 0; r < 4; ++r) { float a = 0.f;
#pragma unroll
                for (int i = 0; i < 4; ++i) a += v[r][i][0] * v[r][i][0] + v[r][i][1] * v[r][i][1] + v[r][i][2] * v[r][i][2] + v[r][i][3] * v[r][i][3];
                ss[r] = a; }
#pragma unroll
            for (int mk = 32; mk >= 1; mk >>= 1)
#pragma unroll
                for (int r = 0; r < 4; ++r) ss[r] += shx(ss[r], mk, lane);
#pragma unroll
            for (int r = 0; r < 4; ++r) { const float rstd = rsqrtf(ss[r] * (1.0f / 1024.0f) + 1e-6f);
#pragma unroll
                for (int i = 0; i < 4; ++i) { const f32x4 o = v[r][i] * rstd * wv4[i] + sh4[i];
                    u32x2 pw; pw.x = pk2(o[0], o[1]); pw.y = pk2(o[2], o[3]); stg8(H + (size_t)(base + hb * 4 + r) * 1024 + i * 256 + lane * 4, pw); } }
        }
    }
}

DI void final_norm_phase(const bf16_t* __restrict__ xh, float* __restrict__ Y, const float* __restrict__ gw, int wv) {
    const int tidl = ltid(wv); const int lane = tidl & 63, w = tidl >> 6;
    for (int base = (blockIdx.x * 8 + w) * 8; base < NTOK; base += gridDim.x * 64) {
        f32x4 g4[4];
#pragma unroll
        for (int i = 0; i < 4; ++i) g4[i] = ldg16f(gw + i * 256 + lane * 4);
#pragma unroll
        for (int hb = 0; hb < 2; ++hb) {
            u32x2 t[4][4]; float ss[4];
#pragma unroll
            for (int r = 0; r < 4; ++r)
#pragma unroll
                for (int i = 0; i < 4; ++i) t[r][i] = ldg8(xh + (size_t)(base + hb * 4 + r) * 1024 + i * 256 + lane * 4);
            f32x4 v[4][4];
#pragma unroll
            for (int r = 0; r < 4; ++r) { float a = 0.f;
#pragma unroll
                for (int i = 0; i < 4; ++i) { v[r][i] = (f32x4){bflo(t[r][i].x), bfhi(t[r][i].x), bflo(t[r][i].y), bfhi(t[r][i].y)}; a += v[r][i][0] * v[r][i][0] + v[r][i][1] * v[r][i][1] + v[r][i][2] * v[r][i][2] + v[r][i][3] * v[r][i][3]; }
                ss[r] = a; }
#pragma unroll
            for (int mk = 32; mk >= 1; mk >>= 1)
#pragma unroll
                for (int r = 0; r < 4; ++r) ss[r] += shx(ss[r], mk, lane);
#pragma unroll
            for (int r = 0; r < 4; ++r) { const float rstd = rsqrtf(ss[r] * (1.0f / 1024.0f) + 1e-6f);
#pragma unroll
                for (int i = 0; i < 4; ++i) stg16f(Y + (size_t)(base + hb * 4 + r) * 1024 + i * 256 + lane * 4, v[r][i] * rstd * g4[i]); }
        }
    }
}

struct EpiIn {
    static constexpr bool PERM = false, AFTER_DRAIN = false;
    int layer; const float* qn; const float* kn; const float* ropec; const float* ropes;
    bf16_t* Q; bf16_t* U; bf16_t* Kctx; bf16_t* Vctx; bf16_t* Klat; bf16_t* Vlat; float* outk; float* outv;
    DI void operator()(const f32x4 (&acc)[2][2][4][2], const pg8::Unit& u, int wr, int wc, int fr, int fq) const {
        asm volatile("" : "+v"(fr), "+v"(fq));
        const bool lat = u.pm >= 32; const int pn = u.pn;
        if (pn >= 3) {
#pragma unroll
            for (int ai = 0; ai < 2; ++ai)
#pragma unroll
                for (int m = 0; m < 4; ++m) { const int row = u.pm * 256 + ai * 128 + wr * 64 + m * 16 + fr;
#pragma unroll
                    for (int bj = 0; bj < 2; ++bj)
#pragma unroll
                        for (int n = 0; n < 2; ++n) { const int col = (pn - 3) * 256 + 64 * wc + 32 * bj + 16 * n + 4 * fq; const f32x4 a = acc[ai][bj][m][n];
                            u32x2 pw; pw.x = pk2(a[0], a[1]); pw.y = pk2(a[2], a[3]); *(u32x2*)(U + (size_t)row * 512 + col) = pw; } }
            return;
        }
        if (pn == 2 && wc >= 2) {
            const int kvh = wc - 2;
#pragma unroll
            for (int ai = 0; ai < 2; ++ai)
#pragma unroll
                for (int m = 0; m < 4; ++m) { const int row = u.pm * 256 + ai * 128 + wr * 64 + m * 16 + fr;
                    if (!lat) { const int b = row >> 8, t = row & 255; float* ov = outv + (((size_t)(b * 2 + layer) * 256 + t) * 2 + kvh) * 64; bf16_t* vt = Vctx + ((size_t)(b * 2 + kvh) * 64) * 256 + t;
#pragma unroll
                        for (int bj = 0; bj < 2; ++bj)
#pragma unroll
                            for (int n = 0; n < 2; ++n) { const int d = 32 * bj + 16 * n + 4 * fq; const f32x4 a = acc[ai][bj][m][n]; *(f32x4*)(ov + d) = a;
                                const unsigned p0 = pk2(a[0], a[1]), p1 = pk2(a[2], a[3]);
                                vt[(size_t)(d + 0) * 256] = (bf16_t)(p0 & 0xffffu); vt[(size_t)(d + 1) * 256] = (bf16_t)(p0 >> 16); vt[(size_t)(d + 2) * 256] = (bf16_t)(p1 & 0xffffu); vt[(size_t)(d + 3) * 256] = (bf16_t)(p1 >> 16); } }
                    else { const int rl = row - NCTX, b = rl >> 11, t = rl & 2047; bf16_t* vt = Vlat + ((size_t)(b * 2 + kvh) * 64) * 2560 + 512 + t;
#pragma unroll
                        for (int bj = 0; bj < 2; ++bj)
#pragma unroll
                            for (int n = 0; n < 2; ++n) { const int d = 32 * bj + 16 * n + 4 * fq; const f32x4 a = acc[ai][bj][m][n];
                                const unsigned p0 = pk2(a[0], a[1]), p1 = pk2(a[2], a[3]);
                                vt[(size_t)(d + 0) * 2560] = (bf16_t)(p0 & 0xffffu); vt[(size_t)(d + 1) * 2560] = (bf16_t)(p0 >> 16); vt[(size_t)(d + 2) * 2560] = (bf16_t)(p1 & 0xffffu); vt[(size_t)(d + 3) * 2560] = (bf16_t)(p1 >> 16); } } }
            return;
        }
        const bool isq = pn < 2; const float* nw = isq ? qn : kn;
        f32x4 w4[2][2];
#pragma unroll
        for (int bj = 0; bj < 2; ++bj)
#pragma unroll
            for (int n = 0; n < 2; ++n) w4[bj][n] = *(const f32x4*)(nw + 32 * bj + 16 * n + 4 * fq);
        const float qscale = isq ? 0.125f * 1.4426950408889634f : 1.0f;
        f32x2 rc[2][2], rsn[2][2], cc[4][2], csn[4][2];
        if (lat) { const int T0 = (u.pm * 256 - NCTX) & 2047;
#pragma unroll
            for (int ai = 0; ai < 2; ++ai)
#pragma unroll
                for (int n = 0; n < 2; ++n) { const int o = (T0 + 128 * ai + 64 * wr) * 32 + 8 * n + 2 * fq; rc[ai][n] = ldg8f(ropec + o); rsn[ai][n] = ldg8f(ropes + o); }
#pragma unroll
            for (int m = 0; m < 4; ++m)
#pragma unroll
                for (int n = 0; n < 2; ++n) { const int o = (16 * m + fr) * 32 + 16 + 8 * n + 2 * fq; cc[m][n] = ldg8f(ropec + o); csn[m][n] = ldg8f(ropes + o); } }
#pragma unroll
        for (int ai = 0; ai < 2; ++ai)
#pragma unroll
            for (int m = 0; m < 4; ++m) { const int row = u.pm * 256 + ai * 128 + wr * 64 + m * 16 + fr;
                float ss = 0.f;
#pragma unroll
                for (int bj = 0; bj < 2; ++bj)
#pragma unroll
                    for (int n = 0; n < 2; ++n) { const f32x4 a = acc[ai][bj][m][n]; ss += a[0] * a[0] + a[1] * a[1] + a[2] * a[2] + a[3] * a[3]; }
                ss += shx(ss, 16, fq * 16 + fr); ss += shx(ss, 32, fq * 16 + fr);
                const float rstd = rsqrtf(ss * (1.0f / 64.0f) + 1e-6f);
                f32x4 v[2][2];
#pragma unroll
                for (int bj = 0; bj < 2; ++bj)
#pragma unroll
                    for (int n = 0; n < 2; ++n) v[bj][n] = acc[ai][bj][m][n] * rstd * w4[bj][n];
                if (!lat) {
                    const int b = row >> 8, t = row & 255;
                    if (isq) { bf16_t* qp = Q + (size_t)row * 512 + (pn * 4 + wc) * 64;
#pragma unroll
                        for (int bj = 0; bj < 2; ++bj)
#pragma unroll
                            for (int n = 0; n < 2; ++n) { const f32x4 a = v[bj][n] * qscale; u32x2 pw; pw.x = pk2(a[0], a[1]); pw.y = pk2(a[2], a[3]); *(u32x2*)(qp + 32 * bj + 16 * n + 4 * fq) = pw; } }
                    else { const int kvh = wc; float* ok = outk + (((size_t)(b * 2 + layer) * 256 + t) * 2 + kvh) * 64; bf16_t* kp = Kctx + ((size_t)(b * 2 + kvh) * 256 + t) * 64;
#pragma unroll
                        for (int bj = 0; bj < 2; ++bj)
#pragma unroll
                            for (int n = 0; n < 2; ++n) { const int d = 32 * bj + 16 * n + 4 * fq; const f32x4 a = v[bj][n]; *(f32x4*)(ok + d) = a;
                                u32x2 pw; pw.x = pk2(a[0], a[1]); pw.y = pk2(a[2], a[3]); *(u32x2*)(kp + d) = pw; } }
                } else {
                    const int rl = row - NCTX, b = rl >> 11, t = rl & 2047;
                    bf16_t* dst = isq ? Q + (size_t)row * 512 + (pn * 4 + wc) * 64 : Klat + ((size_t)(b * 2 + wc) * 2560 + 512 + t) * 64;
#pragma unroll
                    for (int bj = 0; bj < 2; ++bj)
#pragma unroll
                        for (int n = 0; n < 2; ++n) { const int d = 32 * bj + 16 * n + 4 * fq; const int pi = d >> 1;
                            const f32x2 c2 = bj == 0 ? rc[ai][n] : cc[m][n], s2 = bj == 0 ? rsn[ai][n] : csn[m][n]; const f32x4 a = v[bj][n];
                            const float o0 = (a[0] * c2[0] - a[1] * s2[0]) * qscale, o1 = (a[0] * s2[0] + a[1] * c2[0]) * qscale, o2 = (a[2] * c2[1] - a[3] * s2[1]) * qscale, o3 = (a[2] * s2[1] + a[3] * c2[1]) * qscale;
                            u32x2 pw; pw.x = pk2(o0, o1); pw.y = pk2(o2, o3); *(u32x2*)(dst + d) = pw; }
                }
            }
    }
};

struct EpiGlu {
    static constexpr bool PERM = true, AFTER_DRAIN = false;
    const bf16_t* G; const float* bias; bf16_t* MIX;
    DI void operator()(const f32x4 (&acc)[2][2][4][2], const pg8::Unit& u, int wr, int wc, int fr, int fq) const {
        asm volatile("" : "+v"(fr), "+v"(fq));
        const int cb = u.pn * 256 + 32 * wc + 8 * fq, rb = u.pm * 256 + wr * 64 + fr;
        f32x4 bv[2][2]; u32x4 gw[2][4][2];
#pragma unroll
        for (int bj = 0; bj < 2; ++bj) { bv[bj][0] = ldg16f(bias + cb + 128 * bj); bv[bj][1] = ldg16f(bias + cb + 128 * bj + 4); }
#pragma unroll
        for (int ai = 0; ai < 2; ++ai)
#pragma unroll
            for (int m = 0; m < 4; ++m)
#pragma unroll
                for (int bj = 0; bj < 2; ++bj) gw[ai][m][bj] = ldg16(G + (size_t)(rb + 128 * ai + 16 * m) * 512 + cb + 128 * bj);
#pragma unroll
        for (int ai = 0; ai < 2; ++ai)
#pragma unroll
            for (int m = 0; m < 4; ++m)
#pragma unroll
                for (int bj = 0; bj < 2; ++bj) { const u32x4 g4 = gw[ai][m][bj];
                    const f32x4 v0 = acc[ai][bj][m][0] + bv[bj][0], v1 = acc[ai][bj][m][1] + bv[bj][1];
                    u32x4 o;
                    o.x = pk2(bflo(g4.x) * sigmoidf_(v0[0]), bfhi(g4.x) * sigmoidf_(v0[1])); o.y = pk2(bflo(g4.y) * sigmoidf_(v0[2]), bfhi(g4.y) * sigmoidf_(v0[3]));
                    o.z = pk2(bflo(g4.z) * sigmoidf_(v1[0]), bfhi(g4.z) * sigmoidf_(v1[1])); o.w = pk2(bflo(g4.w) * sigmoidf_(v1[2]), bfhi(g4.w) * sigmoidf_(v1[3]));
                    stg16(MIX + (size_t)(rb + 128 * ai + 16 * m) * 1024 + 512 + cb + 128 * bj, o); }
    }
};

struct EpiRes {
    static constexpr bool PERM = true, AFTER_DRAIN = false;
    const float* xa; const float* xb; const bf16_t* xh; bf16_t* Xo; const float* gate;
    DI void operator()(const f32x4 (&acc)[2][2][4][2], const pg8::Unit& u, int wr, int wc, int fr, int fq) const {
        asm volatile("" : "+v"(fr), "+v"(fq));
        const int j = u.pm < 32 ? 0 : 1 + ((u.pm - 32) >> 3);
        const int cb = u.pn * 256 + 32 * wc + 8 * fq, rb = u.pm * 256 + wr * 64 + fr;
        const float* gt = gate + j * 6144 + cb;
        f32x4 gv[2][2];
#pragma unroll
        for (int bj = 0; bj < 2; ++bj)
#pragma unroll
            for (int n = 0; n < 2; ++n) gv[bj][n] = ldg16f(gt + 128 * bj + 4 * n);
        if (xh) {
#pragma unroll
            for (int ai = 0; ai < 2; ++ai) {
                u32x4 xr[4][2];
#pragma unroll
                for (int m = 0; m < 4; ++m)
#pragma unroll
                    for (int bj = 0; bj < 2; ++bj) xr[m][bj] = ldg16(xh + (size_t)(rb + 128 * ai + 16 * m) * 1024 + cb + 128 * bj);
#pragma unroll
                for (int m = 0; m < 4; ++m)
#pragma unroll
                    for (int bj = 0; bj < 2; ++bj) { const u32x4 t = xr[m][bj];
                        const f32x4 x0 = (f32x4){bflo(t.x), bfhi(t.x), bflo(t.y), bfhi(t.y)} + gv[bj][0] * acc[ai][bj][m][0];
                        const f32x4 x1 = (f32x4){bflo(t.z), bfhi(t.z), bflo(t.w), bfhi(t.w)} + gv[bj][1] * acc[ai][bj][m][1];
                        u32x4 pw; pw.x = pk2(x0[0], x0[1]); pw.y = pk2(x0[2], x0[3]); pw.z = pk2(x1[0], x1[1]); pw.w = pk2(x1[2], x1[3]);
                        stg16(Xo + (size_t)(rb + 128 * ai + 16 * m) * 1024 + cb + 128 * bj, pw); }
            }
        } else {
            const float* xs = u.pm < 32 ? xa + (size_t)rb * 1024 : xb + (size_t)(rb - NCTX) * 1024;
#pragma unroll
            for (int ai = 0; ai < 2; ++ai) {
                f32x4 xr[4][2][2];
#pragma unroll
                for (int m = 0; m < 4; ++m)
#pragma unroll
                    for (int bj = 0; bj < 2; ++bj)
#pragma unroll
                        for (int n = 0; n < 2; ++n) xr[m][bj][n] = ldg16f(xs + (size_t)(128 * ai + 16 * m) * 1024 + cb + 128 * bj + 4 * n);
#pragma unroll
                for (int m = 0; m < 4; ++m)
#pragma unroll
                    for (int bj = 0; bj < 2; ++bj) { const f32x4 x0 = xr[m][bj][0] + gv[bj][0] * acc[ai][bj][m][0], x1 = xr[m][bj][1] + gv[bj][1] * acc[ai][bj][m][1];
                        u32x4 pw; pw.x = pk2(x0[0], x0[1]); pw.y = pk2(x0[2], x0[3]); pw.z = pk2(x1[0], x1[1]); pw.w = pk2(x1[2], x1[3]);
                        stg16(Xo + (size_t)(rb + 128 * ai + 16 * m) * 1024 + cb + 128 * bj, pw); }
            }
        }
    }
};

struct EpiFfn1 {
    static constexpr bool PERM = true, AFTER_DRAIN = false;
    bf16_t* ACT;
    DI void operator()(const f32x4 (&acc)[2][2][4][2], const pg8::Unit& u, int wr, int wc, int fr, int fq) const {
        asm volatile("" : "+v"(fr), "+v"(fq));
#pragma unroll
        for (int ai = 0; ai < 2; ++ai)
#pragma unroll
            for (int m = 0; m < 4; ++m) { const int row = u.pm * 256 + ai * 128 + wr * 64 + m * 16 + fr; const int a0 = u.pn * 128 + 32 * wc + 8 * fq;
                const f32x4 g0 = acc[ai][0][m][0], g1 = acc[ai][0][m][1], u0 = acc[ai][1][m][0], u1 = acc[ai][1][m][1];
                u32x4 o;
                o.x = pk2(g0[0] * sigmoidf_(g0[0]) * u0[0], g0[1] * sigmoidf_(g0[1]) * u0[1]); o.y = pk2(g0[2] * sigmoidf_(g0[2]) * u0[2], g0[3] * sigmoidf_(g0[3]) * u0[3]);
                o.z = pk2(g1[0] * sigmoidf_(g1[0]) * u1[0], g1[1] * sigmoidf_(g1[1]) * u1[1]); o.w = pk2(g1[2] * sigmoidf_(g1[2]) * u1[2], g1[3] * sigmoidf_(g1[3]) * u1[3]);
                *(u32x4*)(ACT + (size_t)row * 2816 + a0) = o; }
    }
};

struct ListOrder {
    int count, G, c, mode;
    DI bool next(int i, pg8::Unit& u) const {
        const int L0 = i * G + c; if (L0 >= count) return false;
        const int L = (L0 & 7) * (count >> 3) + (L0 >> 3);
        if (mode == 0) { const int pm = L >> 2, vn = L & 3; if (vn < 3) { u.pm = pm; u.pn = vn; } else { u.pm = 32 + (pm >> 1); u.pn = 3 + (pm & 1); } }
        else { u.pm = L >> 1; u.pn = 3 + (L & 1); }
        return true;
    }
    DI void a_ready(const pg8::Unit&) const {}
    DI void done(const pg8::Unit&) const {}
};

template <class Epi> DI void run_gemm(unsigned char* shm, const bf16_t* A, const bf16_t* Bt, int N, int K, const Epi& E, int wv) {
    pg8::Gemm g; g.A = A; g.Bt = Bt; g.M = NTOK; g.N = N; g.K = K;
    pg8::StaticOrder S; S.init(NTOK, N, (int)gridDim.x, (int)blockIdx.x);
    pg8::gemm_phase<Epi, pg8::StaticOrder, false>((PG8_LAS unsigned char*)shm, g, S, E, nullptr, wv);
}

DI void attn_item(const bf16_t* __restrict__ Q, const bf16_t* __restrict__ Kp, const bf16_t* __restrict__ Vp, int vld, int nkeys, int qtok0, int kvh, bf16_t* __restrict__ MIX, unsigned char* lds, int wv) {
    const int tid = ltid(wv), w = tid >> 6, lane = tid & 63, c = lane & 31, hh = lane >> 5;
    const int hq = kvh * 4 + (w & 3), qtok = qtok0 + 32 * (w >> 2) + c;
    bf16x8 qf[4];
#pragma unroll
    for (int s = 0; s < 4; ++s) qf[s] = __builtin_bit_cast(bf16x8, ldg16(Q + (size_t)qtok * 512 + hq * 64 + 16 * s + 8 * hh));
    unsigned char* Kb = lds; unsigned char* Vb = lds + 2 * 9216;
    const int srow = tid >> 3, sseg = tid & 7;
    const bf16_t* kg = Kp + (size_t)srow * 64 + sseg * 8;
    const bf16_t* vg = Vp + (size_t)srow * vld + sseg * 8;
    u32x4 kr = ldg16(kg), vr = ldg16(vg);
    *(u32x4*)(Kb + srow * 144 + sseg * 16) = kr;
    { u32x2* d = (u32x2*)(Vb + srow * 136 + sseg * 16); u32x2 a; a.x = vr.x; a.y = vr.y; u32x2 b; b.x = vr.z; b.y = vr.w; d[0] = a; d[1] = b; }
    __syncthreads();
    f32x16 ot[2];
#pragma unroll
    for (int i = 0; i < 16; ++i) { ot[0][i] = 0.f; ot[1][i] = 0.f; }
    float mrun = -1e30f, lsum = 0.f;
    const int nt = nkeys >> 6;
    for (int it = 0; it < nt; ++it) {
        const int cur = it & 1;
        if (it + 1 < nt) { kr = ldg16(kg + (size_t)(it + 1) * 4096); vr = ldg16(vg + (it + 1) * 64); }
        const unsigned char* kb = Kb + cur * 9216; const unsigned char* vb = Vb + cur * 8704;
        f32x16 st[2]; bf16x8 kf[2][4];
#pragma unroll
        for (int kt = 0; kt < 2; ++kt)
#pragma unroll
            for (int s = 0; s < 4; ++s) kf[kt][s] = *(const PG8_LAS bf16x8*)(const PG8_LAS unsigned char*)(kb + (32 * kt + c) * 144 + (16 * s + 8 * hh) * 2);
#pragma unroll
        for (int kt = 0; kt < 2; ++kt) {
#pragma unroll
            for (int i = 0; i < 16; ++i) st[kt][i] = 0.f;
#pragma unroll
            for (int s = 0; s < 4; ++s) st[kt] = mfma32p(kf[kt][s], qf[s], st[kt]); }
        float mx = fmaxf(fmaxf(st[0][0], st[0][1]), st[0][2]);
#pragma unroll
        for (int i = 3; i < 15; i += 2) mx = fmaxf(fmaxf(mx, st[0][i]), st[0][i + 1]);
        mx = fmaxf(mx, st[0][15]);
#pragma unroll
        for (int i = 0; i < 16; i += 2) mx = fmaxf(fmaxf(mx, st[1][i]), st[1][i + 1]);
        mx = fmaxf(mx, shx(mx, 32, lane));
        const float mnew = fmaxf(mrun, mx), alpha = __builtin_amdgcn_exp2f(mrun - mnew); mrun = mnew;
        f32x2 ps2 = (f32x2){0.f, 0.f}; const f32x2 mn2 = (f32x2){mnew, mnew};
#pragma unroll
        for (int kt = 0; kt < 2; ++kt)
#pragma unroll
            for (int i = 0; i < 16; i += 2) { f32x2 d = (f32x2){st[kt][i], st[kt][i + 1]} - mn2; f32x2 pp; pp.x = __builtin_amdgcn_exp2f(d.x); pp.y = __builtin_amdgcn_exp2f(d.y); st[kt][i] = pp.x; st[kt][i + 1] = pp.y; ps2 += pp; }
        const float ps = ps2.x + ps2.y;
        lsum = lsum * alpha + ps;
        if (__builtin_amdgcn_ballot_w64(alpha != 1.0f) != 0ull) {
#pragma unroll
            for (int i = 0; i < 16; ++i) { ot[0][i] *= alpha; ot[1][i] *= alpha; } }
        s16x4 vlo[2][2][2], vhi[2][2][2];
#pragma unroll
        for (int kt = 0; kt < 2; ++kt)
#pragma unroll
            for (int sp = 0; sp < 2; ++sp)
#pragma unroll
                for (int dt = 0; dt < 2; ++dt) { const PG8_LAS unsigned char* vrow = (const PG8_LAS unsigned char*)(vb + (32 * dt + c) * 136 + (32 * kt + 16 * sp + 4 * hh) * 2);
                    vlo[kt][sp][dt] = *(const PG8_LAS s16x4*)vrow; vhi[kt][sp][dt] = *(const PG8_LAS s16x4*)(vrow + 16); }
#pragma unroll
        for (int kt = 0; kt < 2; ++kt)
#pragma unroll
            for (int sp = 0; sp < 2; ++sp) {
                const bf16x8 pk = pack8(st[kt][8 * sp], st[kt][8 * sp + 1], st[kt][8 * sp + 2], st[kt][8 * sp + 3], st[kt][8 * sp + 4], st[kt][8 * sp + 5], st[kt][8 * sp + 6], st[kt][8 * sp + 7]);
#pragma unroll
                for (int dt = 0; dt < 2; ++dt) { const bf16x8 va = __builtin_shufflevector(vlo[kt][sp][dt], vhi[kt][sp][dt], 0, 1, 2, 3, 4, 5, 6, 7); ot[dt] = mfma32p(va, pk, ot[dt]); } }
        if (it + 1 < nt) { const int nx = cur ^ 1;
            *(u32x4*)(Kb + nx * 9216 + srow * 144 + sseg * 16) = kr;
            u32x2* d = (u32x2*)(Vb + nx * 8704 + srow * 136 + sseg * 16); u32x2 a; a.x = vr.x; a.y = vr.y; u32x2 b; b.x = vr.z; b.y = vr.w; d[0] = a; d[1] = b; }
        __syncthreads();
    }
    const float ltot = lsum + shx(lsum, 32, lane); const float inv = 1.0f / ltot;
    bf16_t* op = MIX + (size_t)qtok * 1024 + hq * 64;
#pragma unroll
    for (int dt = 0; dt < 2; ++dt)
#pragma unroll
        for (int g4 = 0; g4 < 4; ++g4) { u32x2 pw; pw.x = pk2(ot[dt][4 * g4] * inv, ot[dt][4 * g4 + 1] * inv); pw.y = pk2(ot[dt][4 * g4 + 2] * inv, ot[dt][4 * g4 + 3] * inv);
            stg8(op + 32 * dt + 8 * g4 + 4 * hh, pw); }
}

template <int DIR, bool FULL>
DI void ssm_pass(int layer, int pr, int g, const bf16_t* __restrict__ U, const bf16x8* __restrict__ Bm, const bf16x8* __restrict__ Cm, const float* __restrict__ lam,
                 const float* __restrict__ state_in, const float* sseg_r, float* sseg_w, float* YF, bf16_t* __restrict__ G, const float* __restrict__ dskip,
                 float* __restrict__ out_state, unsigned char* hl, int wv) {
    const int lane = ltid(wv) & 63, c = lane & 31, hh = lane >> 5, fr = lane & 15, kq = lane >> 4;
    const int ldg = (layer * 2 + DIR) * 32 + g;
    bf16x8 bm[4], cm[4];
#pragma unroll
    for (int i = 0; i < 4; ++i) { bm[i] = Bm[(ldg * 4 + i) * 64 + lane]; if (FULL) cm[i] = Cm[(ldg * 4 + i) * 64 + lane]; }
    const float l0r = lam[(ldg * 64 + c) * 2], l0i = lam[(ldg * 64 + c) * 2 + 1], l1r = lam[(ldg * 64 + 32 + c) * 2], l1i = lam[(ldg * 64 + 32 + c) * 2 + 1];
    const int s = 2 * pr + hh;
    float h0r = 0.f, h0i = 0.f, h1r = 0.f, h1i = 0.f;
    if (FULL && pr >= 16) {
        const int sl = s - 32, b = sl >> 3, seg = sl & 7;
        float a0r = l0r, a0i = l0i, a1r = l1r, a1i = l1i;
#pragma unroll
        for (int i = 0; i < 8; ++i) { const float t0 = a0r * a0r - a0i * a0i, t1 = 2.f * a0r * a0i; a0r = t0; a0i = t1; const float t2 = a1r * a1r - a1i * a1i, t3 = 2.f * a1r * a1i; a1r = t2; a1i = t3; }
        const float* si = state_in + ((((size_t)(b * 2 + layer) * 2 + DIR) * 2) * 32 + g) * 64;
        h0r = si[c]; h0i = si[2048 + c]; h1r = si[32 + c]; h1i = si[2048 + 32 + c];
        const int n = DIR == 0 ? seg : 7 - seg;
        for (int jj = 0; jj < n; ++jj) { const int j = DIR == 0 ? jj : 7 - jj;
            const float* sp = sseg_r + ((((size_t)(b * 8 + j) * 2 + DIR) * 32 + g) * 64) * 2;
            const float s0r = sp[c * 2], s0i = sp[c * 2 + 1], s1r = sp[(32 + c) * 2], s1i = sp[(32 + c) * 2 + 1];
            const float n0r = a0r * h0r - a0i * h0i + s0r, n0i = a0r * h0i + a0i * h0r + s0i; h0r = n0r; h0i = n0i;
            const float n1r = a1r * h1r - a1i * h1i + s1r, n1i = a1r * h1i + a1i * h1r + s1i; h1r = n1r; h1i = n1i; }
    }
    const int seq_r = (c >> 2) & 1, q_r = (c & 3) + 4 * (c >> 3);
    const bf16_t* ua_ptr = U + ((size_t)((2 * pr + seq_r) * 256 + q_r)) * 512 + g * 16 + 8 * hh;
    f32x16 zero16;
#pragma unroll
    for (int i = 0; i < 16; ++i) zero16[i] = 0.f;
    auto ldu = [&](int ch) -> bf16x8 { return __builtin_bit_cast(bf16x8, ldg16(ua_ptr + (size_t)(DIR ? 240 - 16 * ch : 16 * ch) * 512)); };
    auto body = [&](const bf16x8 ua, int ch) {
        const int cb = DIR ? 240 - 16 * ch : 16 * ch;
        f32x16 x[4];
#pragma unroll
        for (int i = 0; i < 4; ++i) x[i] = mfma32(ua, bm[i], zero16);
#pragma unroll
        for (int i = 0; i < 16; ++i) { const int reg = DIR ? 15 - i : i;
            const float n0r = __builtin_fmaf(l0r, h0r, __builtin_fmaf(-l0i, h0i, x[0][reg])), n0i = __builtin_fmaf(l0r, h0i, __builtin_fmaf(l0i, h0r, x[1][reg])); h0r = n0r; h0i = n0i;
            const float n1r = __builtin_fmaf(l1r, h1r, __builtin_fmaf(-l1i, h1i, x[2][reg])), n1i = __builtin_fmaf(l1r, h1i, __builtin_fmaf(l1i, h1r, x[3][reg])); h1r = n1r; h1i = n1i;
            if (FULL) { unsigned* hrow = (unsigned*)(hl + (hh * 16 + reg) * 272); hrow[c] = pk2(h0r, h0i); hrow[32 + c] = pk2(h1r, h1i); } }
        if (FULL) {
#pragma unroll
            for (int sq = 0; sq < 2; ++sq) { f32x4 y = (f32x4){0.f, 0.f, 0.f, 0.f};
#pragma unroll
                for (int ks = 0; ks < 4; ++ks) { const bf16x8 af = *(const bf16x8*)(hl + (sq * 16 + fr) * 272 + (32 * ks + 8 * kq) * 2); y = mfma16(cm[ks], af, y); }
                { u32x2 pw; pw.x = pk2(y[0], y[1]); pw.y = pk2(y[2], y[3]); stg8((bf16_t*)YF + ((size_t)((2 * pr + sq) * 256 + cb + fr)) * 512 + g * 16 + 4 * kq, pw); } }
        }
    };
    bf16x8 u0 = ldu(0), u1 = ldu(1), u2 = ldu(2), u3 = ldu(3);
#pragma unroll 1
    for (int c4 = 0; c4 < 16; c4 += 4) {
        const bool more = c4 + 4 < 16;
        body(u0, c4);     if (more) u0 = ldu(c4 + 4);
        body(u1, c4 + 1); if (more) u1 = ldu(c4 + 5);
        body(u2, c4 + 2); if (more) u2 = ldu(c4 + 6);
        body(u3, c4 + 3); if (more) u3 = ldu(c4 + 7);
    }
    if (FULL) { if (pr < 16) { float* os = out_state + ((((size_t)(s * 2 + layer) * 2 + DIR) * 2) * 32 + g) * 64; os[c] = h0r; os[2048 + c] = h0i; os[32 + c] = h1r; os[2048 + 32 + c] = h1i; } }
    else { float* sw = sseg_w + ((((size_t)(s - 32) * 2 + DIR) * 32 + g) * 64) * 2; sw[c * 2] = h0r; sw[c * 2 + 1] = h0i; sw[(32 + c) * 2] = h1r; sw[(32 + c) * 2 + 1] = h1i; }
}

#define XB_TMO      128
#define XB_XCNT(j)  (256  + 64 * (j))
#define XB_XSUB(j)  (1280 + 64 * (j))
#define XB_XGEN(j)  (2304 + 64 * (j))
#define XB_TOP      3328
#define XB_TOPGEN   3392
#define XCD_BAR_WORDS 3456
#define XB_SPIN_CAP (1u << 18)
#define LAS __attribute__((address_space(3)))

__device__ __forceinline__ unsigned xb_ld(unsigned* p)              { return __hip_atomic_load(p, __ATOMIC_RELAXED, __HIP_MEMORY_SCOPE_AGENT); }
__device__ __forceinline__ unsigned xb_add(unsigned* p, unsigned v) { return __hip_atomic_fetch_add(p, v, __ATOMIC_RELAXED, __HIP_MEMORY_SCOPE_AGENT); }
__device__ __forceinline__ unsigned xb_xcc_id() { return (unsigned)__builtin_amdgcn_s_getreg((3 << 11) | 20) & 0xFu; }
#define XB_SPIN(cond, bar) do { unsigned _sp = 0; while (cond) { __builtin_amdgcn_s_sleep(1); \
    if ((++_sp & 255u) == 0u) { if (xb_ld(&(bar)[XB_TMO])) break; if (_sp > XB_SPIN_CAP) { atomicAdd(&(bar)[XB_TMO], 1u); break; } } } } while (0)

struct XcdBarrier {
    unsigned* bar; unsigned x;
    volatile LAS unsigned* st;
};

__device__ __forceinline__ XcdBarrier xcd_barrier_post(unsigned* bar, volatile LAS unsigned* st) {
    XcdBarrier b; b.bar = bar; b.x = xb_xcc_id(); b.st = st;
    if (threadIdx.x == 0) (void)xb_add(&bar[XB_XCNT(b.x)], 1u);
    return b;
}
__device__ __forceinline__ void xcd_barrier_complete(unsigned* bar, unsigned x, unsigned& nloc, unsigned& nx) {
    const unsigned G = gridDim.x * gridDim.y * gridDim.z;
    unsigned sum, cnt, mine, sp = 0u;
    for (;;) {
        sum = 0u; cnt = 0u; mine = 0u;
#pragma unroll
        for (unsigned j = 0; j < 16; ++j) { const unsigned c = xb_ld(&bar[XB_XCNT(j)]); sum += c; cnt += (c > 0u) ? 1u : 0u; mine = (j == x) ? c : mine; }
        if (sum == G) break;
        __builtin_amdgcn_s_sleep(1);
        if ((++sp & 255u) == 0u) { if (xb_ld(&bar[XB_TMO])) break; if (sp > XB_SPIN_CAP) { atomicAdd(&bar[XB_TMO], 1u); break; } }
    }
    nloc = mine > 0u ? mine : 1u; nx = cnt > 0u ? cnt : 1u;
}

__device__ __forceinline__ void xcd_barrier(const XcdBarrier& b) {
    asm volatile("s_waitcnt vmcnt(0)" ::: "memory");
    __syncthreads();
    if (threadIdx.x == 0) {
        unsigned* bar = b.bar;
        __builtin_amdgcn_s_waitcnt(0);
        unsigned nloc = b.st[0], nx = b.st[1];
        if (nloc == 0u) { xcd_barrier_complete(bar, b.x, nloc, nx); b.st[0] = nloc; b.st[1] = nx; }
        const unsigned old = xb_add(&bar[XB_XSUB(b.x)], 1u);
        const unsigned gen = old / nloc;
        if (old + 1u == (gen + 1u) * nloc) {
            __builtin_amdgcn_fence(__ATOMIC_RELEASE, "agent");
            asm volatile("s_waitcnt vmcnt(0)" ::: "memory");
            const unsigned og = xb_add(&bar[XB_TOP], 1u);
            const unsigned tg = og / nx;
            if (og + 1u == (tg + 1u) * nx) xb_add(&bar[XB_TOPGEN], 1u);
            else XB_SPIN(xb_ld(&bar[XB_TOPGEN]) == tg, bar);
            __builtin_amdgcn_fence(__ATOMIC_ACQUIRE, "agent");
            xb_add(&bar[XB_XGEN(b.x)], 1u);
            asm volatile("s_waitcnt vmcnt(0)" ::: "memory");
        } else {
            XB_SPIN(xb_ld(&bar[XB_XGEN(b.x)]) == gen, bar);
            __builtin_amdgcn_fence(__ATOMIC_ACQUIRE, "agent");
            asm volatile("s_waitcnt vmcnt(0)" ::: "memory");
        }
    }
    __syncthreads();
}


typedef const __attribute__((address_space(4))) Params* KParamsPtr;
DI KParamsPtr kparams() { KParamsPtr p = (KParamsPtr)__builtin_amdgcn_kernarg_segment_ptr(); asm volatile("" : "+s"(p)); return p; }
#define PKP (kparams())
__global__ __launch_bounds__(512, 2) void mega_fwd(Params P) {
    extern __shared__ __attribute__((aligned(16))) unsigned char shm[];
    cg::grid_group grid = cg::this_grid();
#define WSP_ (opaque_ptr(PKP->ws))
#define XP_ ((float*)opaque_ptr((unsigned char*)PKP->out))
#define MODS_ ((const float*)(WSP_ + WS_MODS))
#define HB_ ((bf16_t*)(WSP_ + WS_H))
#define YFP_ ((float*)(WSP_ + WS_H))
#define QB_ ((bf16_t*)(WSP_ + WS_Q))
#define UB_ ((bf16_t*)(WSP_ + WS_U))
#define MIXB_ ((bf16_t*)(WSP_ + WS_MIX))
#define GB_ ((bf16_t*)(WSP_ + WS_G))
#define ACTB_ ((bf16_t*)(WSP_ + WS_ACT))
#define KCTX_ ((bf16_t*)(WSP_ + WS_KCTX))
#define VCTX_ ((bf16_t*)(WSP_ + WS_VCTX))
    const int w = __builtin_amdgcn_readfirstlane(threadIdx.x >> 6);
    if (PKP->ws == nullptr) grid.sync();
    if (threadIdx.x == 0) { ((volatile LAS unsigned*)(shm + 131072))[0] = 0u; ((volatile LAS unsigned*)(shm + 131072))[1] = 0u; }
    __syncthreads();
    (void)xcd_barrier_post((unsigned*)(WSP_ + WS_BAR), (volatile LAS unsigned*)(shm + 131072));
#define GSYNC() do { XcdBarrier b_; b_.bar = (unsigned*)(opaque_ptr(PKP->ws) + WS_BAR); b_.x = xb_xcc_id(); b_.st = (volatile LAS unsigned*)(shm + 131072); xcd_barrier(b_); } while (0)

    { Params Pl; for (int i = 0; i < 28; ++i) Pl.in[i] = PKP->in[i]; Pl.out = PKP->out; Pl.ws = PKP->ws; phase0(Pl, shm, w); }
    GSYNC();
#pragma unroll 1
    for (int l = 0; l < 2; ++l) {
#define MODSL_ (MODS_ + l * 5 * 6144)
#define XA_ (PKP->in[0])
#define XH_ ((bf16_t*)(WSP_ + WS_XB))
#define XB_ (PKP->in[1])
#define KLAT_ ((bf16_t*)(WSP_ + WS_KLAT + l * SZ_KLAT))
#define VLAT_ ((bf16_t*)(WSP_ + WS_VLAT + l * SZ_KLAT))
        if (l == 0) {
            const int tid = ltid(w); const float* part = (const float*)(WSP_ + WS_MODP); const float* bm_ = PKP->in[8]; float* mw = (float*)(WSP_ + WS_MODS); float* ldsf = (float*)shm;
            for (int idx = blockIdx.x * 512 + tid; idx < 61440; idx += gridDim.x * 512) { const int ll = idx / 30720, n = idx % 6144;
                mw[idx] = part[idx] + part[61440 + idx] + part[2 * 61440 + idx] + part[3 * 61440 + idx] + bm_[ll * 6144 + n]; }
            for (int e = tid; e < 10240; e += 512) { const int j = e >> 11, r = e & 2047; const int idx = j * 6144 + r;
                ldsf[e] = part[idx] + part[61440 + idx] + part[2 * 61440 + idx] + part[3 * 61440 + idx] + bm_[r]; }
            __syncthreads();
            for (int rep = 0; rep < REP_NORM; ++rep) norm_phase(XA_, XB_, nullptr, PKP->in[9], ldsf, 2048, 0, 1024, HB_, w);
        } else
        for (int rep = 0; rep < REP_NORM; ++rep) norm_phase(XA_, XB_, XH_, PKP->in[9] + l * 1024, MODSL_, 6144, 0, 1024, HB_, w);
        GSYNC();
        { EpiIn E; E.layer = l; E.qn = PKP->in[12] + l * 64; E.kn = PKP->in[13] + l * 64; E.ropec = (const float*)(WSP_ + WS_ROPEC); E.ropes = (const float*)(WSP_ + WS_ROPES);
          E.Q = QB_; E.U = UB_; E.Kctx = KCTX_; E.Vctx = VCTX_; E.Klat = KLAT_; E.Vlat = VLAT_; E.outk = PKP->out + OUT_K; E.outv = PKP->out + OUT_V;
          { pg8::Gemm g; g.A = HB_; g.Bt = (const bf16_t*)(WSP_ + WS_WIN + l * SZ_WIN); g.M = NTOK; g.N = 1280; g.K = 1024;
            ListOrder S; S.count = 256; S.G = (int)gridDim.x; S.c = (int)blockIdx.x; S.mode = 0;
            pg8::gemm_phase<EpiIn, ListOrder, false>((PG8_LAS unsigned char*)shm, g, S, E, nullptr, w); }
          GSYNC();
          { pg8::Gemm g; g.A = HB_; g.Bt = (const bf16_t*)(WSP_ + WS_WIN + l * SZ_WIN); g.M = NTOK; g.N = 1280; g.K = 1024;
            ListOrder S; S.count = 64; S.G = (int)gridDim.x; S.c = (int)blockIdx.x; S.mode = 1;
            pg8::gemm_phase<EpiIn, ListOrder, false>((PG8_LAS unsigned char*)shm, g, S, E, nullptr, w); } }
        { const int nb = gridDim.x > 64 ? 64 : 0;
          if ((int)blockIdx.x >= nb)
          for (int it = blockIdx.x - nb; it < 384; it += gridDim.x - nb) {
            __syncthreads();
            if (it < 256) { const int qc = it & 3, kvh = (it >> 2) & 1, b = it >> 3;
                attn_item(QB_, KCTX_ + ((size_t)(b * 2 + kvh) * 256) * 64, VCTX_ + ((size_t)(b * 2 + kvh) * 64) * 256, 256, 256, b * 256 + qc * 64, kvh, MIXB_, shm, w); }
            else { const int wi = (it - 256) * 8 + w; const int dir = wi & 1, g = (wi >> 1) & 31, pr = 16 + (wi >> 6);
                if (dir == 0) ssm_pass<0, false>(l, pr, g, UB_, (const bf16x8*)(WSP_ + WS_SSMB), (const bf16x8*)(WSP_ + WS_SSMC), (const float*)(WSP_ + WS_SSML), PKP->in[4], nullptr, (float*)(WSP_ + WS_SSEG), nullptr, nullptr, nullptr, nullptr, nullptr, w);
                else ssm_pass<1, false>(l, pr, g, UB_, (const bf16x8*)(WSP_ + WS_SSMB), (const bf16x8*)(WSP_ + WS_SSMC), (const float*)(WSP_ + WS_SSML), PKP->in[4], nullptr, (float*)(WSP_ + WS_SSEG), nullptr, nullptr, nullptr, nullptr, nullptr, w); }
          } }
        GSYNC();
        for (int rep = 0; rep < REP_ATT4; ++rep)
        for (int it = blockIdx.x; it < 512; it += gridDim.x) {
            __syncthreads();
            if (it < 256) { const int qc = it >> 3, kvh = it & 1, b = (it >> 1) & 3;
                attn_item(QB_, KLAT_ + ((size_t)(b * 2 + kvh) * 2560) * 64, VLAT_ + ((size_t)(b * 2 + kvh) * 64) * 2560, 2560, 2560, NCTX + b * 2048 + qc * 64, kvh, MIXB_, shm, w); }
            else { const int si = it - 256, pr = si >> 3, gq = si & 7, g = gq * 4 + (w & 3);
                if (w < 4) ssm_pass<0, true>(l, pr, g, UB_, (const bf16x8*)(WSP_ + WS_SSMB), (const bf16x8*)(WSP_ + WS_SSMC), (const float*)(WSP_ + WS_SSML), PKP->in[4], (const float*)(WSP_ + WS_SSEG), nullptr, YFP_, nullptr, nullptr, PKP->out + OUT_S, shm + w * 8704, w);
                else ssm_pass<1, true>(l, pr, g, UB_, (const bf16x8*)(WSP_ + WS_SSMB), (const bf16x8*)(WSP_ + WS_SSMC), (const float*)(WSP_ + WS_SSML), PKP->in[4], (const float*)(WSP_ + WS_SSEG), nullptr, (float*)(WSP_ + WS_YB), nullptr, nullptr, PKP->out + OUT_S, shm + w * 8704, w);
                __syncthreads();
                { const int tid = ltid(w); const float* YBp = (const float*)(WSP_ + WS_YB); const float* dsk = PKP->in[21] + l * 512;
#pragma unroll 4
                  for (int i = 0; i < 16; ++i) { const int idx = i * 512 + tid, tk = pr * 512 + (idx >> 4), ch = gq * 64 + (idx & 15) * 4; const size_t o = (size_t)tk * 512 + ch;
                      const u32x2 yfw = *(const u32x2*)((const bf16_t*)YFP_ + o), ybw = *(const u32x2*)((const bf16_t*)YBp + o); const f32x4 dd = *(const f32x4*)(dsk + ch); const u32x2 uw = *(const u32x2*)(UB_ + o);
                      const f32x4 yf = (f32x4){bflo(yfw.x), bfhi(yfw.x), bflo(yfw.y), bfhi(yfw.y)}, yb = (f32x4){bflo(ybw.x), bfhi(ybw.x), bflo(ybw.y), bfhi(ybw.y)};
                      f32x4 v; v[0] = yf[0] + yb[0] + dd[0] * bflo(uw.x); v[1] = yf[1] + yb[1] + dd[1] * bfhi(uw.x); v[2] = yf[2] + yb[2] + dd[2] * bflo(uw.y); v[3] = yf[3] + yb[3] + dd[3] * bfhi(uw.y);
                      const f32x2 ga = gelu_pk((f32x2){v[0], v[1]}), gb = gelu_pk((f32x2){v[2], v[3]});
                      u32x2 pw; pw.x = pk2(ga.x, ga.y); pw.y = pk2(gb.x, gb.y); *(u32x2*)(GB_ + o) = pw; } } }
        }
        GSYNC();
        { EpiGlu E; E.G = GB_; E.bias = PKP->in[23] + l * 512; E.MIX = MIXB_; for (int rep = 0; rep < REP_GLU; ++rep) run_gemm(shm, GB_, (const bf16_t*)(WSP_ + WS_WGLU + l * SZ_WGLU), 512, 512, E, w); }
        GSYNC();
        { EpiRes E; E.xa = XA_; E.xb = XB_; E.xh = l == 0 ? nullptr : XH_; E.Xo = XH_; E.gate = MODSL_ + 2 * 1024; run_gemm(shm, MIXB_, (const bf16_t*)(WSP_ + WS_WOUT + l * SZ_WOUT), 1024, 1024, E, w); }
        GSYNC();
        for (int rep = 0; rep < REP_NORM; ++rep) norm_phase(XA_, XB_, XH_, PKP->in[10] + l * 1024, MODSL_, 6144, 3 * 1024, 4 * 1024, HB_, w);
        GSYNC();
        { EpiFfn1 E; E.ACT = ACTB_; for (int rep = 0; rep < REP_F1; ++rep) run_gemm(shm, HB_, (const bf16_t*)(WSP_ + WS_WF1 + l * SZ_WF1), 5632, 1024, E, w); }
        GSYNC();
        { EpiRes E; E.xa = XA_; E.xb = XB_; E.xh = XH_; E.Xo = XH_; E.gate = MODSL_ + 5 * 1024; run_gemm(shm, ACTB_, (const bf16_t*)(WSP_ + WS_WF2 + l * SZ_WF2), 1024, 2816, E, w); }
        GSYNC();
    }
    final_norm_phase(XH_, XP_, PKP->in[27], w);
}
#undef WSP_
#undef XP_
#undef MODS_
#undef HB_
#undef YFP_
#undef QB_
#undef UB_
#undef MIXB_
#undef GB_
#undef ACTB_
#undef KCTX_
#undef VCTX_
#undef MODSL_
#undef XA_
#undef XH_
#undef XB_
#undef KLAT_
#undef VLAT_

extern "C" void kernel_launch(void* const* d_in, const int* in_sizes, int n_in, void* d_out, int out_size, void* d_ws, size_t ws_size, hipStream_t stream) {
    static int grid_blocks = 0;
    if (grid_blocks == 0) {
        if (n_in < 28 || ws_size < WS_END) { fprintf(stderr, "kernel_launch: need 28 inputs and %zu bytes of workspace (got %d, %zu)\n", (size_t)WS_END, n_in, ws_size); grid_blocks = -1; return; }
        int dev = 0, cus = 0, per_cu = 0;
        (void)hipGetDevice(&dev);
        (void)hipDeviceGetAttribute(&cus, hipDeviceAttributeMultiprocessorCount, dev);
        if (hipFuncSetAttribute((const void*)mega_fwd, hipFuncAttributeMaxDynamicSharedMemorySize, LDS_BYTES) != hipSuccess) fprintf(stderr, "kernel_launch: hipFuncSetAttribute failed\n");
        if (hipOccupancyMaxActiveBlocksPerMultiprocessor(&per_cu, (const void*)mega_fwd, 512, LDS_BYTES) != hipSuccess || per_cu < 1) { per_cu = 1; (void)hipGetLastError(); }
        if (per_cu > 1) per_cu = 1;
        grid_blocks = cus * per_cu;
    }
    if (grid_blocks < 0) return;
    (void)hipMemsetAsync((unsigned char*)d_ws + WS_BAR, 0, SZ_BAR, stream);
    Params p{};
    for (int i = 0; i < 28; ++i) p.in[i] = (const float*)d_in[i];
    p.out = (float*)d_out; p.ws = (unsigned char*)d_ws;
    void* args[] = {&p};
    hipError_t e = hipLaunchCooperativeKernel((const void*)mega_fwd, dim3(grid_blocks), dim3(512), args, LDS_BYTES, stream);
    if (e != hipSuccess) fprintf(stderr, "cooperative launch failed: %s (grid %d)\n", hipGetErrorString(e), grid_blocks);
}
```

```cpp
#include <hip/hip_runtime.h>
#include <hip/hip_cooperative_groups.h>
#include <cstdio>
namespace cg = cooperative_groups;
#define DI __device__ __forceinline__
DI unsigned char* opaque_ptr(unsigned char* p) { asm volatile("" : "+s"(p)); return p; }
DI float shx(float v, int m, int lane) { return __int_as_float(__builtin_amdgcn_ds_bpermute((lane ^ m) << 2, __float_as_int(v))); }
DI int lane_now() { int l; asm volatile("v_mbcnt_lo_u32_b32 %0, -1, 0\n\tv_mbcnt_hi_u32_b32 %0, -1, %0" : "=v"(l)); return l; }
DI int ltid(int wv) { return wv * 64 + lane_now(); }

namespace pg8 {
#define PG8_LAS __attribute__((address_space(3)))
typedef unsigned short bf16_t;
typedef short bf16x8 __attribute__((ext_vector_type(8)));
typedef float f32x4 __attribute__((ext_vector_type(4)));
typedef unsigned u32x4 __attribute__((ext_vector_type(4)));
constexpr int BM = 256, BK = 64, HALF = 128, HTB = HALF * BK * 2  , STAGE_BYTES = 8 * HTB, NXCD = 8, WGM = 1;

__host__ __device__ __forceinline__ int lds_byte(int r, int c) { const int st = (r >> 4) * 2 + (c >> 5), rr = r & 15, cc = c & 31, ob = rr * 64 + cc * 2; return st * 1024 + (ob ^ (((ob >> 9) & 1) << 5)); }
__host__ __device__ __forceinline__ void stage_rc(int b, int& R, int& C) { const int st = b / 1024, sb = b % 1024, swz = sb ^ (((sb >> 9) & 1) << 5); R = (st >> 1) * 16 + swz / 64; C = (st & 1) * 32 + (swz % 64) / 2; }
__host__ __device__ __forceinline__ int perm32(int rho) { const int n = rho >> 4, i = rho & 15; return 8 * (i >> 2) + 4 * n + (i & 3); }

struct Unit { int pm, pn; };
struct Gemm { const bf16_t* A; const bf16_t* Bt; int M, N, K; };

struct StaticOrder {
    int nM, nN, nwg, G, c;
    __host__ __device__ void init(int M, int N, int G_, int c_) { nM = M / BM; nN = N / BM; nwg = nM * nN; G = G_; c = c_; }
    __host__ __device__ bool next(int i, Unit& u) const {
        const long L = (long)i * G + c; if (L >= nwg) return false;
        int wgid = (int)L; { const int q = nwg / NXCD, r = nwg % NXCD, xcd = wgid % NXCD, off = wgid / NXCD; wgid = (xcd < r ? xcd * (q + 1) : r * (q + 1) + (xcd - r) * q) + off; }
        const int nig = WGM * nN, gid = wgid / nig, fm = gid * WGM, gsz = (nM - fm) < WGM ? (nM - fm) : WGM;
        u.pm = fm + ((wgid % nig) % gsz); u.pn = (wgid % nig) / gsz; return true;
    }
    __device__ __forceinline__ void a_ready(const Unit&) const {}
    __device__ __forceinline__ void done(const Unit&) const {}
};

template <class Epi, class Sched, bool STAMP = false>
__device__ __forceinline__ void gemm_phase(PG8_LAS unsigned char* lds, const Gemm g, const Sched& S, const Epi& E, unsigned long long* stamps, int wv) {
    int tid_l; asm volatile("v_mbcnt_lo_u32_b32 %0, -1, 0\n\tv_mbcnt_hi_u32_b32 %0, -1, %0" : "=v"(tid_l)); tid_l += wv * 64;
    const int tid = tid_l, wid = __builtin_amdgcn_readfirstlane(tid >> 6), lane = tid & 63, wr = wid >> 2, wc = wid & 3, fr = lane & 15, fq = lane >> 4;
    const int K = g.K, nt = K / BK;
    int ts_lo = 0, ts_hi = 0, nts = 0; const unsigned long long rt_entry = STAMP ? (unsigned long long)wall_clock64() : 0ull;
#define PG8_STAMP() do { if (STAMP && wid == 0 && nts < 64) { const unsigned long long _c = (unsigned long long)clock64(); \
        ts_lo = (lane == nts) ? (int)(unsigned)_c : ts_lo; ts_hi = (lane == nts) ? (int)(unsigned)(_c >> 32) : ts_hi; ++nts; } } while (0)
    PG8_STAMP();
    unsigned voffA[2], voffB[2];
#pragma unroll
    for (int i = 0; i < 2; ++i) { int R, C; stage_rc(tid * 16 + i * 8192, R, C); const int Rb = Epi::PERM ? ((R & ~31) + perm32(R & 31)) : R;
        voffA[i] = (unsigned)(R * K + C) * 2u; voffB[i] = (unsigned)(Rb * K + C) * 2u; }
    const size_t kstep = (size_t)(BK * 2);
    const size_t hstep = (size_t)HALF * K * 2;
    const size_t tstep = 2 * hstep;
    const unsigned ldsw = (unsigned)wid * 1024u;
    const int aoff = lds_byte(wr * 64 + fr, fq * 8), boff = lds_byte(wc * 32 + fr, fq * 8);
#define PG8_SA(b, h) (((b) * 2 + (h)) * HTB)
#define PG8_SB(b, h) ((4 + (b) * 2 + (h)) * HTB)
#define PG8_STAGE(bufoff, gbase, voff) do { _Pragma("unroll") for (int _i = 0; _i < 2; ++_i) \
        __builtin_amdgcn_global_load_lds((const unsigned*)((const char*)(gbase) + (voff)[_i]), (PG8_LAS unsigned*)(lds + (bufoff) + ldsw + _i * 8192), 16, 0, 0); } while (0)
#define PG8_LDA(dst, b, h) do { _Pragma("unroll") for (int m = 0; m < 4; ++m) _Pragma("unroll") for (int k = 0; k < 2; ++k) dst[m][k] = *(const PG8_LAS bf16x8*)(lds + PG8_SA(b, h) + aoff + m * 2048 + k * 1024); } while (0)
#define PG8_LDB(dst, b, h) do { _Pragma("unroll") for (int n = 0; n < 2; ++n) _Pragma("unroll") for (int k = 0; k < 2; ++k) dst[n][k] = *(const PG8_LAS bf16x8*)(lds + PG8_SB(b, h) + boff + n * 2048 + k * 1024); } while (0)
#define PG8_MMA(ai, bj, At, Bt) do { __builtin_amdgcn_s_setprio(1); _Pragma("unroll") for (int m = 0; m < 4; ++m) _Pragma("unroll") for (int n = 0; n < 2; ++n) _Pragma("unroll") for (int k = 0; k < 2; ++k) \
        acc[ai][bj][m][n] = __builtin_amdgcn_mfma_f32_16x16x32_bf16(Bt[n][k], At[m][k], acc[ai][bj][m][n], 0, 0, 0); __builtin_amdgcn_s_setprio(0); } while (0)
#define PG8_WAIT_V(n) asm volatile("s_waitcnt vmcnt(" #n ")" ::: "memory")
#define PG8_WAIT_L(n) asm volatile("s_waitcnt lgkmcnt(" #n ")" ::: "memory")
#define PG8_BAR __builtin_amdgcn_s_barrier()
#define PG8_SCHED __builtin_amdgcn_sched_barrier(0)
    Unit cur, nxt; int ui = 0;
    if (!S.next(0, cur)) return;
    f32x4 acc[2][2][4][2];
#pragma unroll
    for (int a = 0; a < 2; ++a)
#pragma unroll
        for (int b = 0; b < 2; ++b)
#pragma unroll
            for (int m = 0; m < 4; ++m)
#pragma unroll
                for (int n = 0; n < 2; ++n) acc[a][b][m][n] = (f32x4){0.f, 0.f, 0.f, 0.f};
    bf16x8 At[4][2], B0[2][2], B1[2][2];
    const char* cA = (const char*)g.A + (size_t)cur.pm * tstep; const char* cB = (const char*)g.Bt + (size_t)cur.pn * tstep;
    S.a_ready(cur);
    PG8_STAGE(PG8_SB(0, 0), cB, voffB); PG8_STAGE(PG8_SA(0, 0), cA, voffA); PG8_STAGE(PG8_SB(0, 1), cB + hstep, voffB); PG8_STAGE(PG8_SA(0, 1), cA + hstep, voffA);
    if (wr == 1) PG8_BAR;
    PG8_WAIT_V(4); PG8_BAR;
    PG8_STAGE(PG8_SB(1, 0), cB + kstep, voffB); PG8_STAGE(PG8_SA(1, 0), cA + kstep, voffA); PG8_STAGE(PG8_SB(1, 1), cB + hstep + kstep, voffB);
    PG8_WAIT_V(6); PG8_BAR;
    PG8_STAMP();
    for (;;) {
        const bool has_next = S.next(ui + 1, nxt);
        const char* nA = has_next ? (const char*)g.A + (size_t)nxt.pm * tstep : cA; const char* nB = has_next ? (const char*)g.Bt + (size_t)nxt.pn * tstep : cB;
        for (int t = 0; t < nt; t += 2) {
            const bool last = (t == nt - 2);
            const char* a1 = cA + (size_t)(t + 1) * kstep;
            const char* a2 = last ? nA : cA + (size_t)(t + 2) * kstep; const char* b2 = last ? nB : cB + (size_t)(t + 2) * kstep;
            const char* a3 = a2 + kstep; const char* b3 = b2 + kstep;
            if (last && has_next) S.a_ready(nxt);
            PG8_LDB(B0, 0, 0); PG8_SCHED; PG8_LDA(At, 0, 0); PG8_STAGE(PG8_SA(1, 1), a1 + hstep, voffA);
            PG8_WAIT_L(8); PG8_BAR; PG8_WAIT_L(0); PG8_MMA(0, 0, At, B0); PG8_BAR; PG8_SCHED;
            PG8_LDB(B1, 0, 1); PG8_STAGE(PG8_SB(0, 0), b2, voffB);
            PG8_BAR; PG8_WAIT_L(0); PG8_MMA(0, 1, At, B1); PG8_BAR;
            PG8_LDA(At, 0, 1); PG8_STAGE(PG8_SA(0, 0), a2, voffA);
            PG8_BAR; PG8_WAIT_L(0); PG8_MMA(1, 0, At, B0); PG8_BAR; PG8_SCHED;
            PG8_STAGE(PG8_SB(0, 1), b2 + hstep, voffB);
            PG8_WAIT_V(6); PG8_BAR; PG8_MMA(1, 1, At, B1); PG8_BAR;
            PG8_LDB(B0, 1, 0); PG8_SCHED; PG8_LDA(At, 1, 0); PG8_STAGE(PG8_SA(0, 1), a2 + hstep, voffA);
            PG8_WAIT_L(8); PG8_BAR; PG8_WAIT_L(0); PG8_MMA(0, 0, At, B0); PG8_BAR; PG8_SCHED;
            PG8_LDB(B1, 1, 1); PG8_STAGE(PG8_SB(1, 0), b3, voffB);
            PG8_BAR; PG8_WAIT_L(0); PG8_MMA(0, 1, At, B1); PG8_BAR;
            PG8_LDA(At, 1, 1); PG8_STAGE(PG8_SA(1, 0), a3, voffA);
            PG8_BAR; PG8_WAIT_L(0); PG8_MMA(1, 0, At, B0); PG8_BAR; PG8_SCHED;
            PG8_STAGE(PG8_SB(1, 1), b3 + hstep, voffB);
            PG8_WAIT_V(6); PG8_BAR; PG8_MMA(1, 1, At, B1); PG8_BAR;
        }
        PG8_STAMP();
        if constexpr (!Epi::AFTER_DRAIN) { E(acc, cur, wr, wc, fr, fq); S.done(cur); }
        PG8_STAMP();
        if (!has_next) break;
#pragma unroll
        for (int a = 0; a < 2; ++a)
#pragma unroll
            for (int b = 0; b < 2; ++b)
#pragma unroll
                for (int m = 0; m < 4; ++m)
#pragma unroll
                    for (int n = 0; n < 2; ++n) acc[a][b][m][n] = (f32x4){0.f, 0.f, 0.f, 0.f};
        cur = nxt; cA = nA; cB = nB; ++ui;
    }
    PG8_WAIT_V(0);
    if (wr == 0) PG8_BAR;
    PG8_BAR;
    if constexpr (Epi::AFTER_DRAIN) { E.fused(acc, cur, wr, wc, fr, fq, lds, wid, lane); S.done(cur); }
    PG8_STAMP();
    if (STAMP && wid == 0) { stamps[lane] = lane < nts ? (((unsigned long long)(unsigned)ts_hi << 32) | (unsigned)ts_lo) : 0ull;
        if (lane == 62) stamps[62] = rt_entry; if (lane == 63) stamps[63] = (unsigned long long)wall_clock64(); }
#undef PG8_STAMP
#undef PG8_SA
#undef PG8_SB
#undef PG8_STAGE
#undef PG8_LDA
#undef PG8_LDB
#undef PG8_MMA
#undef PG8_WAIT_V
#undef PG8_WAIT_L
#undef PG8_BAR
#undef PG8_SCHED
}
}

typedef unsigned short bf16_t;
typedef short bf16x8 __attribute__((ext_vector_type(8)));
typedef short s16x4 __attribute__((ext_vector_type(4)));
typedef float f32x4 __attribute__((ext_vector_type(4)));
typedef float f32x2 __attribute__((ext_vector_type(2)));
typedef float f32x16 __attribute__((ext_vector_type(16)));
typedef unsigned u32x4 __attribute__((ext_vector_type(4)));
typedef unsigned u32x2 __attribute__((ext_vector_type(2)));
typedef __bf16 bf16x2_t __attribute__((ext_vector_type(2)));

constexpr int NTOK = 16384, DM = 1024, NCTX = 8192;
constexpr size_t SZ_WIN = (size_t)1280 * 1024 * 2, SZ_WGLU = (size_t)512 * 512 * 2, SZ_WOUT = (size_t)1024 * 1024 * 2, SZ_WF1 = (size_t)5632 * 1024 * 2, SZ_WF2 = (size_t)1024 * 2816 * 2;
constexpr size_t WS_WIN = 0, WS_WGLU = WS_WIN + 2 * SZ_WIN, WS_WOUT = WS_WGLU + 2 * SZ_WGLU, WS_WF1 = WS_WOUT + 2 * SZ_WOUT, WS_WF2 = WS_WF1 + 2 * SZ_WF1;
constexpr size_t WS_H = WS_WF2 + 2 * SZ_WF2;
constexpr size_t WS_Q = WS_H + (size_t)NTOK * 1024 * 2;
constexpr size_t WS_U = WS_Q + (size_t)NTOK * 512 * 2;
constexpr size_t WS_MIX = WS_U + (size_t)NTOK * 512 * 2;
constexpr size_t WS_G = WS_MIX + (size_t)NTOK * 1024 * 2;
constexpr size_t WS_ACT = WS_Q;
constexpr size_t WS_KLAT = WS_ACT + (size_t)NTOK * 2816 * 2;
constexpr size_t SZ_KLAT = (size_t)4 * 2 * 2560 * 64 * 2;
constexpr size_t WS_VLAT = WS_KLAT + 2 * SZ_KLAT;
constexpr size_t WS_KCTX = WS_VLAT + 2 * SZ_KLAT;
constexpr size_t SZ_KCTX = (size_t)32 * 2 * 256 * 64 * 2;
constexpr size_t WS_VCTX = WS_KCTX + SZ_KCTX;
constexpr size_t WS_MODS = WS_VCTX + SZ_KCTX;
constexpr size_t SZ_MODS = (size_t)2 * 5 * 6144 * 4;
constexpr size_t WS_BAR = WS_MODS + SZ_MODS;
constexpr size_t SZ_BAR = (size_t)3456 * 4;
constexpr size_t WS_ROPEC = WS_BAR + SZ_BAR;
constexpr size_t WS_ROPES = WS_ROPEC + (size_t)2048 * 32 * 4;
constexpr size_t WS_SSMB = WS_ROPES + (size_t)2048 * 32 * 4;
constexpr size_t WS_SSMC = WS_SSMB + (size_t)128 * 4096;
constexpr size_t WS_SSML = WS_SSMC + (size_t)128 * 4096;
constexpr size_t WS_SSEG = WS_SSML + (size_t)128 * 512;
constexpr size_t WS_YB = WS_SSEG + (size_t)32 * 2 * 32 * 64 * 2 * 4;
constexpr size_t WS_MODP = WS_YB + (size_t)NTOK * 512 * 4;
constexpr size_t WS_XB = WS_MODP + (size_t)4 * 61440 * 4;
constexpr size_t WS_END = WS_XB + (size_t)NTOK * 1024 * 2;
constexpr size_t OUT_K = (size_t)2 * 8388608, OUT_V = OUT_K + 2097152, OUT_S = OUT_V + 2097152;
constexpr int LDS_ROPE = 131072 + 16;
constexpr int LDS_BYTES = LDS_ROPE + 12288;

#ifndef REP_NORM
#define REP_NORM 1
#endif
#ifndef REP_IN
#define REP_IN 1
#endif
#ifndef REP_ATT3
#define REP_ATT3 1
#endif
#ifndef REP_ATT4
#define REP_ATT4 1
#endif
#ifndef REP_GLU
#define REP_GLU 1
#endif
#ifndef REP_F1
#define REP_F1 1
#endif
#ifndef REP_P0
#define REP_P0 1
#endif
struct Params { const float* in[28]; float* out; unsigned char* ws; };

DI unsigned pk2(float lo, float hi) { f32x2 v = {lo, hi}; return __builtin_bit_cast(unsigned, __builtin_convertvector(v, bf16x2_t)); }
DI float bf2f(bf16_t b) { return __uint_as_float(((unsigned)b) << 16); }
DI float bflo(unsigned w) { return __uint_as_float(w << 16); }
DI float bfhi(unsigned w) { return __uint_as_float(w & 0xffff0000u); }
DI bf16x8 pack8(float a0, float a1, float a2, float a3, float a4, float a5, float a6, float a7) {
    u32x4 p; p.x = pk2(a0, a1); p.y = pk2(a2, a3); p.z = pk2(a4, a5); p.w = pk2(a6, a7); return __builtin_bit_cast(bf16x8, p); }
DI f32x16 mfma32(bf16x8 a, bf16x8 b, f32x16 c) { return __builtin_amdgcn_mfma_f32_32x32x16_bf16(a, b, c, 0, 0, 0); }
DI f32x16 mfma32p(bf16x8 a, bf16x8 b, f32x16 c) { __builtin_amdgcn_s_setprio(1); f32x16 r = __builtin_amdgcn_mfma_f32_32x32x16_bf16(a, b, c, 0, 0, 0); __builtin_amdgcn_s_setprio(0); return r; }
DI f32x4 mfma16(bf16x8 a, bf16x8 b, f32x4 c) { return __builtin_amdgcn_mfma_f32_16x16x32_bf16(a, b, c, 0, 0, 0); }
DI f32x2 gelu_pk(f32x2 v) {
    const f32x2 av = __builtin_elementwise_abs(v), d = av * 0.2316418882f + 1.0f;
    f32x2 t; t.x = __builtin_amdgcn_rcpf(d.x); t.y = __builtin_amdgcn_rcpf(d.y);
    f32x2 q = t * 0.5307027145f + (-0.7265760135f); q = q * t + 0.7107068705f; q = q * t + (-0.142248368f); q = q * t + 0.127414796f; q = q * t;
    const f32x2 sq = (v * v) * (-0.72134752044f);
    f32x2 e; e.x = __builtin_amdgcn_exp2f(sq.x); e.y = __builtin_amdgcn_exp2f(sq.y);
    const f32x2 m = v * (q * e), r = v - m;
    f32x2 o; o.x = v.x < 0.f ? m.x : r.x; o.y = v.y < 0.f ? m.y : r.y; return o;
}
#define GAS __attribute__((address_space(1)))
DI u32x2 ldg8(const void* p) { return *(const GAS u32x2*)p; }
DI u32x4 ldg16(const void* p) { return *(const GAS u32x4*)p; }
DI f32x4 ldg16f(const void* p) { return *(const GAS f32x4*)p; }
DI f32x2 ldg8f(const void* p) { return *(const GAS f32x2*)p; }
DI void stg8(void* p, u32x2 v) { *(GAS u32x2*)p = v; }
DI void stg16(void* p, u32x4 v) { *(GAS u32x4*)p = v; }
DI void stg16f(void* p, f32x4 v) { *(GAS f32x4*)p = v; }
DI float sigmoidf_(float x) { return __builtin_amdgcn_rcpf(1.0f + __expf(-x)); }

DI void tconv_tile(const float* __restrict__ src, size_t sld, int ca, int cb, bf16_t* __restrict__ dst, size_t dld, float* lds, int wv) {
    const int tid = ltid(wv);
#pragma unroll
    for (int i = 0; i < 8; ++i) { const int idx = i * 512 + tid, kk = idx >> 6, nn = idx & 63; const int col = nn < 32 ? ca + nn : cb + nn - 32;
        lds[nn * 65 + kk] = src[(size_t)kk * sld + col]; }
    __syncthreads();
    { const int nn = tid >> 3, k8 = (tid & 7) * 8; const float* r = lds + nn * 65 + k8;
      u32x4 w; w.x = pk2(r[0], r[1]); w.y = pk2(r[2], r[3]); w.z = pk2(r[4], r[5]); w.w = pk2(r[6], r[7]);
      *(u32x4*)(dst + (size_t)nn * dld + k8) = w; }
    __syncthreads();
}
DI int srccol_in(int np) { const int pn = np >> 8, cpos = np & 255, bj = cpos >> 7, wc = (cpos >> 5) & 3, w = cpos & 31; return pn * 256 + wc * 64 + bj * 32 + w; }
DI int srccol_f1(int np) { const int tile = np >> 8, bj = (np >> 7) & 1, i = np & 127; return bj * 2816 + tile * 128 + i; }

DI void wconv_task(const Params& P, int t, float* lds, int wv) {
    const int l = t / 2752; int r = t % 2752;
    unsigned char* ws = P.ws;
    if (r < 320) { const int kt = r & 15, ntl = r >> 4, n0 = ntl * 64, k0 = kt * 64;
        tconv_tile(P.in[11] + ((size_t)l * 1024 + k0) * 1280, 1280, srccol_in(n0), srccol_in(n0 + 32), (bf16_t*)(ws + WS_WIN + l * SZ_WIN) + (size_t)n0 * 1024 + k0, 1024, lds, wv); return; }
    r -= 320;
    if (r < 64) { const int kt = r & 7, ntl = r >> 3, n0 = ntl * 64, k0 = kt * 64;
        tconv_tile(P.in[22] + ((size_t)l * 512 + k0) * 512, 512, n0, n0 + 32, (bf16_t*)(ws + WS_WGLU + l * SZ_WGLU) + (size_t)n0 * 512 + k0, 512, lds, wv); return; }
    r -= 64;
    if (r < 256) { const int kt = r & 15, ntl = r >> 4, n0 = ntl * 64, k0 = kt * 64;
        tconv_tile(P.in[24] + ((size_t)l * 1024 + k0) * 1024, 1024, n0, n0 + 32, (bf16_t*)(ws + WS_WOUT + l * SZ_WOUT) + (size_t)n0 * 1024 + k0, 1024, lds, wv); return; }
    r -= 256;
    if (r < 1408) { const int kt = r & 15, ntl = r >> 4, n0 = ntl * 64, k0 = kt * 64;
        tconv_tile(P.in[25] + ((size_t)l * 1024 + k0) * 5632, 5632, srccol_f1(n0), srccol_f1(n0 + 32), (bf16_t*)(ws + WS_WF1 + l * SZ_WF1) + (size_t)n0 * 1024 + k0, 1024, lds, wv); return; }
    r -= 1408;
    { const int kt = r % 44, ntl = r / 44, n0 = ntl * 64, k0 = kt * 64;
        tconv_tile(P.in[26] + ((size_t)l * 2816 + k0) * 1024, 1024, n0, n0 + 32, (bf16_t*)(ws + WS_WF2 + l * SZ_WF2) + (size_t)n0 * 2816 + k0, 2816, lds, wv); }
}

DI void adaln_task(const Params& P, int task, float* lds, int wv) {
    const int tid = ltid(wv), w = tid >> 6, lane = tid & 63;
    const int kc = task & 3, cgp = (task >> 2) % 24, l = task / 96;
    const int n = cgp * 256 + lane * 4;
    const int k0 = kc * 256 + w * 32;
    const float* wm = P.in[7] + ((size_t)l * 1024 + k0) * 6144 + n;
    const float* cc = P.in[5]; const float* cx = P.in[6];
    f32x4 wrow[32];
#pragma unroll
    for (int kk = 0; kk < 32; ++kk) wrow[kk] = *(const f32x4*)(wm + (size_t)kk * 6144);
    f32x4 acc[5];
#pragma unroll
    for (int j = 0; j < 5; ++j) acc[j] = (f32x4){0.f, 0.f, 0.f, 0.f};
#pragma unroll
    for (int kk = 0; kk < 32; ++kk) { const int k = k0 + kk;
#pragma unroll
        for (int j = 0; j < 5; ++j) { const float cv = (j == 0) ? cx[k] : cc[(j - 1) * 1024 + k]; const float sv = cv / (1.0f + __expf(-cv)); acc[j] += wrow[kk] * sv; } }
#pragma unroll
    for (int j = 0; j < 5; ++j) *(f32x4*)(lds + (w * 5 + j) * 256 + lane * 4) = acc[j];
    __syncthreads();
    float* part = (float*)(P.ws + WS_MODP) + (size_t)kc * 61440;
    for (int e = tid; e < 1280; e += 512) { const int j = e >> 8, col = e & 255; float sm = 0.f;
#pragma unroll
        for (int ww = 0; ww < 8; ++ww) sm += lds[(ww * 5 + j) * 256 + col];
        part[(l * 5 + j) * 6144 + cgp * 256 + col] = sm; }
    __syncthreads();
}

DI void ssmconst_task(const Params& P, int task, int wv) {
    const int idx = task * 512 + ltid(wv); const int p = idx & 63, ldg = idx >> 6;
    const double dt = exp((double)P.in[16][ldg]); const double ar = (double)P.in[14][ldg * 64 + p], ai = (double)P.in[15][ldg * 64 + p];
    const double mag = exp(ar * dt); double sn, cs; sincos(ai * dt, &sn, &cs);
    const double lr = mag * cs, li = mag * sn, den = ar * ar + ai * ai;
    const double zr = ((lr - 1.0) * ar + li * ai) / den, zi = (li * ar - (lr - 1.0) * ai) / den;
    float* lam = (float*)(P.ws + WS_SSML); lam[(ldg * 64 + p) * 2] = (float)lr; lam[(ldg * 64 + p) * 2 + 1] = (float)li;
    bf16_t* Bm = (bf16_t*)(P.ws + WS_SSMB); bf16_t* Cm = (bf16_t*)(P.ws + WS_SSMC);
    const float* bre = P.in[17] + ((size_t)ldg * 64 + p) * 16; const float* bim = P.in[18] + ((size_t)ldg * 64 + p) * 16;
    const int ntb = (p >= 32) ? 2 : 0;
    for (int h = 0; h < 16; ++h) { const double br = bre[h], bi = bim[h]; const float bbr = (float)(zr * br - zi * bi), bbi = (float)(zr * bi + zi * br);
        const int ln = (p & 31) + 32 * (h >> 3), j = h & 7;
        Bm[(((size_t)ldg * 4 + ntb) * 64 + ln) * 8 + j] = (bf16_t)(pk2(bbr, 0.f) & 0xffffu);
        Bm[(((size_t)ldg * 4 + ntb + 1) * 64 + ln) * 8 + j] = (bf16_t)(pk2(bbi, 0.f) & 0xffffu); }
    for (int hp = 0; hp < 16; ++hp) { const float cr = P.in[19][((size_t)ldg * 16 + hp) * 64 + p], ci = P.in[20][((size_t)ldg * 16 + hp) * 64 + p];
#pragma unroll
        for (int ri = 0; ri < 2; ++ri) { const int pp = 2 * p + ri, ks = pp >> 5, kq = (pp >> 3) & 3, j = pp & 7;
            Cm[(((size_t)ldg * 4 + ks) * 64 + kq * 16 + hp) * 8 + j] = (bf16_t)(pk2(ri ? -ci : cr, 0.f) & 0xffffu); } }
}

DI void phase0(const Params& P, unsigned char* shm, int wv) {
    float* lds = (float*)shm;
    constexpr int T_ADA = 192, T_W = 5504, T_V = 128, T_K = 128, T_S = 16, T_R = 128;
    constexpr int T_TOTAL = T_ADA + T_W + T_V + T_K + T_S + T_R;
    for (int rep = 0; rep < REP_P0; ++rep)
    for (int t = blockIdx.x; t < T_TOTAL; t += gridDim.x) {
        int r = t;
        if (r < T_ADA) { adaln_task(P, r, lds, wv); continue; }
        r -= T_ADA;
        if (r < T_W) { wconv_task(P, r, lds, wv); continue; }
        r -= T_W;
        if (r < T_V) { const int s8 = r & 7, kvh = (r >> 3) & 1, b = (r >> 4) & 3, l = r >> 6;
            tconv_tile(P.in[3] + (((size_t)(b * 2 + l) * 512 + s8 * 64) * 2 + kvh) * 64, 128, 0, 32,
                       (bf16_t*)(P.ws + WS_VLAT + l * SZ_KLAT) + ((size_t)(b * 2 + kvh) * 64) * 2560 + s8 * 64, 2560, lds, wv); continue; }
        r -= T_V;
        if (r < T_K) { const int idx = r * 4096 + ltid(wv) * 8; const int d = idx & 63, s = (idx >> 6) & 511, kvh = (idx >> 15) & 1, b = (idx >> 16) & 3, l = idx >> 18;
            const float* src = P.in[2] + ((((size_t)(b * 2 + l) * 512 + s) * 2 + kvh) * 64 + d);
            const f32x4 a = *(const f32x4*)src, c = *(const f32x4*)(src + 4);
            u32x4 w; w.x = pk2(a[0], a[1]); w.y = pk2(a[2], a[3]); w.z = pk2(c[0], c[1]); w.w = pk2(c[2], c[3]);
            *(u32x4*)((bf16_t*)(P.ws + WS_KLAT + l * SZ_KLAT) + ((size_t)(b * 2 + kvh) * 2560 + s) * 64 + d) = w; continue; }
        r -= T_K;
        if (r < T_S) { ssmconst_task(P, r, wv); continue; }
        r -= T_S;
        { const int idx = r * 512 + ltid(wv); const int tt = idx >> 5, i = idx & 31; const int pos = (i < 16) ? (tt >> 6) : (tt & 63); const int f = i & 15;
          const double inv = pow(10000.0, -(2.0 * f) / 32.0); double sn, cs; sincos((double)pos * inv, &sn, &cs);
          ((float*)(P.ws + WS_ROPEC))[idx] = (float)cs; ((float*)(P.ws + WS_ROPES))[idx] = (float)sn; }
    }
}

DI float wave_sum(float v, int lane) {
    v += shx(v, 32, lane); v += shx(v, 16, lane); v += shx(v, 8, lane); v += shx(v, 4, lane); v += shx(v, 2, lane); v += shx(v, 1, lane); return v; }

DI void norm_phase(const float* __restrict__ xa, const float* __restrict__ xb, const bf16_t* __restrict__ xh, const float* __restrict__ gw, const float* mbase, int jstride, int sh_off, int sc_off, bf16_t* __restrict__ H, int wv) {
    const int tidl = ltid(wv); const int lane = tidl & 63, w = tidl >> 6;
    for (int base = (blockIdx.x * 8 + w) * 8; base < NTOK; base += gridDim.x * 64) {
        const int j = base < NCTX ? 0 : 1 + ((base - NCTX) >> 11);
        f32x4 wv4[4], sh4[4];
#pragma unroll
        for (int i = 0; i < 4; ++i) { const int col = i * 256 + lane * 4;
            const f32x4 g4 = ldg16f(gw + col), sc = *(const f32x4*)(mbase + j * jstride + sc_off + col); sh4[i] = *(const f32x4*)(mbase + j * jstride + sh_off + col); wv4[i] = g4 * (sc + 1.0f); }
#pragma unroll
        for (int hb = 0; hb < 2; ++hb) {
            f32x4 v[4][4]; float ss[4];
            if (xh) { u32x2 t[4][4];
#pragma unroll
                for (int r = 0; r < 4; ++r)
#pragma unroll
                    for (int i = 0; i < 4; ++i) t[r][i] = ldg8(xh + (size_t)(base + hb * 4 + r) * 1024 + i * 256 + lane * 4);
#pragma unroll
                for (int r = 0; r < 4; ++r)
#pragma unroll
                    for (int i = 0; i < 4; ++i) v[r][i] = (f32x4){bflo(t[r][i].x), bfhi(t[r][i].x), bflo(t[r][i].y), bfhi(t[r][i].y)};
            } else { const float* xr = base < NCTX ? xa + (size_t)(base + hb * 4) * 1024 : xb + (size_t)(base + hb * 4 - NCTX) * 1024;
#pragma unroll
                for (int r = 0; r < 4; ++r)
#pragma unroll
                    for (int i = 0; i < 4; ++i) v[r][i] = ldg16f(xr + (size_t)r * 1024 + i * 256 + lane * 4); }
#pragma unroll
            for (int r = 0; r < 4; ++r) { float a = 0.f;
#pragma unroll
                for (int i = 0; i < 4; ++i) a += v[r][i][0] * v[r][i][0] + v[r][i][1] * v[r][i][1] + v[r][i][2] * v[r][i][2] + v[r][i][3] * v[r][i][3];
                ss[r] = a; }
#pragma unroll
            for (int mk = 32; mk >= 1; mk >>= 1)
#pragma unroll
                for (int r = 0; r < 4; ++r) ss[r] += shx(ss[r], mk, lane);
#pragma unroll
            for (int r = 0; r < 4; ++r) { const float rstd = rsqrtf(ss[r] * (1.0f / 1024.0f) + 1e-6f);
#pragma unroll
                for (int i = 0; i < 4; ++i) { const f32x4 o = v[r][i] * rstd * wv4[i] + sh4[i];
                    u32x2 pw; pw.x = pk2(o[0], o[1]); pw.y = pk2(o[2], o[3]); stg8(H + (size_t)(base + hb * 4 + r) * 1024 + i * 256 + lane * 4, pw); } }
        }
    }
}

DI void final_norm_phase(const bf16_t* __restrict__ xh, float* __restrict__ Y, const float* __restrict__ gw, int wv) {
    const int tidl = ltid(wv); const int lane = tidl & 63, w = tidl >> 6;
    for (int base = (blockIdx.x * 8 + w) * 8; base < NTOK; base += gridDim.x * 64) {
        f32x4 g4[4];
#pragma unroll
        for (int i = 0; i < 4; ++i) g4[i] = ldg16f(gw + i * 256 + lane * 4);
#pragma unroll
        for (int hb = 0; hb < 2; ++hb) {
            u32x2 t[4][4]; float ss[4];
#pragma unroll
            for (int r = 0; r < 4; ++r)
#pragma unroll
                for (int i = 0; i < 4; ++i) t[r][i] = ldg8(xh + (size_t)(base + hb * 4 + r) * 1024 + i * 256 + lane * 4);
            f32x4 v[4][4];
#pragma unroll
            for (int r = 0; r < 4; ++r) { float a = 0.f;
#pragma unroll
                for (int i = 0; i < 4; ++i) { v[r][i] = (f32x4){bflo(t[r][i].x), bfhi(t[r][i].x), bflo(t[r][i].y), bfhi(t[r][i].y)}; a += v[r][i][0] * v[r][i][0] + v[r][i][1] * v[r][i][1] + v[r][i][2] * v[r][i][2] + v[r][i][3] * v[r][i][3]; }
                ss[r] = a; }
#pragma unroll
            for (int mk = 32; mk >= 1; mk >>= 1)
#pragma unroll
                for (int r = 0; r < 4; ++r) ss[r] += shx(ss[r], mk, lane);
#pragma unroll
            for (int r = 0; r < 4; ++r) { const float rstd = rsqrtf(ss[r] * (1.0f / 1024.0f) + 1e-6f);
#pragma unroll
                for (int i = 0; i < 4; ++i) stg16f(Y + (size_t)(base + hb * 4 + r) * 1024 + i * 256 + lane * 4, v[r][i] * rstd * g4[i]); }
        }
    }
}

struct EpiIn {
    static constexpr bool PERM = true, AFTER_DRAIN = false;
    int layer; const float* qn; const float* kn; const PG8_LAS float* lr;
    bf16_t* Q; bf16_t* U; bf16_t* Kctx; bf16_t* Vctx; bf16_t* Klat; bf16_t* Vlat; float* outk; float* outv;
    DI void operator()(const f32x4 (&acc)[2][2][4][2], const pg8::Unit& u, int wr, int wc, int fr, int fq) const {
        asm volatile("" : "+v"(fr), "+v"(fq));
        const bool lat = u.pm >= 32; const int pn = u.pn;
        if (pn >= 3) {
#pragma unroll
            for (int ai = 0; ai < 2; ++ai)
#pragma unroll
                for (int m = 0; m < 4; ++m) { const int row = u.pm * 256 + ai * 128 + wr * 64 + m * 16 + fr;
#pragma unroll
                    for (int bj = 0; bj < 2; ++bj) { const int col = (pn - 3) * 256 + 64 * wc + 32 * bj + 8 * fq; const f32x4 a0 = acc[ai][bj][m][0], a1 = acc[ai][bj][m][1];
                        u32x4 pw; pw.x = pk2(a0[0], a0[1]); pw.y = pk2(a0[2], a0[3]); pw.z = pk2(a1[0], a1[1]); pw.w = pk2(a1[2], a1[3]); stg16(U + (size_t)row * 512 + col, pw); } }
            return;
        }
        if (pn == 2 && wc >= 2) {
            const int kvh = wc - 2;
#pragma unroll
            for (int ai = 0; ai < 2; ++ai)
#pragma unroll
                for (int m = 0; m < 4; ++m) { const int row = u.pm * 256 + ai * 128 + wr * 64 + m * 16 + fr;
                    if (!lat) { const int b = row >> 8, t = row & 255; float* ov = outv + (((size_t)(b * 2 + layer) * 256 + t) * 2 + kvh) * 64; bf16_t* vt = Vctx + ((size_t)(b * 2 + kvh) * 64) * 256 + t;
#pragma unroll
                        for (int bj = 0; bj < 2; ++bj)
#pragma unroll
                            for (int n = 0; n < 2; ++n) { const int d = 32 * bj + 8 * fq + 4 * n; const f32x4 a = acc[ai][bj][m][n]; stg16f(ov + d, a);
                                const unsigned p0 = pk2(a[0], a[1]), p1 = pk2(a[2], a[3]);
                                vt[(size_t)(d + 0) * 256] = (bf16_t)(p0 & 0xffffu); vt[(size_t)(d + 1) * 256] = (bf16_t)(p0 >> 16); vt[(size_t)(d + 2) * 256] = (bf16_t)(p1 & 0xffffu); vt[(size_t)(d + 3) * 256] = (bf16_t)(p1 >> 16); } }
                    else { const int rl = row - NCTX, b = rl >> 11, t = rl & 2047; bf16_t* vt = Vlat + ((size_t)(b * 2 + kvh) * 64) * 2560 + 512 + t;
#pragma unroll
                        for (int bj = 0; bj < 2; ++bj)
#pragma unroll
                            for (int n = 0; n < 2; ++n) { const int d = 32 * bj + 8 * fq + 4 * n; const f32x4 a = acc[ai][bj][m][n];
                                const unsigned p0 = pk2(a[0], a[1]), p1 = pk2(a[2], a[3]);
                                vt[(size_t)(d + 0) * 2560] = (bf16_t)(p0 & 0xffffu); vt[(size_t)(d + 1) * 2560] = (bf16_t)(p0 >> 16); vt[(size_t)(d + 2) * 2560] = (bf16_t)(p1 & 0xffffu); vt[(size_t)(d + 3) * 2560] = (bf16_t)(p1 >> 16); } } }
            return;
        }
        const bool isq = pn < 2; const float* nw = isq ? qn : kn;
        f32x4 w4[2][2];
#pragma unroll
        for (int bj = 0; bj < 2; ++bj)
#pragma unroll
            for (int n = 0; n < 2; ++n) w4[bj][n] = ldg16f(nw + 32 * bj + 8 * fq + 4 * n);
        const float qscale = isq ? 0.125f * 1.4426950408889634f : 1.0f;
        const int T0r = ((u.pm * 256 - NCTX) & 2047) >> 6;
#pragma unroll
        for (int ai = 0; ai < 2; ++ai)
#pragma unroll
            for (int m = 0; m < 4; ++m) { const int row = u.pm * 256 + ai * 128 + wr * 64 + m * 16 + fr;
                float ss = 0.f;
#pragma unroll
                for (int bj = 0; bj < 2; ++bj)
#pragma unroll
                    for (int n = 0; n < 2; ++n) { const f32x4 a = acc[ai][bj][m][n]; ss += a[0] * a[0] + a[1] * a[1] + a[2] * a[2] + a[3] * a[3]; }
                ss += shx(ss, 16, fq * 16 + fr); ss += shx(ss, 32, fq * 16 + fr);
                const float rstd = rsqrtf(ss * (1.0f / 64.0f) + 1e-6f);
                f32x4 v[2][2];
#pragma unroll
                for (int bj = 0; bj < 2; ++bj)
#pragma unroll
                    for (int n = 0; n < 2; ++n) v[bj][n] = acc[ai][bj][m][n] * rstd * w4[bj][n];
                if (!lat) {
                    const int b = row >> 8, t = row & 255;
                    if (isq) { bf16_t* qp = Q + (size_t)row * 512 + (pn * 4 + wc) * 64;
#pragma unroll
                        for (int bj = 0; bj < 2; ++bj) { const f32x4 a0 = v[bj][0] * qscale, a1 = v[bj][1] * qscale;
                            u32x4 pw; pw.x = pk2(a0[0], a0[1]); pw.y = pk2(a0[2], a0[3]); pw.z = pk2(a1[0], a1[1]); pw.w = pk2(a1[2], a1[3]); stg16(qp + 32 * bj + 8 * fq, pw); } }
                    else { const int kvh = wc; float* ok = outk + (((size_t)(b * 2 + layer) * 256 + t) * 2 + kvh) * 64; bf16_t* kp = Kctx + ((size_t)(b * 2 + kvh) * 256 + t) * 64;
#pragma unroll
                        for (int bj = 0; bj < 2; ++bj) { const int d = 32 * bj + 8 * fq; const f32x4 a0 = v[bj][0], a1 = v[bj][1]; stg16f(ok + d, a0); stg16f(ok + d + 4, a1);
                            u32x4 pw; pw.x = pk2(a0[0], a0[1]); pw.y = pk2(a0[2], a0[3]); pw.z = pk2(a1[0], a1[1]); pw.w = pk2(a1[2], a1[3]); stg16(kp + d, pw); } }
                } else {
                    const int rl = row - NCTX, b = rl >> 11, t = rl & 2047;
                    bf16_t* dst = isq ? Q + (size_t)row * 512 + (pn * 4 + wc) * 64 : Klat + ((size_t)(b * 2 + wc) * 2560 + 512 + t) * 64;
                    const int grow = T0r + 2 * ai + wr, gcol = 16 * m + fr;
#pragma unroll
                    for (int bj = 0; bj < 2; ++bj) { u32x4 pw;
#pragma unroll
                        for (int n = 0; n < 2; ++n) { const int o = (bj == 0 ? grow * 16 : 1024 + gcol * 16) + 4 * fq + 2 * n;
                            const f32x2 c2 = *(const PG8_LAS f32x2*)(lr + o), s2 = *(const PG8_LAS f32x2*)(lr + o + (bj == 0 ? 512 : 1024)); const f32x4 a = v[bj][n];
                            const float o0 = (a[0] * c2[0] - a[1] * s2[0]) * qscale, o1 = (a[0] * s2[0] + a[1] * c2[0]) * qscale, o2 = (a[2] * c2[1] - a[3] * s2[1]) * qscale, o3 = (a[2] * s2[1] + a[3] * c2[1]) * qscale;
                            if (n == 0) { pw.x = pk2(o0, o1); pw.y = pk2(o2, o3); } else { pw.z = pk2(o0, o1); pw.w = pk2(o2, o3); } }
                        stg16(dst + 32 * bj + 8 * fq, pw); }
                }
            }
    }
};

struct EpiGlu {
    static constexpr bool PERM = true, AFTER_DRAIN = false;
    const bf16_t* G; const float* bias; bf16_t* MIX;
    DI void operator()(const f32x4 (&acc)[2][2][4][2], const pg8::Unit& u, int wr, int wc, int fr, int fq) const {
        asm volatile("" : "+v"(fr), "+v"(fq));
        const int cb = u.pn * 256 + 32 * wc + 8 * fq, rb = u.pm * 256 + wr * 64 + fr;
        f32x4 bv[2][2]; u32x4 gw[2][4][2];
#pragma unroll
        for (int bj = 0; bj < 2; ++bj) { bv[bj][0] = ldg16f(bias + cb + 128 * bj); bv[bj][1] = ldg16f(bias + cb + 128 * bj + 4); }
#pragma unroll
        for (int ai = 0; ai < 2; ++ai)
#pragma unroll
            for (int m = 0; m < 4; ++m)
#pragma unroll
                for (int bj = 0; bj < 2; ++bj) gw[ai][m][bj] = ldg16(G + (size_t)(rb + 128 * ai + 16 * m) * 512 + cb + 128 * bj);
#pragma unroll
        for (int ai = 0; ai < 2; ++ai)
#pragma unroll
            for (int m = 0; m < 4; ++m)
#pragma unroll
                for (int bj = 0; bj < 2; ++bj) { const u32x4 g4 = gw[ai][m][bj];
                    const f32x4 v0 = acc[ai][bj][m][0] + bv[bj][0], v1 = acc[ai][bj][m][1] + bv[bj][1];
                    u32x4 o;
                    o.x = pk2(bflo(g4.x) * sigmoidf_(v0[0]), bfhi(g4.x) * sigmoidf_(v0[1])); o.y = pk2(bflo(g4.y) * sigmoidf_(v0[2]), bfhi(g4.y) * sigmoidf_(v0[3]));
                    o.z = pk2(bflo(g4.z) * sigmoidf_(v1[0]), bfhi(g4.z) * sigmoidf_(v1[1])); o.w = pk2(bflo(g4.w) * sigmoidf_(v1[2]), bfhi(g4.w) * sigmoidf_(v1[3]));
                    stg16(MIX + (size_t)(rb + 128 * ai + 16 * m) * 1024 + 512 + cb + 128 * bj, o); }
    }
};

struct EpiRes {
    static constexpr bool PERM = true, AFTER_DRAIN = false;
    const float* xa; const float* xb; const bf16_t* xh; bf16_t* Xo; const float* gate;
    DI void operator()(const f32x4 (&acc)[2][2][4][2], const pg8::Unit& u, int wr, int wc, int fr, int fq) const {
        asm volatile("" : "+v"(fr), "+v"(fq));
        const int j = u.pm < 32 ? 0 : 1 + ((u.pm - 32) >> 3);
        const int cb = u.pn * 256 + 32 * wc + 8 * fq, rb = u.pm * 256 + wr * 64 + fr;
        const float* gt = gate + j * 6144 + cb;
        f32x4 gv[2][2];
#pragma unroll
        for (int bj = 0; bj < 2; ++bj)
#pragma unroll
            for (int n = 0; n < 2; ++n) gv[bj][n] = ldg16f(gt + 128 * bj + 4 * n);
        if (xh) {
#pragma unroll
            for (int ai = 0; ai < 2; ++ai) {
                u32x4 xr[4][2];
#pragma unroll
                for (int m = 0; m < 4; ++m)
#pragma unroll
                    for (int bj = 0; bj < 2; ++bj) xr[m][bj] = ldg16(xh + (size_t)(rb + 128 * ai + 16 * m) * 1024 + cb + 128 * bj);
#pragma unroll
                for (int m = 0; m < 4; ++m)
#pragma unroll
                    for (int bj = 0; bj < 2; ++bj) { const u32x4 t = xr[m][bj];
                        const f32x4 x0 = (f32x4){bflo(t.x), bfhi(t.x), bflo(t.y), bfhi(t.y)} + gv[bj][0] * acc[ai][bj][m][0];
                        const f32x4 x1 = (f32x4){bflo(t.z), bfhi(t.z), bflo(t.w), bfhi(t.w)} + gv[bj][1] * acc[ai][bj][m][1];
                        u32x4 pw; pw.x = pk2(x0[0], x0[1]); pw.y = pk2(x0[2], x0[3]); pw.z = pk2(x1[0], x1[1]); pw.w = pk2(x1[2], x1[3]);
                        stg16(Xo + (size_t)(rb + 128 * ai + 16 * m) * 1024 + cb + 128 * bj, pw); }
            }
        } else {
            const float* xs = u.pm < 32 ? xa + (size_t)rb * 1024 : xb + (size_t)(rb - NCTX) * 1024;
#pragma unroll
            for (int ai = 0; ai < 2; ++ai) {
                f32x4 xr[4][2][2];
#pragma unroll
                for (int m = 0; m < 4; ++m)
#pragma unroll
                    for (int bj = 0; bj < 2; ++bj)
#pragma unroll
                        for (int n = 0; n < 2; ++n) xr[m][bj][n] = ldg16f(xs + (size_t)(128 * ai + 16 * m) * 1024 + cb + 128 * bj + 4 * n);
#pragma unroll
                for (int m = 0; m < 4; ++m)
#pragma unroll
                    for (int bj = 0; bj < 2; ++bj) { const f32x4 x0 = xr[m][bj][0] + gv[bj][0] * acc[ai][bj][m][0], x1 = xr[m][bj][1] + gv[bj][1] * acc[ai][bj][m][1];
                        u32x4 pw; pw.x = pk2(x0[0], x0[1]); pw.y = pk2(x0[2], x0[3]); pw.z = pk2(x1[0], x1[1]); pw.w = pk2(x1[2], x1[3]);
                        stg16(Xo + (size_t)(rb + 128 * ai + 16 * m) * 1024 + cb + 128 * bj, pw); }
            }
        }
    }
};

struct EpiFfn1 {
    static constexpr bool PERM = true, AFTER_DRAIN = false;
    bf16_t* ACT;
    DI void operator()(const f32x4 (&acc)[2][2][4][2], const pg8::Unit& u, int wr, int wc, int fr, int fq) const {
        asm volatile("" : "+v"(fr), "+v"(fq));
#pragma unroll
        for (int ai = 0; ai < 2; ++ai)
#pragma unroll
            for (int m = 0; m < 4; ++m) { const int row = u.pm * 256 + ai * 128 + wr * 64 + m * 16 + fr; const int a0 = u.pn * 128 + 32 * wc + 8 * fq;
                const f32x4 g0 = acc[ai][0][m][0], g1 = acc[ai][0][m][1], u0 = acc[ai][1][m][0], u1 = acc[ai][1][m][1];
                u32x4 o;
                o.x = pk2(g0[0] * sigmoidf_(g0[0]) * u0[0], g0[1] * sigmoidf_(g0[1]) * u0[1]); o.y = pk2(g0[2] * sigmoidf_(g0[2]) * u0[2], g0[3] * sigmoidf_(g0[3]) * u0[3]);
                o.z = pk2(g1[0] * sigmoidf_(g1[0]) * u1[0], g1[1] * sigmoidf_(g1[1]) * u1[1]); o.w = pk2(g1[2] * sigmoidf_(g1[2]) * u1[2], g1[3] * sigmoidf_(g1[3]) * u1[3]);
                *(u32x4*)(ACT + (size_t)row * 2816 + a0) = o; }
    }
};

struct ListOrder {
    int count, G, c, mode;
    DI bool next(int i, pg8::Unit& u) const {
        const int L0 = i * G + c; if (L0 >= count) return false;
        const int L = (L0 & 7) * (count >> 3) + (L0 >> 3);
        if (mode == 0) { const int pm = L >> 2, vn = L & 3; if (vn < 3) { u.pm = pm; u.pn = vn; } else { u.pm = 32 + (pm >> 1); u.pn = 3 + (pm & 1); } }
        else { u.pm = L >> 1; u.pn = 3 + (L & 1); }
        return true;
    }
    DI void a_ready(const pg8::Unit&) const {}
    DI void done(const pg8::Unit&) const {}
};

template <class Epi> DI void run_gemm(unsigned char* shm, const bf16_t* A, const bf16_t* Bt, int N, int K, const Epi& E, int wv) {
    pg8::Gemm g; g.A = A; g.Bt = Bt; g.M = NTOK; g.N = N; g.K = K;
    pg8::StaticOrder S; S.init(NTOK, N, (int)gridDim.x, (int)blockIdx.x);
    pg8::gemm_phase<Epi, pg8::StaticOrder, false>((PG8_LAS unsigned char*)shm, g, S, E, nullptr, wv);
}

DI void attn_item(const bf16_t* __restrict__ Q, const bf16_t* __restrict__ Kp, const bf16_t* __restrict__ Vp, int vld, int nkeys, int qtok0, int kvh, bf16_t* __restrict__ MIX, unsigned char* lds, int wv) {
    const int tid = ltid(wv), w = tid >> 6, lane = tid & 63, c = lane & 31, hh = lane >> 5;
    const int hq = kvh * 4 + (w & 3), qtok = qtok0 + 32 * (w >> 2) + c;
    bf16x8 qf[4];
#pragma unroll
    for (int s = 0; s < 4; ++s) qf[s] = __builtin_bit_cast(bf16x8, ldg16(Q + (size_t)qtok * 512 + hq * 64 + 16 * s + 8 * hh));
    unsigned char* Kb = lds; unsigned char* Vb = lds + 2 * 9216;
    const int srow = tid >> 3, sseg = tid & 7;
    const bf16_t* kg = Kp + (size_t)srow * 64 + sseg * 8;
    const bf16_t* vg = Vp + (size_t)srow * vld + sseg * 8;
    u32x4 kr = ldg16(kg), vr = ldg16(vg);
    *(u32x4*)(Kb + srow * 144 + sseg * 16) = kr;
    { u32x2* d = (u32x2*)(Vb + srow * 136 + sseg * 16); u32x2 a; a.x = vr.x; a.y = vr.y; u32x2 b; b.x = vr.z; b.y = vr.w; d[0] = a; d[1] = b; }
    __syncthreads();
    f32x16 ot[2];
#pragma unroll
    for (int i = 0; i < 16; ++i) { ot[0][i] = 0.f; ot[1][i] = 0.f; }
    float mrun = -1e30f, lsum = 0.f;
    const int nt = nkeys >> 6;
    for (int it = 0; it < nt; ++it) {
        const int cur = it & 1;
        if (it + 1 < nt) { kr = ldg16(kg + (size_t)(it + 1) * 4096); vr = ldg16(vg + (it + 1) * 64); }
        const unsigned char* kb = Kb + cur * 9216; const unsigned char* vb = Vb + cur * 8704;
        f32x16 st[2]; bf16x8 kf[2][4];
#pragma unroll
        for (int kt = 0; kt < 2; ++kt)
#pragma unroll
            for (int s = 0; s < 4; ++s) kf[kt][s] = *(const PG8_LAS bf16x8*)(const PG8_LAS unsigned char*)(kb + (32 * kt + c) * 144 + (16 * s + 8 * hh) * 2);
#pragma unroll
        for (int kt = 0; kt < 2; ++kt) {
#pragma unroll
            for (int i = 0; i < 16; ++i) st[kt][i] = 0.f;
#pragma unroll
            for (int s = 0; s < 4; ++s) st[kt] = mfma32p(kf[kt][s], qf[s], st[kt]); }
        float mx = fmaxf(fmaxf(st[0][0], st[0][1]), st[0][2]);
#pragma unroll
        for (int i = 3; i < 15; i += 2) mx = fmaxf(fmaxf(mx, st[0][i]), st[0][i + 1]);
        mx = fmaxf(mx, st[0][15]);
#pragma unroll
        for (int i = 0; i < 16; i += 2) mx = fmaxf(fmaxf(mx, st[1][i]), st[1][i + 1]);
        mx = fmaxf(mx, shx(mx, 32, lane));
        const float mnew = fmaxf(mrun, mx), alpha = __builtin_amdgcn_exp2f(mrun - mnew); mrun = mnew;
        f32x2 ps2 = (f32x2){0.f, 0.f}; const f32x2 mn2 = (f32x2){mnew, mnew};
#pragma unroll
        for (int kt = 0; kt < 2; ++kt)
#pragma unroll
            for (int i = 0; i < 16; i += 2) { f32x2 d = (f32x2){st[kt][i], st[kt][i + 1]} - mn2; f32x2 pp; pp.x = __builtin_amdgcn_exp2f(d.x); pp.y = __builtin_amdgcn_exp2f(d.y); st[kt][i] = pp.x; st[kt][i + 1] = pp.y; ps2 += pp; }
        const float ps = ps2.x + ps2.y;
        lsum = lsum * alpha + ps;
        if (__builtin_amdgcn_ballot_w64(alpha != 1.0f) != 0ull) {
#pragma unroll
            for (int i = 0; i < 16; ++i) { ot[0][i] *= alpha; ot[1][i] *= alpha; } }
        s16x4 vlo[2][2][2], vhi[2][2][2];
#pragma unroll
        for (int kt = 0; kt < 2; ++kt)
#pragma unroll
            for (int sp = 0; sp < 2; ++sp)
#pragma unroll
                for (int dt = 0; dt < 2; ++dt) { const PG8_LAS unsigned char* vrow = (const PG8_LAS unsigned char*)(vb + (32 * dt + c) * 136 + (32 * kt + 16 * sp + 4 * hh) * 2);
                    vlo[kt][sp][dt] = *(const PG8_LAS s16x4*)vrow; vhi[kt][sp][dt] = *(const PG8_LAS s16x4*)(vrow + 16); }
#pragma unroll
        for (int kt = 0; kt < 2; ++kt)
#pragma unroll
            for (int sp = 0; sp < 2; ++sp) {
                const bf16x8 pk = pack8(st[kt][8 * sp], st[kt][8 * sp + 1], st[kt][8 * sp + 2], st[kt][8 * sp + 3], st[kt][8 * sp + 4], st[kt][8 * sp + 5], st[kt][8 * sp + 6], st[kt][8 * sp + 7]);
#pragma unroll
                for (int dt = 0; dt < 2; ++dt) { const bf16x8 va = __builtin_shufflevector(vlo[kt][sp][dt], vhi[kt][sp][dt], 0, 1, 2, 3, 4, 5, 6, 7); ot[dt] = mfma32p(va, pk, ot[dt]); } }
        if (it + 1 < nt) { const int nx = cur ^ 1;
            *(u32x4*)(Kb + nx * 9216 + srow * 144 + sseg * 16) = kr;
            u32x2* d = (u32x2*)(Vb + nx * 8704 + srow * 136 + sseg * 16); u32x2 a; a.x = vr.x; a.y = vr.y; u32x2 b; b.x = vr.z; b.y = vr.w; d[0] = a; d[1] = b; }
        __syncthreads();
    }
    const float ltot = lsum + shx(lsum, 32, lane); const float inv = 1.0f / ltot;
    bf16_t* op = MIX + (size_t)qtok * 1024 + hq * 64;
#pragma unroll
    for (int dt = 0; dt < 2; ++dt)
#pragma unroll
        for (int g4 = 0; g4 < 4; ++g4) { u32x2 pw; pw.x = pk2(ot[dt][4 * g4] * inv, ot[dt][4 * g4 + 1] * inv); pw.y = pk2(ot[dt][4 * g4 + 2] * inv, ot[dt][4 * g4 + 3] * inv);
            stg8(op + 32 * dt + 8 * g4 + 4 * hh, pw); }
}

template <int DIR, bool FULL>
DI void ssm_pass(int layer, int pr, int g, const bf16_t* __restrict__ U, const bf16x8* __restrict__ Bm, const bf16x8* __restrict__ Cm, const float* __restrict__ lam,
                 const float* __restrict__ state_in, const float* sseg_r, float* sseg_w, float* YF, bf16_t* __restrict__ G, const float* __restrict__ dskip,
                 float* __restrict__ out_state, unsigned char* hl, int wv) {
    const int lane = ltid(wv) & 63, c = lane & 31, hh = lane >> 5, fr = lane & 15, kq = lane >> 4;
    const int ldg = (layer * 2 + DIR) * 32 + g;
    bf16x8 bm[4], cm[4];
#pragma unroll
    for (int i = 0; i < 4; ++i) { bm[i] = Bm[(ldg * 4 + i) * 64 + lane]; if (FULL) cm[i] = Cm[(ldg * 4 + i) * 64 + lane]; }
    const float l0r = lam[(ldg * 64 + c) * 2], l0i = lam[(ldg * 64 + c) * 2 + 1], l1r = lam[(ldg * 64 + 32 + c) * 2], l1i = lam[(ldg * 64 + 32 + c) * 2 + 1];
    const int s = 2 * pr + hh;
    float h0r = 0.f, h0i = 0.f, h1r = 0.f, h1i = 0.f;
    if (FULL && pr >= 16) {
        const int sl = s - 32, b = sl >> 3, seg = sl & 7;
        float a0r = l0r, a0i = l0i, a1r = l1r, a1i = l1i;
#pragma unroll
        for (int i = 0; i < 8; ++i) { const float t0 = a0r * a0r - a0i * a0i, t1 = 2.f * a0r * a0i; a0r = t0; a0i = t1; const float t2 = a1r * a1r - a1i * a1i, t3 = 2.f * a1r * a1i; a1r = t2; a1i = t3; }
        const float* si = state_in + ((((size_t)(b * 2 + layer) * 2 + DIR) * 2) * 32 + g) * 64;
        h0r = si[c]; h0i = si[2048 + c]; h1r = si[32 + c]; h1i = si[2048 + 32 + c];
        const int n = DIR == 0 ? seg : 7 - seg;
        for (int jj = 0; jj < n; ++jj) { const int j = DIR == 0 ? jj : 7 - jj;
            const float* sp = sseg_r + ((((size_t)(b * 8 + j) * 2 + DIR) * 32 + g) * 64) * 2;
            const float s0r = sp[c * 2], s0i = sp[c * 2 + 1], s1r = sp[(32 + c) * 2], s1i = sp[(32 + c) * 2 + 1];
            const float n0r = a0r * h0r - a0i * h0i + s0r, n0i = a0r * h0i + a0i * h0r + s0i; h0r = n0r; h0i = n0i;
            const float n1r = a1r * h1r - a1i * h1i + s1r, n1i = a1r * h1i + a1i * h1r + s1i; h1r = n1r; h1i = n1i; }
    }
    const int seq_r = (c >> 2) & 1, q_r = (c & 3) + 4 * (c >> 3);
    const bf16_t* ua_ptr = U + ((size_t)((2 * pr + seq_r) * 256 + q_r)) * 512 + g * 16 + 8 * hh;
    f32x16 zero16;
#pragma unroll
    for (int i = 0; i < 16; ++i) zero16[i] = 0.f;
    auto ldu = [&](int ch) -> bf16x8 { return __builtin_bit_cast(bf16x8, ldg16(ua_ptr + (size_t)(DIR ? 240 - 16 * ch : 16 * ch) * 512)); };
    auto body = [&](const bf16x8 ua, int ch) {
        const int cb = DIR ? 240 - 16 * ch : 16 * ch;
        f32x16 x[4];
#pragma unroll
        for (int i = 0; i < 4; ++i) x[i] = mfma32(ua, bm[i], zero16);
#pragma unroll
        for (int i = 0; i < 16; ++i) { const int reg = DIR ? 15 - i : i;
            const float n0r = __builtin_fmaf(l0r, h0r, __builtin_fmaf(-l0i, h0i, x[0][reg])), n0i = __builtin_fmaf(l0r, h0i, __builtin_fmaf(l0i, h0r, x[1][reg])); h0r = n0r; h0i = n0i;
            const float n1r = __builtin_fmaf(l1r, h1r, __builtin_fmaf(-l1i, h1i, x[2][reg])), n1i = __builtin_fmaf(l1r, h1i, __builtin_fmaf(l1i, h1r, x[3][reg])); h1r = n1r; h1i = n1i;
            if (FULL) { unsigned* hrow = (unsigned*)(hl + (hh * 16 + reg) * 272); hrow[c] = pk2(h0r, h0i); hrow[32 + c] = pk2(h1r, h1i); } }
        if (FULL) {
#pragma unroll
            for (int sq = 0; sq < 2; ++sq) { f32x4 y = (f32x4){0.f, 0.f, 0.f, 0.f};
#pragma unroll
                for (int ks = 0; ks < 4; ++ks) { const bf16x8 af = *(const bf16x8*)(hl + (sq * 16 + fr) * 272 + (32 * ks + 8 * kq) * 2); y = mfma16(cm[ks], af, y); }
                { u32x2 pw; pw.x = pk2(y[0], y[1]); pw.y = pk2(y[2], y[3]); stg8((bf16_t*)YF + ((size_t)((2 * pr + sq) * 256 + cb + fr)) * 512 + g * 16 + 4 * kq, pw); } }
        }
    };
    bf16x8 u0 = ldu(0), u1 = ldu(1), u2 = ldu(2), u3 = ldu(3);
#pragma unroll 1
    for (int c4 = 0; c4 < 16; c4 += 4) {
        const bool more = c4 + 4 < 16;
        body(u0, c4);     if (more) u0 = ldu(c4 + 4);
        body(u1, c4 + 1); if (more) u1 = ldu(c4 + 5);
        body(u2, c4 + 2); if (more) u2 = ldu(c4 + 6);
        body(u3, c4 + 3); if (more) u3 = ldu(c4 + 7);
    }
    if (FULL) { if (pr < 16) { float* os = out_state + ((((size_t)(s * 2 + layer) * 2 + DIR) * 2) * 32 + g) * 64; os[c] = h0r; os[2048 + c] = h0i; os[32 + c] = h1r; os[2048 + 32 + c] = h1i; } }
    else { float* sw = sseg_w + ((((size_t)(s - 32) * 2 + DIR) * 32 + g) * 64) * 2; sw[c * 2] = h0r; sw[c * 2 + 1] = h0i; sw[(32 + c) * 2] = h1r; sw[(32 + c) * 2 + 1] = h1i; }
}

#define XB_TMO      128
#define XB_XCNT(j)  (256  + 64 * (j))
#define XB_XSUB(j)  (1280 + 64 * (j))
#define XB_XGEN(j)  (2304 + 64 * (j))
#define XB_TOP      3328
#define XB_TOPGEN   3392
#define XCD_BAR_WORDS 3456
#define XB_SPIN_CAP (1u << 18)
#define LAS __attribute__((address_space(3)))

__device__ __forceinline__ unsigned xb_ld(unsigned* p)              { return __hip_atomic_load(p, __ATOMIC_RELAXED, __HIP_MEMORY_SCOPE_AGENT); }
__device__ __forceinline__ unsigned xb_add(unsigned* p, unsigned v) { return __hip_atomic_fetch_add(p, v, __ATOMIC_RELAXED, __HIP_MEMORY_SCOPE_AGENT); }
__device__ __forceinline__ unsigned xb_xcc_id() { return (unsigned)__builtin_amdgcn_s_getreg((3 << 11) | 20) & 0xFu; }
#define XB_SPIN(cond, bar) do { unsigned _sp = 0; while (cond) { __builtin_amdgcn_s_sleep(1); \
    if ((++_sp & 255u) == 0u) { if (xb_ld(&(bar)[XB_TMO])) break; if (_sp > XB_SPIN_CAP) { atomicAdd(&(bar)[XB_TMO], 1u); break; } } } } while (0)

struct XcdBarrier {
    unsigned* bar; unsigned x;
    volatile LAS unsigned* st;
};

__device__ __forceinline__ XcdBarrier xcd_barrier_post(unsigned* bar, volatile LAS unsigned* st) {
    XcdBarrier b; b.bar = bar; b.x = xb_xcc_id(); b.st = st;
    if (threadIdx.x == 0) (void)xb_add(&bar[XB_XCNT(b.x)], 1u);
    return b;
}
__device__ __forceinline__ void xcd_barrier_complete(unsigned* bar, unsigned x, unsigned& nloc, unsigned& nx) {
    const unsigned G = gridDim.x * gridDim.y * gridDim.z;
    unsigned sum, cnt, mine, sp = 0u;
    for (;;) {
        sum = 0u; cnt = 0u; mine = 0u;
#pragma unroll
        for (unsigned j = 0; j < 16; ++j) { const unsigned c = xb_ld(&bar[XB_XCNT(j)]); sum += c; cnt += (c > 0u) ? 1u : 0u; mine = (j == x) ? c : mine; }
        if (sum == G) break;
        __builtin_amdgcn_s_sleep(1);
        if ((++sp & 255u) == 0u) { if (xb_ld(&bar[XB_TMO])) break; if (sp > XB_SPIN_CAP) { atomicAdd(&bar[XB_TMO], 1u); break; } }
    }
    nloc = mine > 0u ? mine : 1u; nx = cnt > 0u ? cnt : 1u;
}

__device__ __forceinline__ void xcd_barrier(const XcdBarrier& b) {
    asm volatile("s_waitcnt vmcnt(0)" ::: "memory");
    __syncthreads();
    if (threadIdx.x == 0) {
        unsigned* bar = b.bar;
        __builtin_amdgcn_s_waitcnt(0);
        unsigned nloc = b.st[0], nx = b.st[1];
        if (nloc == 0u) { xcd_barrier_complete(bar, b.x, nloc, nx); b.st[0] = nloc; b.st[1] = nx; }
        const unsigned old = xb_add(&bar[XB_XSUB(b.x)], 1u);
        const unsigned gen = old / nloc;
        if (old + 1u == (gen + 1u) * nloc) {
            __builtin_amdgcn_fence(__ATOMIC_RELEASE, "agent");
            asm volatile("s_waitcnt vmcnt(0)" ::: "memory");
            const unsigned og = xb_add(&bar[XB_TOP], 1u);
            const unsigned tg = og / nx;
            if (og + 1u == (tg + 1u) * nx) xb_add(&bar[XB_TOPGEN], 1u);
            else XB_SPIN(xb_ld(&bar[XB_TOPGEN]) == tg, bar);
            __builtin_amdgcn_fence(__ATOMIC_ACQUIRE, "agent");
            xb_add(&bar[XB_XGEN(b.x)], 1u);
            asm volatile("s_waitcnt vmcnt(0)" ::: "memory");
        } else {
            XB_SPIN(xb_ld(&bar[XB_XGEN(b.x)]) == gen, bar);
            __builtin_amdgcn_fence(__ATOMIC_ACQUIRE, "agent");
            asm volatile("s_waitcnt vmcnt(0)" ::: "memory");
        }
    }
    __syncthreads();
}


typedef const __attribute__((address_space(4))) Params* KParamsPtr;
DI KParamsPtr kparams() { KParamsPtr p = (KParamsPtr)__builtin_amdgcn_kernarg_segment_ptr(); asm volatile("" : "+s"(p)); return p; }
#define PKP (kparams())
__global__ __launch_bounds__(512, 2) void mega_fwd(Params P) {
    extern __shared__ __attribute__((aligned(16))) unsigned char shm[];
    cg::grid_group grid = cg::this_grid();
#define WSP_ (opaque_ptr(PKP->ws))
#define XP_ ((float*)opaque_ptr((unsigned char*)PKP->out))
#define MODS_ ((const float*)(WSP_ + WS_MODS))
#define HB_ ((bf16_t*)(WSP_ + WS_H))
#define YFP_ ((float*)(WSP_ + WS_H))
#define QB_ ((bf16_t*)(WSP_ + WS_Q))
#define UB_ ((bf16_t*)(WSP_ + WS_U))
#define MIXB_ ((bf16_t*)(WSP_ + WS_MIX))
#define GB_ ((bf16_t*)(WSP_ + WS_G))
#define ACTB_ ((bf16_t*)(WSP_ + WS_ACT))
#define KCTX_ ((bf16_t*)(WSP_ + WS_KCTX))
#define VCTX_ ((bf16_t*)(WSP_ + WS_VCTX))
    const int w = __builtin_amdgcn_readfirstlane(threadIdx.x >> 6);
    if (PKP->ws == nullptr) grid.sync();
    if (threadIdx.x == 0) { ((volatile LAS unsigned*)(shm + 131072))[0] = 0u; ((volatile LAS unsigned*)(shm + 131072))[1] = 0u; }
    __syncthreads();
    (void)xcd_barrier_post((unsigned*)(WSP_ + WS_BAR), (volatile LAS unsigned*)(shm + 131072));
#define GSYNC() do { XcdBarrier b_; b_.bar = (unsigned*)(opaque_ptr(PKP->ws) + WS_BAR); b_.x = xb_xcc_id(); b_.st = (volatile LAS unsigned*)(shm + 131072); xcd_barrier(b_); } while (0)

    { Params Pl; for (int i = 0; i < 28; ++i) Pl.in[i] = PKP->in[i]; Pl.out = PKP->out; Pl.ws = PKP->ws; phase0(Pl, shm, w); }
    GSYNC();
    { const int tid = ltid(w); const float* rcg = (const float*)(WSP_ + WS_ROPEC); const float* rsg = (const float*)(WSP_ + WS_ROPES); float* lrw = (float*)(shm + LDS_ROPE);
      { const int e = tid, r = e >> 4, i = e & 15; lrw[e] = rcg[(64 * r) * 32 + i]; lrw[512 + e] = rsg[(64 * r) * 32 + i]; }
      for (int e = tid; e < 1024; e += 512) { const int cidx = e >> 4, i = e & 15; lrw[1024 + e] = rcg[cidx * 32 + 16 + i]; lrw[2048 + e] = rsg[cidx * 32 + 16 + i]; }
      __syncthreads(); }
#pragma unroll 1
    for (int l = 0; l < 2; ++l) {
#define MODSL_ (MODS_ + l * 5 * 6144)
#define XA_ (PKP->in[0])
#define XH_ ((bf16_t*)(WSP_ + WS_XB))
#define XB_ (PKP->in[1])
#define KLAT_ ((bf16_t*)(WSP_ + WS_KLAT + l * SZ_KLAT))
#define VLAT_ ((bf16_t*)(WSP_ + WS_VLAT + l * SZ_KLAT))
        if (l == 0) {
            const int tid = ltid(w); const float* part = (const float*)(WSP_ + WS_MODP); const float* bm_ = PKP->in[8]; float* mw = (float*)(WSP_ + WS_MODS); float* ldsf = (float*)opaque_ptr(shm);
            for (int idx = blockIdx.x * 512 + tid; idx < 61440; idx += gridDim.x * 512) { const int ll = idx / 30720, n = idx % 6144;
                mw[idx] = part[idx] + part[61440 + idx] + part[2 * 61440 + idx] + part[3 * 61440 + idx] + bm_[ll * 6144 + n]; }
            for (int e = tid; e < 10240; e += 512) { const int j = e >> 11, r = e & 2047; const int idx = j * 6144 + r;
                ldsf[e] = part[idx] + part[61440 + idx] + part[2 * 61440 + idx] + part[3 * 61440 + idx] + bm_[r]; }
            __syncthreads();
            for (int rep = 0; rep < REP_NORM; ++rep) norm_phase(XA_, XB_, nullptr, PKP->in[9], ldsf, 2048, 0, 1024, HB_, w);
        } else
        for (int rep = 0; rep < REP_NORM; ++rep) norm_phase(XA_, XB_, XH_, PKP->in[9] + l * 1024, MODSL_, 6144, 0, 1024, HB_, w);
        GSYNC();
        { EpiIn E; E.layer = l; E.qn = PKP->in[12] + l * 64; E.kn = PKP->in[13] + l * 64; E.lr = (const PG8_LAS float*)(shm + LDS_ROPE);
          E.Q = QB_; E.U = UB_; E.Kctx = KCTX_; E.Vctx = VCTX_; E.Klat = KLAT_; E.Vlat = VLAT_; E.outk = PKP->out + OUT_K; E.outv = PKP->out + OUT_V;
          { pg8::Gemm g; g.A = HB_; g.Bt = (const bf16_t*)(WSP_ + WS_WIN + l * SZ_WIN); g.M = NTOK; g.N = 1280; g.K = 1024;
            ListOrder S; S.count = 256; S.G = (int)gridDim.x; S.c = (int)blockIdx.x; S.mode = 0;
            pg8::gemm_phase<EpiIn, ListOrder, false>((PG8_LAS unsigned char*)shm, g, S, E, nullptr, w); }
          GSYNC();
          { pg8::Gemm g; g.A = HB_; g.Bt = (const bf16_t*)(WSP_ + WS_WIN + l * SZ_WIN); g.M = NTOK; g.N = 1280; g.K = 1024;
            ListOrder S; S.count = 64; S.G = (int)gridDim.x; S.c = (int)blockIdx.x; S.mode = 1;
            pg8::gemm_phase<EpiIn, ListOrder, false>((PG8_LAS unsigned char*)shm, g, S, E, nullptr, w); } }
        { const int nb = gridDim.x > 64 ? 64 : 0;
          if ((int)blockIdx.x >= nb)
          for (int it = blockIdx.x - nb; it < 384; it += gridDim.x - nb) {
            __syncthreads();
            if (it < 256) { const int qc = it & 3, kvh = (it >> 2) & 1, b = it >> 3;
                attn_item(QB_, KCTX_ + ((size_t)(b * 2 + kvh) * 256) * 64, VCTX_ + ((size_t)(b * 2 + kvh) * 64) * 256, 256, 256, b * 256 + qc * 64, kvh, MIXB_, shm, w); }
            else { const int wi = (it - 256) * 8 + w; const int dir = wi & 1, g = (wi >> 1) & 31, pr = 16 + (wi >> 6);
                if (dir == 0) ssm_pass<0, false>(l, pr, g, UB_, (const bf16x8*)(WSP_ + WS_SSMB), (const bf16x8*)(WSP_ + WS_SSMC), (const float*)(WSP_ + WS_SSML), PKP->in[4], nullptr, (float*)(WSP_ + WS_SSEG), nullptr, nullptr, nullptr, nullptr, nullptr, w);
                else ssm_pass<1, false>(l, pr, g, UB_, (const bf16x8*)(WSP_ + WS_SSMB), (const bf16x8*)(WSP_ + WS_SSMC), (const float*)(WSP_ + WS_SSML), PKP->in[4], nullptr, (float*)(WSP_ + WS_SSEG), nullptr, nullptr, nullptr, nullptr, nullptr, w); }
          } }
        GSYNC();
        for (int rep = 0; rep < REP_ATT4; ++rep)
        for (int it = blockIdx.x; it < 512; it += gridDim.x) {
            __syncthreads();
            if (it < 256) { const int qc = it >> 3, kvh = it & 1, b = (it >> 1) & 3;
                attn_item(QB_, KLAT_ + ((size_t)(b * 2 + kvh) * 2560) * 64, VLAT_ + ((size_t)(b * 2 + kvh) * 64) * 2560, 2560, 2560, NCTX + b * 2048 + qc * 64, kvh, MIXB_, shm, w); }
            else { const int si = it - 256, pr = si >> 3, gq = si & 7, g = gq * 4 + (w & 3);
                if (w < 4) ssm_pass<0, true>(l, pr, g, UB_, (const bf16x8*)(WSP_ + WS_SSMB), (const bf16x8*)(WSP_ + WS_SSMC), (const float*)(WSP_ + WS_SSML), PKP->in[4], (const float*)(WSP_ + WS_SSEG), nullptr, YFP_, nullptr, nullptr, PKP->out + OUT_S, shm + w * 8704, w);
                else ssm_pass<1, true>(l, pr, g, UB_, (const bf16x8*)(WSP_ + WS_SSMB), (const bf16x8*)(WSP_ + WS_SSMC), (const float*)(WSP_ + WS_SSML), PKP->in[4], (const float*)(WSP_ + WS_SSEG), nullptr, (float*)(WSP_ + WS_YB), nullptr, nullptr, PKP->out + OUT_S, shm + w * 8704, w);
                __syncthreads();
                { const int tid = ltid(w); const float* YBp = (const float*)(WSP_ + WS_YB); const float* dsk = PKP->in[21] + l * 512;
#pragma unroll 4
                  for (int i = 0; i < 16; ++i) { const int idx = i * 512 + tid, tk = pr * 512 + (idx >> 4), ch = gq * 64 + (idx & 15) * 4; const size_t o = (size_t)tk * 512 + ch;
                      const u32x2 yfw = *(const u32x2*)((const bf16_t*)YFP_ + o), ybw = *(const u32x2*)((const bf16_t*)YBp + o); const f32x4 dd = *(const f32x4*)(dsk + ch); const u32x2 uw = *(const u32x2*)(UB_ + o);
                      const f32x4 yf = (f32x4){bflo(yfw.x), bfhi(yfw.x), bflo(yfw.y), bfhi(yfw.y)}, yb = (f32x4){bflo(ybw.x), bfhi(ybw.x), bflo(ybw.y), bfhi(ybw.y)};
                      f32x4 v; v[0] = yf[0] + yb[0] + dd[0] * bflo(uw.x); v[1] = yf[1] + yb[1] + dd[1] * bfhi(uw.x); v[2] = yf[2] + yb[2] + dd[2] * bflo(uw.y); v[3] = yf[3] + yb[3] + dd[3] * bfhi(uw.y);
                      const f32x2 ga = gelu_pk((f32x2){v[0], v[1]}), gb = gelu_pk((f32x2){v[2], v[3]});
                      u32x2 pw; pw.x = pk2(ga.x, ga.y); pw.y = pk2(gb.x, gb.y); *(u32x2*)(GB_ + o) = pw; } } }
        }
        GSYNC();
        { EpiGlu E; E.G = GB_; E.bias = PKP->in[23] + l * 512; E.MIX = MIXB_; for (int rep = 0; rep < REP_GLU; ++rep) run_gemm(shm, GB_, (const bf16_t*)(WSP_ + WS_WGLU + l * SZ_WGLU), 512, 512, E, w); }
        GSYNC();
        { EpiRes E; E.xa = XA_; E.xb = XB_; E.xh = l == 0 ? nullptr : XH_; E.Xo = XH_; E.gate = MODSL_ + 2 * 1024; run_gemm(shm, MIXB_, (const bf16_t*)(WSP_ + WS_WOUT + l * SZ_WOUT), 1024, 1024, E, w); }
        GSYNC();
        for (int rep = 0; rep < REP_NORM; ++rep) norm_phase(XA_, XB_, XH_, PKP->in[10] + l * 1024, MODSL_, 6144, 3 * 1024, 4 * 1024, HB_, w);
        GSYNC();
        { EpiFfn1 E; E.ACT = ACTB_; for (int rep = 0; rep < REP_F1; ++rep) run_gemm(shm, HB_, (const bf16_t*)(WSP_ + WS_WF1 + l * SZ_WF1), 5632, 1024, E, w); }
        GSYNC();
        { EpiRes E; E.xa = XA_; E.xb = XB_; E.xh = XH_; E.Xo = XH_; E.gate = MODSL_ + 5 * 1024; run_gemm(shm, ACTB_, (const bf16_t*)(WSP_ + WS_WF2 + l * SZ_WF2), 1024, 2816, E, w); }
        GSYNC();
    }
    final_norm_phase(XH_, XP_, PKP->in[27], w);
}
#undef WSP_
#undef XP_
#undef MODS_
#undef HB_
#undef YFP_
#undef QB_
#undef UB_
#undef MIXB_
#undef GB_
#undef ACTB_
#undef KCTX_
#undef VCTX_
#undef MODSL_
#undef XA_
#undef XH_
#undef XB_
#undef KLAT_
#undef VLAT_

extern "C" void kernel_launch(void* const* d_in, const int* in_sizes, int n_in, void* d_out, int out_size, void* d_ws, size_t ws_size, hipStream_t stream) {
    static int grid_blocks = 0;
    if (grid_blocks == 0) {
        if (n_in < 28 || ws_size < WS_END) { fprintf(stderr, "kernel_launch: need 28 inputs and %zu bytes of workspace (got %d, %zu)\n", (size_t)WS_END, n_in, ws_size); grid_blocks = -1; return; }
        int dev = 0, cus = 0, per_cu = 0;
        (void)hipGetDevice(&dev);
        (void)hipDeviceGetAttribute(&cus, hipDeviceAttributeMultiprocessorCount, dev);
        if (hipFuncSetAttribute((const void*)mega_fwd, hipFuncAttributeMaxDynamicSharedMemorySize, LDS_BYTES) != hipSuccess) fprintf(stderr, "kernel_launch: hipFuncSetAttribute failed\n");
        if (hipOccupancyMaxActiveBlocksPerMultiprocessor(&per_cu, (const void*)mega_fwd, 512, LDS_BYTES) != hipSuccess || per_cu < 1) { per_cu = 1; (void)hipGetLastError(); }
        if (per_cu > 1) per_cu = 1;
        grid_blocks = cus * per_cu;
    }
    if (grid_blocks < 0) return;
    (void)hipMemsetAsync((unsigned char*)d_ws + WS_BAR, 0, SZ_BAR, stream);
    Params p{};
    for (int i = 0; i < 28; ++i) p.in[i] = (const float*)d_in[i];
    p.out = (float*)d_out; p.ws = (unsigned char*)d_ws;
    void* args[] = {&p};
    hipError_t e = hipLaunchCooperativeKernel((const void*)mega_fwd, dim3(grid_blocks), dim3(512), args, LDS_BYTES, stream);
    if (e != hipSuccess) fprintf(stderr, "cooperative launch failed: %s (grid %d)\n", hipGetErrorString(e), grid_blocks);
}
```

```cpp
#include <hip/hip_runtime.h>
#include <hip/hip_cooperative_groups.h>
#include <cstdio>
namespace cg = cooperative_groups;
#define DI __device__ __forceinline__
DI unsigned char* opaque_ptr(unsigned char* p) { asm volatile("" : "+s"(p)); return p; }
DI float shx(float v, int m, int lane) { return __int_as_float(__builtin_amdgcn_ds_bpermute((lane ^ m) << 2, __float_as_int(v))); }
DI int lane_now() { int l; asm volatile("v_mbcnt_lo_u32_b32 %0, -1, 0\n\tv_mbcnt_hi_u32_b32 %0, -1, %0" : "=v"(l)); return l; }
DI int ltid(int wv) { return wv * 64 + lane_now(); }

namespace pg8 {
#define PG8_LAS __attribute__((address_space(3)))
typedef unsigned short bf16_t;
typedef short bf16x8 __attribute__((ext_vector_type(8)));
typedef float f32x4 __attribute__((ext_vector_type(4)));
typedef unsigned u32x4 __attribute__((ext_vector_type(4)));
constexpr int BM = 256, BK = 64, HALF = 128, HTB = HALF * BK * 2  , STAGE_BYTES = 8 * HTB, NXCD = 8, WGM = 1;

__host__ __device__ __forceinline__ int lds_byte(int r, int c) { const int st = (r >> 4) * 2 + (c >> 5), rr = r & 15, cc = c & 31, ob = rr * 64 + cc * 2; return st * 1024 + (ob ^ (((ob >> 9) & 1) << 5)); }
__host__ __device__ __forceinline__ void stage_rc(int b, int& R, int& C) { const int st = b / 1024, sb = b % 1024, swz = sb ^ (((sb >> 9) & 1) << 5); R = (st >> 1) * 16 + swz / 64; C = (st & 1) * 32 + (swz % 64) / 2; }
__host__ __device__ __forceinline__ int perm32(int rho) { const int n = rho >> 4, i = rho & 15; return 8 * (i >> 2) + 4 * n + (i & 3); }

struct Unit { int pm, pn; };
struct Gemm { const bf16_t* A; const bf16_t* Bt; int M, N, K; };

struct StaticOrder {
    int nM, nN, nwg, G, c;
    __host__ __device__ void init(int M, int N, int G_, int c_) { nM = M / BM; nN = N / BM; nwg = nM * nN; G = G_; c = c_; }
    __host__ __device__ bool next(int i, Unit& u) const {
        const long L = (long)i * G + c; if (L >= nwg) return false;
        int wgid = (int)L; { const int q = nwg / NXCD, r = nwg % NXCD, xcd = wgid % NXCD, off = wgid / NXCD; wgid = (xcd < r ? xcd * (q + 1) : r * (q + 1) + (xcd - r) * q) + off; }
        const int nig = WGM * nN, gid = wgid / nig, fm = gid * WGM, gsz = (nM - fm) < WGM ? (nM - fm) : WGM;
        u.pm = fm + ((wgid % nig) % gsz); u.pn = (wgid % nig) / gsz; return true;
    }
    __device__ __forceinline__ void a_ready(const Unit&) const {}
    __device__ __forceinline__ void done(const Unit&) const {}
};

template <class Epi, class Sched, bool STAMP = false>
__device__ __forceinline__ void gemm_phase(PG8_LAS unsigned char* lds, const Gemm g, const Sched& S, const Epi& E, unsigned long long* stamps, int wv) {
    int tid_l; asm volatile("v_mbcnt_lo_u32_b32 %0, -1, 0\n\tv_mbcnt_hi_u32_b32 %0, -1, %0" : "=v"(tid_l)); tid_l += wv * 64;
    const int tid = tid_l, wid = __builtin_amdgcn_readfirstlane(tid >> 6), lane = tid & 63, wr = wid >> 2, wc = wid & 3, fr = lane & 15, fq = lane >> 4;
    const int K = g.K, nt = K / BK;
    int ts_lo = 0, ts_hi = 0, nts = 0; const unsigned long long rt_entry = STAMP ? (unsigned long long)wall_clock64() : 0ull;
#define PG8_STAMP() do { if (STAMP && wid == 0 && nts < 64) { const unsigned long long _c = (unsigned long long)clock64(); \
        ts_lo = (lane == nts) ? (int)(unsigned)_c : ts_lo; ts_hi = (lane == nts) ? (int)(unsigned)(_c >> 32) : ts_hi; ++nts; } } while (0)
    PG8_STAMP();
    unsigned voffA[2], voffB[2];
#pragma unroll
    for (int i = 0; i < 2; ++i) { int R, C; stage_rc(tid * 16 + i * 8192, R, C); const int Rb = Epi::PERM ? ((R & ~31) + perm32(R & 31)) : R;
        voffA[i] = (unsigned)(R * K + C) * 2u; voffB[i] = (unsigned)(Rb * K + C) * 2u; }
    const size_t kstep = (size_t)(BK * 2);
    const size_t hstep = (size_t)HALF * K * 2;
    const size_t tstep = 2 * hstep;
    const unsigned ldsw = (unsigned)wid * 1024u;
    const int aoff = lds_byte(wr * 64 + fr, fq * 8), boff = lds_byte(wc * 32 + fr, fq * 8);
#define PG8_SA(b, h) (((b) * 2 + (h)) * HTB)
#define PG8_SB(b, h) ((4 + (b) * 2 + (h)) * HTB)
#define PG8_STAGE(bufoff, gbase, voff) do { _Pragma("unroll") for (int _i = 0; _i < 2; ++_i) \
        __builtin_amdgcn_global_load_lds((const unsigned*)((const char*)(gbase) + (voff)[_i]), (PG8_LAS unsigned*)(lds + (bufoff) + ldsw + _i * 8192), 16, 0, 0); } while (0)
#define PG8_LDA(dst, b, h) do { _Pragma("unroll") for (int m = 0; m < 4; ++m) _Pragma("unroll") for (int k = 0; k < 2; ++k) dst[m][k] = *(const PG8_LAS bf16x8*)(lds + PG8_SA(b, h) + aoff + m * 2048 + k * 1024); } while (0)
#define PG8_LDB(dst, b, h) do { _Pragma("unroll") for (int n = 0; n < 2; ++n) _Pragma("unroll") for (int k = 0; k < 2; ++k) dst[n][k] = *(const PG8_LAS bf16x8*)(lds + PG8_SB(b, h) + boff + n * 2048 + k * 1024); } while (0)
#define PG8_MMA(ai, bj, At, Bt) do { __builtin_amdgcn_s_setprio(1); _Pragma("unroll") for (int m = 0; m < 4; ++m) _Pragma("unroll") for (int n = 0; n < 2; ++n) _Pragma("unroll") for (int k = 0; k < 2; ++k) \
        acc[ai][bj][m][n] = __builtin_amdgcn_mfma_f32_16x16x32_bf16(Bt[n][k], At[m][k], acc[ai][bj][m][n], 0, 0, 0); __builtin_amdgcn_s_setprio(0); } while (0)
#define PG8_WAIT_V(n) asm volatile("s_waitcnt vmcnt(" #n ")" ::: "memory")
#define PG8_WAIT_L(n) asm volatile("s_waitcnt lgkmcnt(" #n ")" ::: "memory")
#define PG8_BAR __builtin_amdgcn_s_barrier()
#define PG8_SCHED __builtin_amdgcn_sched_barrier(0)
    Unit cur, nxt; int ui = 0;
    if (!S.next(0, cur)) return;
    f32x4 acc[2][2][4][2];
#pragma unroll
    for (int a = 0; a < 2; ++a)
#pragma unroll
        for (int b = 0; b < 2; ++b)
#pragma unroll
            for (int m = 0; m < 4; ++m)
#pragma unroll
                for (int n = 0; n < 2; ++n) acc[a][b][m][n] = (f32x4){0.f, 0.f, 0.f, 0.f};
    bf16x8 At[4][2], B0[2][2], B1[2][2];
    const char* cA = (const char*)g.A + (size_t)cur.pm * tstep; const char* cB = (const char*)g.Bt + (size_t)cur.pn * tstep;
    S.a_ready(cur);
    PG8_STAGE(PG8_SB(0, 0), cB, voffB); PG8_STAGE(PG8_SA(0, 0), cA, voffA); PG8_STAGE(PG8_SB(0, 1), cB + hstep, voffB); PG8_STAGE(PG8_SA(0, 1), cA + hstep, voffA);
    if (wr == 1) PG8_BAR;
    PG8_WAIT_V(4); PG8_BAR;
    PG8_STAGE(PG8_SB(1, 0), cB + kstep, voffB); PG8_STAGE(PG8_SA(1, 0), cA + kstep, voffA); PG8_STAGE(PG8_SB(1, 1), cB + hstep + kstep, voffB);
    PG8_WAIT_V(6); PG8_BAR;
    PG8_STAMP();
    for (;;) {
        const bool has_next = S.next(ui + 1, nxt);
        const char* nA = has_next ? (const char*)g.A + (size_t)nxt.pm * tstep : cA; const char* nB = has_next ? (const char*)g.Bt + (size_t)nxt.pn * tstep : cB;
        for (int t = 0; t < nt; t += 2) {
            const bool last = (t == nt - 2);
            const char* a1 = cA + (size_t)(t + 1) * kstep;
            const char* a2 = last ? nA : cA + (size_t)(t + 2) * kstep; const char* b2 = last ? nB : cB + (size_t)(t + 2) * kstep;
            const char* a3 = a2 + kstep; const char* b3 = b2 + kstep;
            if (last && has_next) S.a_ready(nxt);
            PG8_LDB(B0, 0, 0); PG8_SCHED; PG8_LDA(At, 0, 0); PG8_STAGE(PG8_SA(1, 1), a1 + hstep, voffA);
            PG8_WAIT_L(8); PG8_BAR; PG8_WAIT_L(0); PG8_MMA(0, 0, At, B0); PG8_BAR; PG8_SCHED;
            PG8_LDB(B1, 0, 1); PG8_STAGE(PG8_SB(0, 0), b2, voffB);
            PG8_BAR; PG8_WAIT_L(0); PG8_MMA(0, 1, At, B1); PG8_BAR;
            PG8_LDA(At, 0, 1); PG8_STAGE(PG8_SA(0, 0), a2, voffA);
            PG8_BAR; PG8_WAIT_L(0); PG8_MMA(1, 0, At, B0); PG8_BAR; PG8_SCHED;
            PG8_STAGE(PG8_SB(0, 1), b2 + hstep, voffB);
            PG8_WAIT_V(6); PG8_BAR; PG8_MMA(1, 1, At, B1); PG8_BAR;
            PG8_LDB(B0, 1, 0); PG8_SCHED; PG8_LDA(At, 1, 0); PG8_STAGE(PG8_SA(0, 1), a2 + hstep, voffA);
            PG8_WAIT_L(8); PG8_BAR; PG8_WAIT_L(0); PG8_MMA(0, 0, At, B0); PG8_BAR; PG8_SCHED;
            PG8_LDB(B1, 1, 1); PG8_STAGE(PG8_SB(1, 0), b3, voffB);
            PG8_BAR; PG8_WAIT_L(0); PG8_MMA(0, 1, At, B1); PG8_BAR;
            PG8_LDA(At, 1, 1); PG8_STAGE(PG8_SA(1, 0), a3, voffA);
            PG8_BAR; PG8_WAIT_L(0); PG8_MMA(1, 0, At, B0); PG8_BAR; PG8_SCHED;
            PG8_STAGE(PG8_SB(1, 1), b3 + hstep, voffB);
            PG8_WAIT_V(6); PG8_BAR; PG8_MMA(1, 1, At, B1); PG8_BAR;
        }
        PG8_STAMP();
        if constexpr (!Epi::AFTER_DRAIN) { E(acc, cur, wr, wc, fr, fq); S.done(cur); }
        PG8_STAMP();
        if (!has_next) break;
#pragma unroll
        for (int a = 0; a < 2; ++a)
#pragma unroll
            for (int b = 0; b < 2; ++b)
#pragma unroll
                for (int m = 0; m < 4; ++m)
#pragma unroll
                    for (int n = 0; n < 2; ++n) acc[a][b][m][n] = (f32x4){0.f, 0.f, 0.f, 0.f};
        cur = nxt; cA = nA; cB = nB; ++ui;
    }
    PG8_WAIT_V(0);
    if (wr == 0) PG8_BAR;
    PG8_BAR;
    if constexpr (Epi::AFTER_DRAIN) { E.fused(acc, cur, wr, wc, fr, fq, lds, wid, lane); S.done(cur); }
    PG8_STAMP();
    if (STAMP && wid == 0) { stamps[lane] = lane < nts ? (((unsigned long long)(unsigned)ts_hi << 32) | (unsigned)ts_lo) : 0ull;
        if (lane == 62) stamps[62] = rt_entry; if (lane == 63) stamps[63] = (unsigned long long)wall_clock64(); }
#undef PG8_STAMP
#undef PG8_SA
#undef PG8_SB
#undef PG8_STAGE
#undef PG8_LDA
#undef PG8_LDB
#undef PG8_MMA
#undef PG8_WAIT_V
#undef PG8_WAIT_L
#undef PG8_BAR
#undef PG8_SCHED
}
}

typedef unsigned short bf16_t;
typedef short bf16x8 __attribute__((ext_vector_type(8)));
typedef short s16x4 __attribute__((ext_vector_type(4)));
typedef float f32x4 __attribute__((ext_vector_type(4)));
typedef float f32x2 __attribute__((ext_vector_type(2)));
typedef float f32x16 __attribute__((ext_vector_type(16)));
typedef unsigned u32x4 __attribute__((ext_vector_type(4)));
typedef unsigned u32x2 __attribute__((ext_vector_type(2)));
typedef __bf16 bf16x2_t __attribute__((ext_vector_type(2)));

constexpr int NTOK = 16384, DM = 1024, NCTX = 8192;
constexpr size_t SZ_WIN = (size_t)1280 * 1024 * 2, SZ_WGLU = (size_t)512 * 512 * 2, SZ_WOUT = (size_t)1024 * 1024 * 2, SZ_WF1 = (size_t)5632 * 1024 * 2, SZ_WF2 = (size_t)1024 * 2816 * 2;
constexpr size_t WS_WIN = 0, WS_WGLU = WS_WIN + 2 * SZ_WIN, WS_WOUT = WS_WGLU + 2 * SZ_WGLU, WS_WF1 = WS_WOUT + 2 * SZ_WOUT, WS_WF2 = WS_WF1 + 2 * SZ_WF1;
constexpr size_t WS_H = WS_WF2 + 2 * SZ_WF2;
constexpr size_t WS_Q = WS_H + (size_t)NTOK * 1024 * 2;
constexpr size_t WS_U = WS_Q + (size_t)NTOK * 512 * 2;
constexpr size_t WS_MIX = WS_U + (size_t)NTOK * 512 * 2;
constexpr size_t WS_G = WS_MIX + (size_t)NTOK * 1024 * 2;
constexpr size_t WS_ACT = WS_Q;
constexpr size_t WS_KLAT = WS_ACT + (size_t)NTOK * 2816 * 2;
constexpr size_t SZ_KLAT = (size_t)4 * 2 * 2560 * 64 * 2;
constexpr size_t WS_VLAT = WS_KLAT + 2 * SZ_KLAT;
constexpr size_t WS_KCTX = WS_VLAT + 2 * SZ_KLAT;
constexpr size_t SZ_KCTX = (size_t)32 * 2 * 256 * 64 * 2;
constexpr size_t WS_VCTX = WS_KCTX + SZ_KCTX;
constexpr size_t WS_MODS = WS_VCTX + SZ_KCTX;
constexpr size_t SZ_MODS = (size_t)2 * 5 * 6144 * 4;
constexpr size_t WS_BAR = WS_MODS + SZ_MODS;
constexpr size_t SZ_BAR = (size_t)3456 * 4;
constexpr size_t WS_ROPEC = WS_BAR + SZ_BAR;
constexpr size_t WS_ROPES = WS_ROPEC + (size_t)2048 * 32 * 4;
constexpr size_t WS_SSMB = WS_ROPES + (size_t)2048 * 32 * 4;
constexpr size_t WS_SSMC = WS_SSMB + (size_t)128 * 4096;
constexpr size_t WS_SSML = WS_SSMC + (size_t)128 * 4096;
constexpr size_t WS_SSEG = WS_SSML + (size_t)128 * 512;
constexpr size_t WS_YB = WS_SSEG + (size_t)32 * 2 * 32 * 64 * 2 * 4;
constexpr size_t WS_MODP = WS_YB + (size_t)NTOK * 512 * 4;
constexpr size_t WS_XB = WS_MODP + (size_t)4 * 61440 * 4;
constexpr size_t WS_END = WS_XB + (size_t)NTOK * 1024 * 2;
constexpr size_t OUT_K = (size_t)2 * 8388608, OUT_V = OUT_K + 2097152, OUT_S = OUT_V + 2097152;
constexpr int LDS_ROPE = 131072 + 16;
constexpr int LDS_BYTES = LDS_ROPE + 12288;

#ifndef REP_NORM
#define REP_NORM 1
#endif
#ifndef REP_IN
#define REP_IN 1
#endif
#ifndef REP_ATT3
#define REP_ATT3 1
#endif
#ifndef REP_ATT4
#define REP_ATT4 1
#endif
#ifndef REP_GLU
#define REP_GLU 1
#endif
#ifndef REP_F1
#define REP_F1 1
#endif
#ifndef REP_P0
#define REP_P0 1
#endif
struct Params { const float* in[28]; float* out; unsigned char* ws; };

DI unsigned pk2(float lo, float hi) { f32x2 v = {lo, hi}; return __builtin_bit_cast(unsigned, __builtin_convertvector(v, bf16x2_t)); }
DI float bf2f(bf16_t b) { return __uint_as_float(((unsigned)b) << 16); }
DI float bflo(unsigned w) { return __uint_as_float(w << 16); }
DI float bfhi(unsigned w) { return __uint_as_float(w & 0xffff0000u); }
DI bf16x8 pack8(float a0, float a1, float a2, float a3, float a4, float a5, float a6, float a7) {
    u32x4 p; p.x = pk2(a0, a1); p.y = pk2(a2, a3); p.z = pk2(a4, a5); p.w = pk2(a6, a7); return __builtin_bit_cast(bf16x8, p); }
DI f32x16 mfma32(bf16x8 a, bf16x8 b, f32x16 c) { return __builtin_amdgcn_mfma_f32_32x32x16_bf16(a, b, c, 0, 0, 0); }
DI f32x16 mfma32p(bf16x8 a, bf16x8 b, f32x16 c) { __builtin_amdgcn_s_setprio(1); f32x16 r = __builtin_amdgcn_mfma_f32_32x32x16_bf16(a, b, c, 0, 0, 0); __builtin_amdgcn_s_setprio(0); return r; }
DI f32x4 mfma16(bf16x8 a, bf16x8 b, f32x4 c) { return __builtin_amdgcn_mfma_f32_16x16x32_bf16(a, b, c, 0, 0, 0); }
DI f32x2 gelu_pk(f32x2 v) {
    const f32x2 av = __builtin_elementwise_abs(v), d = av * 0.2316418882f + 1.0f;
    f32x2 t; t.x = __builtin_amdgcn_rcpf(d.x); t.y = __builtin_amdgcn_rcpf(d.y);
    f32x2 q = t * 0.5307027145f + (-0.7265760135f); q = q * t + 0.7107068705f; q = q * t + (-0.142248368f); q = q * t + 0.127414796f; q = q * t;
    const f32x2 sq = (v * v) * (-0.72134752044f);
    f32x2 e; e.x = __builtin_amdgcn_exp2f(sq.x); e.y = __builtin_amdgcn_exp2f(sq.y);
    const f32x2 m = v * (q * e), r = v - m;
    f32x2 o; o.x = v.x < 0.f ? m.x : r.x; o.y = v.y < 0.f ? m.y : r.y; return o;
}
#define GAS __attribute__((address_space(1)))
DI u32x2 ldg8(const void* p) { return *(const GAS u32x2*)p; }
DI u32x4 ldg16(const void* p) { return *(const GAS u32x4*)p; }
DI f32x4 ldg16f(const void* p) { return *(const GAS f32x4*)p; }
DI f32x2 ldg8f(const void* p) { return *(const GAS f32x2*)p; }
DI void stg8(void* p, u32x2 v) { *(GAS u32x2*)p = v; }
DI void stg16(void* p, u32x4 v) { *(GAS u32x4*)p = v; }
DI void stg16f(void* p, f32x4 v) { *(GAS f32x4*)p = v; }
DI float sigmoidf_(float x) { return __builtin_amdgcn_rcpf(1.0f + __expf(-x)); }

DI void tconv_tile(const float* __restrict__ src, size_t sld, int ca, int cb, bf16_t* __restrict__ dst, size_t dld, float* lds, int wv) {
    const int tid = ltid(wv);
#pragma unroll
    for (int i = 0; i < 8; ++i) { const int idx = i * 512 + tid, kk = idx >> 6, nn = idx & 63; const int col = nn < 32 ? ca + nn : cb + nn - 32;
        lds[nn * 65 + kk] = src[(size_t)kk * sld + col]; }
    __syncthreads();
    { const int nn = tid >> 3, k8 = (tid & 7) * 8; const float* r = lds + nn * 65 + k8;
      u32x4 w; w.x = pk2(r[0], r[1]); w.y = pk2(r[2], r[3]); w.z = pk2(r[4], r[5]); w.w = pk2(r[6], r[7]);
      *(u32x4*)(dst + (size_t)nn * dld + k8) = w; }
    __syncthreads();
}
DI int srccol_in(int np) { const int pn = np >> 8, cpos = np & 255, bj = cpos >> 7, wc = (cpos >> 5) & 3, w = cpos & 31; return pn * 256 + wc * 64 + bj * 32 + w; }
DI int srccol_f1(int np) { const int tile = np >> 8, bj = (np >> 7) & 1, i = np & 127; return bj * 2816 + tile * 128 + i; }

DI void wconv_task(const Params& P, int t, float* lds, int wv) {
    const int l = t / 2752; int r = t % 2752;
    unsigned char* ws = P.ws;
    if (r < 320) { const int kt = r & 15, ntl = r >> 4, n0 = ntl * 64, k0 = kt * 64;
        tconv_tile(P.in[11] + ((size_t)l * 1024 + k0) * 1280, 1280, srccol_in(n0), srccol_in(n0 + 32), (bf16_t*)(ws + WS_WIN + l * SZ_WIN) + (size_t)n0 * 1024 + k0, 1024, lds, wv); return; }
    r -= 320;
    if (r < 64) { const int kt = r & 7, ntl = r >> 3, n0 = ntl * 64, k0 = kt * 64;
        tconv_tile(P.in[22] + ((size_t)l * 512 + k0) * 512, 512, n0, n0 + 32, (bf16_t*)(ws + WS_WGLU + l * SZ_WGLU) + (size_t)n0 * 512 + k0, 512, lds, wv); return; }
    r -= 64;
    if (r < 256) { const int kt = r & 15, ntl = r >> 4, n0 = ntl * 64, k0 = kt * 64;
        tconv_tile(P.in[24] + ((size_t)l * 1024 + k0) * 1024, 1024, n0, n0 + 32, (bf16_t*)(ws + WS_WOUT + l * SZ_WOUT) + (size_t)n0 * 1024 + k0, 1024, lds, wv); return; }
    r -= 256;
    if (r < 1408) { const int kt = r & 15, ntl = r >> 4, n0 = ntl * 64, k0 = kt * 64;
        tconv_tile(P.in[25] + ((size_t)l * 1024 + k0) * 5632, 5632, srccol_f1(n0), srccol_f1(n0 + 32), (bf16_t*)(ws + WS_WF1 + l * SZ_WF1) + (size_t)n0 * 1024 + k0, 1024, lds, wv); return; }
    r -= 1408;
    { const int kt = r % 44, ntl = r / 44, n0 = ntl * 64, k0 = kt * 64;
        tconv_tile(P.in[26] + ((size_t)l * 2816 + k0) * 1024, 1024, n0, n0 + 32, (bf16_t*)(ws + WS_WF2 + l * SZ_WF2) + (size_t)n0 * 2816 + k0, 2816, lds, wv); }
}

DI void adaln_task(const Params& P, int task, float* lds, int wv) {
    const int tid = ltid(wv), w = tid >> 6, lane = tid & 63;
    const int kc = task & 3, cgp = (task >> 2) % 24, l = task / 96;
    const int n = cgp * 256 + lane * 4;
    const int k0 = kc * 256 + w * 32;
    const float* wm = P.in[7] + ((size_t)l * 1024 + k0) * 6144 + n;
    const float* cc = P.in[5]; const float* cx = P.in[6];
    f32x4 wrow[32];
#pragma unroll
    for (int kk = 0; kk < 32; ++kk) wrow[kk] = *(const f32x4*)(wm + (size_t)kk * 6144);
    f32x4 acc[5];
#pragma unroll
    for (int j = 0; j < 5; ++j) acc[j] = (f32x4){0.f, 0.f, 0.f, 0.f};
#pragma unroll
    for (int kk = 0; kk < 32; ++kk) { const int k = k0 + kk;
#pragma unroll
        for (int j = 0; j < 5; ++j) { const float cv = (j == 0) ? cx[k] : cc[(j - 1) * 1024 + k]; const float sv = cv / (1.0f + __expf(-cv)); acc[j] += wrow[kk] * sv; } }
#pragma unroll
    for (int j = 0; j < 5; ++j) *(f32x4*)(lds + (w * 5 + j) * 256 + lane * 4) = acc[j];
    __syncthreads();
    float* part = (float*)(P.ws + WS_MODP) + (size_t)kc * 61440;
    for (int e = tid; e < 1280; e += 512) { const int j = e >> 8, col = e & 255; float sm = 0.f;
#pragma unroll
        for (int ww = 0; ww < 8; ++ww) sm += lds[(ww * 5 + j) * 256 + col];
        part[(l * 5 + j) * 6144 + cgp * 256 + col] = sm; }
    __syncthreads();
}

DI void ssmconst_task(const Params& P, int task, int wv) {
    const int idx = task * 512 + ltid(wv); const int p = idx & 63, ldg = idx >> 6;
    const double dt = exp((double)P.in[16][ldg]); const double ar = (double)P.in[14][ldg * 64 + p], ai = (double)P.in[15][ldg * 64 + p];
    const double mag = exp(ar * dt); double sn, cs; sincos(ai * dt, &sn, &cs);
    const double lr = mag * cs, li = mag * sn, den = ar * ar + ai * ai;
    const double zr = ((lr - 1.0) * ar + li * ai) / den, zi = (li * ar - (lr - 1.0) * ai) / den;
    float* lam = (float*)(P.ws + WS_SSML); lam[(ldg * 64 + p) * 2] = (float)lr; lam[(ldg * 64 + p) * 2 + 1] = (float)li;
    bf16_t* Bm = (bf16_t*)(P.ws + WS_SSMB); bf16_t* Cm = (bf16_t*)(P.ws + WS_SSMC);
    const float* bre = P.in[17] + ((size_t)ldg * 64 + p) * 16; const float* bim = P.in[18] + ((size_t)ldg * 64 + p) * 16;
    const int ntb = (p >= 32) ? 2 : 0;
    for (int h = 0; h < 16; ++h) { const double br = bre[h], bi = bim[h]; const float bbr = (float)(zr * br - zi * bi), bbi = (float)(zr * bi + zi * br);
        const int ln = (p & 31) + 32 * (h >> 3), j = h & 7;
        Bm[(((size_t)ldg * 4 + ntb) * 64 + ln) * 8 + j] = (bf16_t)(pk2(bbr, 0.f) & 0xffffu);
        Bm[(((size_t)ldg * 4 + ntb + 1) * 64 + ln) * 8 + j] = (bf16_t)(pk2(bbi, 0.f) & 0xffffu); }
    for (int hp = 0; hp < 16; ++hp) { const float cr = P.in[19][((size_t)ldg * 16 + hp) * 64 + p], ci = P.in[20][((size_t)ldg * 16 + hp) * 64 + p];
#pragma unroll
        for (int ri = 0; ri < 2; ++ri) { const int pp = 2 * p + ri, ks = pp >> 5, kq = (pp >> 3) & 3, j = pp & 7;
            Cm[(((size_t)ldg * 4 + ks) * 64 + kq * 16 + hp) * 8 + j] = (bf16_t)(pk2(ri ? -ci : cr, 0.f) & 0xffffu); } }
}

DI void phase0(const Params& P, unsigned char* shm, int wv) {
    float* lds = (float*)shm;
    constexpr int T_ADA = 192, T_W = 5504, T_V = 128, T_K = 128, T_S = 16, T_R = 128;
    constexpr int T_TOTAL = T_ADA + T_W + T_V + T_K + T_S + T_R;
    for (int rep = 0; rep < REP_P0; ++rep)
    for (int t = blockIdx.x; t < T_TOTAL; t += gridDim.x) {
        int r = t;
        if (r < T_ADA) { adaln_task(P, r, lds, wv); continue; }
        r -= T_ADA;
        if (r < T_W) { wconv_task(P, r, lds, wv); continue; }
        r -= T_W;
        if (r < T_V) { const int s8 = r & 7, kvh = (r >> 3) & 1, b = (r >> 4) & 3, l = r >> 6;
            tconv_tile(P.in[3] + (((size_t)(b * 2 + l) * 512 + s8 * 64) * 2 + kvh) * 64, 128, 0, 32,
                       (bf16_t*)(P.ws + WS_VLAT + l * SZ_KLAT) + ((size_t)(b * 2 + kvh) * 64) * 2560 + s8 * 64, 2560, lds, wv); continue; }
        r -= T_V;
        if (r < T_K) { const int idx = r * 4096 + ltid(wv) * 8; const int d = idx & 63, s = (idx >> 6) & 511, kvh = (idx >> 15) & 1, b = (idx >> 16) & 3, l = idx >> 18;
            const float* src = P.in[2] + ((((size_t)(b * 2 + l) * 512 + s) * 2 + kvh) * 64 + d);
            const f32x4 a = *(const f32x4*)src, c = *(const f32x4*)(src + 4);
            u32x4 w; w.x = pk2(a[0], a[1]); w.y = pk2(a[2], a[3]); w.z = pk2(c[0], c[1]); w.w = pk2(c[2], c[3]);
            *(u32x4*)((bf16_t*)(P.ws + WS_KLAT + l * SZ_KLAT) + ((size_t)(b * 2 + kvh) * 2560 + s) * 64 + d) = w; continue; }
        r -= T_K;
        if (r < T_S) { ssmconst_task(P, r, wv); continue; }
        r -= T_S;
        { const int idx = r * 512 + ltid(wv); const int tt = idx >> 5, i = idx & 31; const int pos = (i < 16) ? (tt >> 6) : (tt & 63); const int f = i & 15;
          const double inv = pow(10000.0, -(2.0 * f) / 32.0); double sn, cs; sincos((double)pos * inv, &sn, &cs);
          ((float*)(P.ws + WS_ROPEC))[idx] = (float)cs; ((float*)(P.ws + WS_ROPES))[idx] = (float)sn; }
    }
}

DI float wave_sum(float v, int lane) {
    v += shx(v, 32, lane); v += shx(v, 16, lane); v += shx(v, 8, lane); v += shx(v, 4, lane); v += shx(v, 2, lane); v += shx(v, 1, lane); return v; }

DI void norm_phase(const float* __restrict__ xa, const float* __restrict__ xb, const bf16_t* __restrict__ xh, const float* __restrict__ gw, const float* mbase, int jstride, int sh_off, int sc_off, bf16_t* __restrict__ H, int wv) {
    const int tidl = ltid(wv); const int lane = tidl & 63, w = tidl >> 6;
    for (int base = (blockIdx.x * 8 + w) * 8; base < NTOK; base += gridDim.x * 64) {
        const int j = base < NCTX ? 0 : 1 + ((base - NCTX) >> 11);
        f32x4 wv4[4], sh4[4];
#pragma unroll
        for (int i = 0; i < 4; ++i) { const int col = i * 256 + lane * 4;
            const f32x4 g4 = ldg16f(gw + col), sc = *(const f32x4*)(mbase + j * jstride + sc_off + col); sh4[i] = *(const f32x4*)(mbase + j * jstride + sh_off + col); wv4[i] = g4 * (sc + 1.0f); }
#pragma unroll
        for (int hb = 0; hb < 2; ++hb) {
            f32x4 v[4][4]; float ss[4];
            if (xh) { u32x2 t[4][4];
#pragma unroll
                for (int r = 0; r < 4; ++r)
#pragma unroll
                    for (int i = 0; i < 4; ++i) t[r][i] = ldg8(xh + (size_t)(base + hb * 4 + r) * 1024 + i * 256 + lane * 4);
#pragma unroll
                for (int r = 0; r < 4; ++r)
#pragma unroll
                    for (int i = 0; i < 4; ++i) v[r][i] = (f32x4){bflo(t[r][i].x), bfhi(t[r][i].x), bflo(t[r][i].y), bfhi(t[r][i].y)};
            } else { const float* xr = base < NCTX ? xa + (size_t)(base + hb * 4) * 1024 : xb + (size_t)(base + hb * 4 - NCTX) * 1024;
#pragma unroll
                for (int r = 0; r < 4; ++r)
#pragma unroll
                    for (int i = 0; i < 4; ++i) v[r][i] = ldg16f(xr + (size_t)r * 1024 + i * 256 + lane * 4); }
#pragma unroll
            for (int r = 0; r < 4; ++r) { float a = 0.f;
#pragma unroll
                for (int i = 0; i < 4; ++i) a += v[r][i][0] * v[r][i][0] + v[r][i][1] * v[r][i][1] + v[r][i][2] * v[r][i][2] + v[r][i][3] * v[r][i][3];
                ss[r] = a; }
#pragma unroll
            for (int mk = 32; mk >= 1; mk >>= 1)
#pragma unroll
                for (int r = 0; r < 4; ++r) ss[r] += shx(ss[r], mk, lane);
#pragma unroll
            for (int r = 0; r < 4; ++r) { const float rstd = rsqrtf(ss[r] * (1.0f / 1024.0f) + 1e-6f);
#pragma unroll
                for (int i = 0; i < 4; ++i) { const f32x4 o = v[r][i] * rstd * wv4[i] + sh4[i];
                    u32x2 pw; pw.x = pk2(o[0], o[1]); pw.y = pk2(o[2], o[3]); stg8(H + (size_t)(base + hb * 4 + r) * 1024 + i * 256 + lane * 4, pw); } }
        }
    }
}

DI void final_norm_phase(const bf16_t* __restrict__ xh, float* __restrict__ Y, const float* __restrict__ gw, int wv) {
    const int tidl = ltid(wv); const int lane = tidl & 63, w = tidl >> 6;
    for (int base = (blockIdx.x * 8 + w) * 8; base < NTOK; base += gridDim.x * 64) {
        f32x4 g4[4];
#pragma unroll
        for (int i = 0; i < 4; ++i) g4[i] = ldg16f(gw + i * 256 + lane * 4);
#pragma unroll
        for (int hb = 0; hb < 2; ++hb) {
            u32x2 t[4][4]; float ss[4];
#pragma unroll
            for (int r = 0; r < 4; ++r)
#pragma unroll
                for (int i = 0; i < 4; ++i) t[r][i] = ldg8(xh + (size_t)(base + hb * 4 + r) * 1024 + i * 256 + lane * 4);
            f32x4 v[4][4];
#pragma unroll
            for (int r = 0; r < 4; ++r) { float a = 0.f;
#pragma unroll
                for (int i = 0; i < 4; ++i) { v[r][i] = (f32x4){bflo(t[r][i].x), bfhi(t[r][i].x), bflo(t[r][i].y), bfhi(t[r][i].y)}; a += v[r][i][0] * v[r][i][0] + v[r][i][1] * v[r][i][1] + v[r][i][2] * v[r][i][2] + v[r][i][3] * v[r][i][3]; }
                ss[r] = a; }
#pragma unroll
            for (int mk = 32; mk >= 1; mk >>= 1)
#pragma unroll
                for (int r = 0; r < 4; ++r) ss[r] += shx(ss[r], mk, lane);
#pragma unroll
            for (int r = 0; r < 4; ++r) { const float rstd = rsqrtf(ss[r] * (1.0f / 1024.0f) + 1e-6f);
#pragma unroll
                for (int i = 0; i < 4; ++i) stg16f(Y + (size_t)(base + hb * 4 + r) * 1024 + i * 256 + lane * 4, v[r][i] * rstd * g4[i]); }
        }
    }
}

struct EpiIn {
    static constexpr bool PERM = true, AFTER_DRAIN = false;
    int layer; const float* qn; const float* kn; const PG8_LAS float* lr;
    bf16_t* Q; bf16_t* U; bf16_t* Kctx; bf16_t* Vctx; bf16_t* Klat; bf16_t* Vlat; float* outk; float* outv;
    DI void operator()(const f32x4 (&acc)[2][2][4][2], const pg8::Unit& u, int wr, int wc, int fr, int fq) const {
        asm volatile("" : "+v"(fr), "+v"(fq));
        const bool lat = u.pm >= 32; const int pn = u.pn;
        if (pn >= 3) {
#pragma unroll
            for (int ai = 0; ai < 2; ++ai)
#pragma unroll
                for (int m = 0; m < 4; ++m) { const int row = u.pm * 256 + ai * 128 + wr * 64 + m * 16 + fr;
#pragma unroll
                    for (int bj = 0; bj < 2; ++bj) { const int col = (pn - 3) * 256 + 64 * wc + 32 * bj + 8 * fq; const f32x4 a0 = acc[ai][bj][m][0], a1 = acc[ai][bj][m][1];
                        u32x4 pw; pw.x = pk2(a0[0], a0[1]); pw.y = pk2(a0[2], a0[3]); pw.z = pk2(a1[0], a1[1]); pw.w = pk2(a1[2], a1[3]); stg16(U + (size_t)row * 512 + col, pw); } }
            return;
        }
        if (pn == 2 && wc >= 2) {
            const int kvh = wc - 2;
#pragma unroll
            for (int ai = 0; ai < 2; ++ai)
#pragma unroll
                for (int m = 0; m < 4; ++m) { const int row = u.pm * 256 + ai * 128 + wr * 64 + m * 16 + fr;
                    if (!lat) { const int b = row >> 8, t = row & 255; float* ov = outv + (((size_t)(b * 2 + layer) * 256 + t) * 2 + kvh) * 64; bf16_t* vt = Vctx + ((size_t)(b * 2 + kvh) * 64) * 256 + t;
#pragma unroll
                        for (int bj = 0; bj < 2; ++bj)
#pragma unroll
                            for (int n = 0; n < 2; ++n) { const int d = 32 * bj + 8 * fq + 4 * n; const f32x4 a = acc[ai][bj][m][n]; stg16f(ov + d, a);
                                const unsigned p0 = pk2(a[0], a[1]), p1 = pk2(a[2], a[3]);
                                vt[(size_t)(d + 0) * 256] = (bf16_t)(p0 & 0xffffu); vt[(size_t)(d + 1) * 256] = (bf16_t)(p0 >> 16); vt[(size_t)(d + 2) * 256] = (bf16_t)(p1 & 0xffffu); vt[(size_t)(d + 3) * 256] = (bf16_t)(p1 >> 16); } }
                    else { const int rl = row - NCTX, b = rl >> 11, t = rl & 2047; bf16_t* vt = Vlat + ((size_t)(b * 2 + kvh) * 64) * 2560 + 512 + t;
#pragma unroll
                        for (int bj = 0; bj < 2; ++bj)
#pragma unroll
                            for (int n = 0; n < 2; ++n) { const int d = 32 * bj + 8 * fq + 4 * n; const f32x4 a = acc[ai][bj][m][n];
                                const unsigned p0 = pk2(a[0], a[1]), p1 = pk2(a[2], a[3]);
                                vt[(size_t)(d + 0) * 2560] = (bf16_t)(p0 & 0xffffu); vt[(size_t)(d + 1) * 2560] = (bf16_t)(p0 >> 16); vt[(size_t)(d + 2) * 2560] = (bf16_t)(p1 & 0xffffu); vt[(size_t)(d + 3) * 2560] = (bf16_t)(p1 >> 16); } } }
            return;
        }
        const bool isq = pn < 2; const float* nw = isq ? qn : kn;
        f32x4 w4[2][2];
#pragma unroll
        for (int bj = 0; bj < 2; ++bj)
#pragma unroll
            for (int n = 0; n < 2; ++n) w4[bj][n] = ldg16f(nw + 32 * bj + 8 * fq + 4 * n);
        const float qscale = isq ? 0.125f * 1.4426950408889634f : 1.0f;
        const int T0r = ((u.pm * 256 - NCTX) & 2047) >> 6;
#pragma unroll
        for (int ai = 0; ai < 2; ++ai)
#pragma unroll
            for (int m = 0; m < 4; ++m) { const int row = u.pm * 256 + ai * 128 + wr * 64 + m * 16 + fr;
                float ss = 0.f;
#pragma unroll
                for (int bj = 0; bj < 2; ++bj)
#pragma unroll
                    for (int n = 0; n < 2; ++n) { const f32x4 a = acc[ai][bj][m][n]; ss += a[0] * a[0] + a[1] * a[1] + a[2] * a[2] + a[3] * a[3]; }
                ss += shx(ss, 16, fq * 16 + fr); ss += shx(ss, 32, fq * 16 + fr);
                const float rstd = rsqrtf(ss * (1.0f / 64.0f) + 1e-6f);
                f32x4 v[2][2];
#pragma unroll
                for (int bj = 0; bj < 2; ++bj)
#pragma unroll
                    for (int n = 0; n < 2; ++n) v[bj][n] = acc[ai][bj][m][n] * rstd * w4[bj][n];
                if (!lat) {
                    const int b = row >> 8, t = row & 255;
                    if (isq) { bf16_t* qp = Q + (size_t)row * 512 + (pn * 4 + wc) * 64;
#pragma unroll
                        for (int bj = 0; bj < 2; ++bj) { const f32x4 a0 = v[bj][0] * qscale, a1 = v[bj][1] * qscale;
                            u32x4 pw; pw.x = pk2(a0[0], a0[1]); pw.y = pk2(a0[2], a0[3]); pw.z = pk2(a1[0], a1[1]); pw.w = pk2(a1[2], a1[3]); stg16(qp + 32 * bj + 8 * fq, pw); } }
                    else { const int kvh = wc; float* ok = outk + (((size_t)(b * 2 + layer) * 256 + t) * 2 + kvh) * 64; bf16_t* kp = Kctx + ((size_t)(b * 2 + kvh) * 256 + t) * 64;
#pragma unroll
                        for (int bj = 0; bj < 2; ++bj) { const int d = 32 * bj + 8 * fq; const f32x4 a0 = v[bj][0], a1 = v[bj][1]; stg16f(ok + d, a0); stg16f(ok + d + 4, a1);
                            u32x4 pw; pw.x = pk2(a0[0], a0[1]); pw.y = pk2(a0[2], a0[3]); pw.z = pk2(a1[0], a1[1]); pw.w = pk2(a1[2], a1[3]); stg16(kp + d, pw); } }
                } else {
                    const int rl = row - NCTX, b = rl >> 11, t = rl & 2047;
                    bf16_t* dst = isq ? Q + (size_t)row * 512 + (pn * 4 + wc) * 64 : Klat + ((size_t)(b * 2 + wc) * 2560 + 512 + t) * 64;
                    const int grow = T0r + 2 * ai + wr, gcol = 16 * m + fr;
#pragma unroll
                    for (int bj = 0; bj < 2; ++bj) { u32x4 pw;
#pragma unroll
                        for (int n = 0; n < 2; ++n) { const int o = (bj == 0 ? grow * 16 : 1024 + gcol * 16) + 4 * fq + 2 * n;
                            const f32x2 c2 = *(const PG8_LAS f32x2*)(lr + o), s2 = *(const PG8_LAS f32x2*)(lr + o + (bj == 0 ? 512 : 1024)); const f32x4 a = v[bj][n];
                            const float o0 = (a[0] * c2[0] - a[1] * s2[0]) * qscale, o1 = (a[0] * s2[0] + a[1] * c2[0]) * qscale, o2 = (a[2] * c2[1] - a[3] * s2[1]) * qscale, o3 = (a[2] * s2[1] + a[3] * c2[1]) * qscale;
                            if (n == 0) { pw.x = pk2(o0, o1); pw.y = pk2(o2, o3); } else { pw.z = pk2(o0, o1); pw.w = pk2(o2, o3); } }
                        stg16(dst + 32 * bj + 8 * fq, pw); }
                }
            }
    }
};

struct EpiGlu {
    static constexpr bool PERM = true, AFTER_DRAIN = false;
    const bf16_t* G; const float* bias; bf16_t* MIX;
    DI void operator()(const f32x4 (&acc)[2][2][4][2], const pg8::Unit& u, int wr, int wc, int fr, int fq) const {
        asm volatile("" : "+v"(fr), "+v"(fq));
        const int cb = u.pn * 256 + 32 * wc + 8 * fq, rb = u.pm * 256 + wr * 64 + fr;
        f32x4 bv[2][2]; u32x4 gw[2][4][2];
#pragma unroll
        for (int bj = 0; bj < 2; ++bj) { bv[bj][0] = ldg16f(bias + cb + 128 * bj); bv[bj][1] = ldg16f(bias + cb + 128 * bj + 4); }
#pragma unroll
        for (int ai = 0; ai < 2; ++ai)
#pragma unroll
            for (int m = 0; m < 4; ++m)
#pragma unroll
                for (int bj = 0; bj < 2; ++bj) gw[ai][m][bj] = ldg16(G + (size_t)(rb + 128 * ai + 16 * m) * 512 + cb + 128 * bj);
#pragma unroll
        for (int ai = 0; ai < 2; ++ai)
#pragma unroll
            for (int m = 0; m < 4; ++m)
#pragma unroll
                for (int bj = 0; bj < 2; ++bj) { const u32x4 g4 = gw[ai][m][bj];
                    const f32x4 v0 = acc[ai][bj][m][0] + bv[bj][0], v1 = acc[ai][bj][m][1] + bv[bj][1];
                    u32x4 o;
                    o.x = pk2(bflo(g4.x) * sigmoidf_(v0[0]), bfhi(g4.x) * sigmoidf_(v0[1])); o.y = pk2(bflo(g4.y) * sigmoidf_(v0[2]), bfhi(g4.y) * sigmoidf_(v0[3]));
                    o.z = pk2(bflo(g4.z) * sigmoidf_(v1[0]), bfhi(g4.z) * sigmoidf_(v1[1])); o.w = pk2(bflo(g4.w) * sigmoidf_(v1[2]), bfhi(g4.w) * sigmoidf_(v1[3]));
                    stg16(MIX + (size_t)(rb + 128 * ai + 16 * m) * 1024 + 512 + cb + 128 * bj, o); }
    }
};

struct EpiRes {
    static constexpr bool PERM = true, AFTER_DRAIN = false;
    const float* xa; const float* xb; const bf16_t* xh; bf16_t* Xo; const float* gate;
    DI void operator()(const f32x4 (&acc)[2][2][4][2], const pg8::Unit& u, int wr, int wc, int fr, int fq) const {
        asm volatile("" : "+v"(fr), "+v"(fq));
        const int j = u.pm < 32 ? 0 : 1 + ((u.pm - 32) >> 3);
        const int cb = u.pn * 256 + 32 * wc + 8 * fq, rb = u.pm * 256 + wr * 64 + fr;
        const float* gt = gate + j * 6144 + cb;
        f32x4 gv[2][2];
#pragma unroll
        for (int bj = 0; bj < 2; ++bj)
#pragma unroll
            for (int n = 0; n < 2; ++n) gv[bj][n] = ldg16f(gt + 128 * bj + 4 * n);
        if (xh) {
#pragma unroll
            for (int ai = 0; ai < 2; ++ai) {
                u32x4 xr[4][2];
#pragma unroll
                for (int m = 0; m < 4; ++m)
#pragma unroll
                    for (int bj = 0; bj < 2; ++bj) xr[m][bj] = ldg16(xh + (size_t)(rb + 128 * ai + 16 * m) * 1024 + cb + 128 * bj);
#pragma unroll
                for (int m = 0; m < 4; ++m)
#pragma unroll
                    for (int bj = 0; bj < 2; ++bj) { const u32x4 t = xr[m][bj];
                        const f32x4 x0 = (f32x4){bflo(t.x), bfhi(t.x), bflo(t.y), bfhi(t.y)} + gv[bj][0] * acc[ai][bj][m][0];
                        const f32x4 x1 = (f32x4){bflo(t.z), bfhi(t.z), bflo(t.w), bfhi(t.w)} + gv[bj][1] * acc[ai][bj][m][1];
                        u32x4 pw; pw.x = pk2(x0[0], x0[1]); pw.y = pk2(x0[2], x0[3]); pw.z = pk2(x1[0], x1[1]); pw.w = pk2(x1[2], x1[3]);
                        stg16(Xo + (size_t)(rb + 128 * ai + 16 * m) * 1024 + cb + 128 * bj, pw); }
            }
        } else {
            const float* xs = u.pm < 32 ? xa + (size_t)rb * 1024 : xb + (size_t)(rb - NCTX) * 1024;
#pragma unroll
            for (int ai = 0; ai < 2; ++ai) {
                f32x4 xr[4][2][2];
#pragma unroll
                for (int m = 0; m < 4; ++m)
#pragma unroll
                    for (int bj = 0; bj < 2; ++bj)
#pragma unroll
                        for (int n = 0; n < 2; ++n) xr[m][bj][n] = ldg16f(xs + (size_t)(128 * ai + 16 * m) * 1024 + cb + 128 * bj + 4 * n);
#pragma unroll
                for (int m = 0; m < 4; ++m)
#pragma unroll
                    for (int bj = 0; bj < 2; ++bj) { const f32x4 x0 = xr[m][bj][0] + gv[bj][0] * acc[ai][bj][m][0], x1 = xr[m][bj][1] + gv[bj][1] * acc[ai][bj][m][1];
                        u32x4 pw; pw.x = pk2(x0[0], x0[1]); pw.y = pk2(x0[2], x0[3]); pw.z = pk2(x1[0], x1[1]); pw.w = pk2(x1[2], x1[3]);
                        stg16(Xo + (size_t)(rb + 128 * ai + 16 * m) * 1024 + cb + 128 * bj, pw); }
            }
        }
    }
};

struct EpiFfn1 {
    static constexpr bool PERM = true, AFTER_DRAIN = false;
    bf16_t* ACT;
    DI void operator()(const f32x4 (&acc)[2][2][4][2], const pg8::Unit& u, int wr, int wc, int fr, int fq) const {
        asm volatile("" : "+v"(fr), "+v"(fq));
#pragma unroll
        for (int ai = 0; ai < 2; ++ai)
#pragma unroll
            for (int m = 0; m < 4; ++m) { const int row = u.pm * 256 + ai * 128 + wr * 64 + m * 16 + fr; const int a0 = u.pn * 128 + 32 * wc + 8 * fq;
                const f32x4 g0 = acc[ai][0][m][0], g1 = acc[ai][0][m][1], u0 = acc[ai][1][m][0], u1 = acc[ai][1][m][1];
                u32x4 o;
                o.x = pk2(g0[0] * sigmoidf_(g0[0]) * u0[0], g0[1] * sigmoidf_(g0[1]) * u0[1]); o.y = pk2(g0[2] * sigmoidf_(g0[2]) * u0[2], g0[3] * sigmoidf_(g0[3]) * u0[3]);
                o.z = pk2(g1[0] * sigmoidf_(g1[0]) * u1[0], g1[1] * sigmoidf_(g1[1]) * u1[1]); o.w = pk2(g1[2] * sigmoidf_(g1[2]) * u1[2], g1[3] * sigmoidf_(g1[3]) * u1[3]);
                *(u32x4*)(ACT + (size_t)row * 2816 + a0) = o; }
    }
};

struct ListOrder {
    int count, G, c, mode;
    DI bool next(int i, pg8::Unit& u) const {
        const int L0 = i * G + c; if (L0 >= count) return false;
        const int L = (L0 & 7) * (count >> 3) + (L0 >> 3);
        if (mode == 0) { const int pm = L >> 2, vn = L & 3; if (vn < 3) { u.pm = pm; u.pn = vn; } else { u.pm = 32 + (pm >> 1); u.pn = 3 + (pm & 1); } }
        else { u.pm = L >> 1; u.pn = 3 + (L & 1); }
        return true;
    }
    DI void a_ready(const pg8::Unit&) const {}
    DI void done(const pg8::Unit&) const {}
};

template <class Epi> DI void run_gemm(unsigned char* shm, const bf16_t* A, const bf16_t* Bt, int N, int K, const Epi& E, int wv) {
    pg8::Gemm g; g.A = A; g.Bt = Bt; g.M = NTOK; g.N = N; g.K = K;
    pg8::StaticOrder S; S.init(NTOK, N, (int)gridDim.x, (int)blockIdx.x);
    pg8::gemm_phase<Epi, pg8::StaticOrder, false>((PG8_LAS unsigned char*)shm, g, S, E, nullptr, wv);
}

DI void attn_item(const bf16_t* __restrict__ Q, const bf16_t* __restrict__ Kp, const bf16_t* __restrict__ Vp, int vld, int nkeys, int qtok0, int kvh, bf16_t* __restrict__ MIX, unsigned char* lds, int wv) {
    const int tid = ltid(wv), w = tid >> 6, lane = tid & 63, c = lane & 31, hh = lane >> 5;
    const int hq = kvh * 4 + (w & 3), qtok = qtok0 + 32 * (w >> 2) + c;
    bf16x8 qf[4];
#pragma unroll
    for (int s = 0; s < 4; ++s) qf[s] = __builtin_bit_cast(bf16x8, ldg16(Q + (size_t)qtok * 512 + hq * 64 + 16 * s + 8 * hh));
    unsigned char* Kb = lds; unsigned char* Vb = lds + 2 * 9216;
    const int srow = tid >> 3, sseg = tid & 7;
    const bf16_t* kg = Kp + (size_t)srow * 64 + sseg * 8;
    const bf16_t* vg = Vp + (size_t)srow * vld + sseg * 8;
    u32x4 kr = ldg16(kg), vr = ldg16(vg);
    *(u32x4*)(Kb + srow * 144 + sseg * 16) = kr;
    { u32x2* d = (u32x2*)(Vb + srow * 136 + sseg * 16); u32x2 a; a.x = vr.x; a.y = vr.y; u32x2 b; b.x = vr.z; b.y = vr.w; d[0] = a; d[1] = b; }
    __syncthreads();
    f32x16 ot[2];
#pragma unroll
    for (int i = 0; i < 16; ++i) { ot[0][i] = 0.f; ot[1][i] = 0.f; }
    float mrun = -1e30f, lsum = 0.f;
    const int nt = nkeys >> 6;
    for (int it = 0; it < nt; ++it) {
        const int cur = it & 1;
        if (it + 1 < nt) { kr = ldg16(kg + (size_t)(it + 1) * 4096); vr = ldg16(vg + (it + 1) * 64); }
        const unsigned char* kb = Kb + cur * 9216; const unsigned char* vb = Vb + cur * 8704;
        f32x16 st[2]; bf16x8 kf[2][4];
#pragma unroll
        for (int kt = 0; kt < 2; ++kt)
#pragma unroll
            for (int s = 0; s < 4; ++s) kf[kt][s] = *(const PG8_LAS bf16x8*)(const PG8_LAS unsigned char*)(kb + (32 * kt + c) * 144 + (16 * s + 8 * hh) * 2);
#pragma unroll
        for (int kt = 0; kt < 2; ++kt) {
#pragma unroll
            for (int i = 0; i < 16; ++i) st[kt][i] = 0.f;
#pragma unroll
            for (int s = 0; s < 4; ++s) st[kt] = mfma32p(kf[kt][s], qf[s], st[kt]); }
        float mx = fmaxf(fmaxf(st[0][0], st[0][1]), st[0][2]);
#pragma unroll
        for (int i = 3; i < 15; i += 2) mx = fmaxf(fmaxf(mx, st[0][i]), st[0][i + 1]);
        mx = fmaxf(mx, st[0][15]);
#pragma unroll
        for (int i = 0; i < 16; i += 2) mx = fmaxf(fmaxf(mx, st[1][i]), st[1][i + 1]);
        mx = fmaxf(mx, shx(mx, 32, lane));
        const float mnew = fmaxf(mrun, mx), alpha = __builtin_amdgcn_exp2f(mrun - mnew); mrun = mnew;
        f32x2 ps2 = (f32x2){0.f, 0.f}; const f32x2 mn2 = (f32x2){mnew, mnew};
#pragma unroll
        for (int kt = 0; kt < 2; ++kt)
#pragma unroll
            for (int i = 0; i < 16; i += 2) { f32x2 d = (f32x2){st[kt][i], st[kt][i + 1]} - mn2; f32x2 pp; pp.x = __builtin_amdgcn_exp2f(d.x); pp.y = __builtin_amdgcn_exp2f(d.y); st[kt][i] = pp.x; st[kt][i + 1] = pp.y; ps2 += pp; }
        const float ps = ps2.x + ps2.y;
        lsum = lsum * alpha + ps;
        if (__builtin_amdgcn_ballot_w64(alpha != 1.0f) != 0ull) {
#pragma unroll
            for (int i = 0; i < 16; ++i) { ot[0][i] *= alpha; ot[1][i] *= alpha; } }
        s16x4 vlo[2][2][2], vhi[2][2][2];
#pragma unroll
        for (int kt = 0; kt < 2; ++kt)
#pragma unroll
            for (int sp = 0; sp < 2; ++sp)
#pragma unroll
                for (int dt = 0; dt < 2; ++dt) { const PG8_LAS unsigned char* vrow = (const PG8_LAS unsigned char*)(vb + (32 * dt + c) * 136 + (32 * kt + 16 * sp + 4 * hh) * 2);
                    vlo[kt][sp][dt] = *(const PG8_LAS s16x4*)vrow; vhi[kt][sp][dt] = *(const PG8_LAS s16x4*)(vrow + 16); }
#pragma unroll
        for (int kt = 0; kt < 2; ++kt)
#pragma unroll
            for (int sp = 0; sp < 2; ++sp) {
                const bf16x8 pk = pack8(st[kt][8 * sp], st[kt][8 * sp + 1], st[kt][8 * sp + 2], st[kt][8 * sp + 3], st[kt][8 * sp + 4], st[kt][8 * sp + 5], st[kt][8 * sp + 6], st[kt][8 * sp + 7]);
#pragma unroll
                for (int dt = 0; dt < 2; ++dt) { const bf16x8 va = __builtin_shufflevector(vlo[kt][sp][dt], vhi[kt][sp][dt], 0, 1, 2, 3, 4, 5, 6, 7); ot[dt] = mfma32p(va, pk, ot[dt]); } }
        if (it + 1 < nt) { const int nx = cur ^ 1;
            *(u32x4*)(Kb + nx * 9216 + srow * 144 + sseg * 16) = kr;
            u32x2* d = (u32x2*)(Vb + nx * 8704 + srow * 136 + sseg * 16); u32x2 a; a.x = vr.x; a.y = vr.y; u32x2 b; b.x = vr.z; b.y = vr.w; d[0] = a; d[1] = b; }
        __syncthreads();
    }
    const float ltot = lsum + shx(lsum, 32, lane); const float inv = 1.0f / ltot;
    bf16_t* op = MIX + (size_t)qtok * 1024 + hq * 64;
#pragma unroll
    for (int dt = 0; dt < 2; ++dt)
#pragma unroll
        for (int g4 = 0; g4 < 4; ++g4) { u32x2 pw; pw.x = pk2(ot[dt][4 * g4] * inv, ot[dt][4 * g4 + 1] * inv); pw.y = pk2(ot[dt][4 * g4 + 2] * inv, ot[dt][4 * g4 + 3] * inv);
            stg8(op + 32 * dt + 8 * g4 + 4 * hh, pw); }
}

template <int DIR, bool FULL>
DI void ssm_pass(int layer, int pr, int g, const bf16_t* __restrict__ U, const bf16x8* __restrict__ Bm, const bf16x8* __restrict__ Cm, const float* __restrict__ lam,
                 const float* __restrict__ state_in, const float* sseg_r, float* sseg_w, float* YF, bf16_t* __restrict__ G, const float* __restrict__ dskip,
                 float* __restrict__ out_state, unsigned char* hl, int wv) {
    const int lane = ltid(wv) & 63, c = lane & 31, hh = lane >> 5, fr = lane & 15, kq = lane >> 4;
    const int ldg = (layer * 2 + DIR) * 32 + g;
    bf16x8 bm[4], cm[4];
#pragma unroll
    for (int i = 0; i < 4; ++i) { bm[i] = Bm[(ldg * 4 + i) * 64 + lane]; if (FULL) cm[i] = Cm[(ldg * 4 + i) * 64 + lane]; }
    const float l0r = lam[(ldg * 64 + c) * 2], l0i = lam[(ldg * 64 + c) * 2 + 1], l1r = lam[(ldg * 64 + 32 + c) * 2], l1i = lam[(ldg * 64 + 32 + c) * 2 + 1];
    const int s = 2 * pr + hh;
    float h0r = 0.f, h0i = 0.f, h1r = 0.f, h1i = 0.f;
    if (FULL && pr >= 16) {
        const int sl = s - 32, b = sl >> 3, seg = sl & 7;
        float a0r = l0r, a0i = l0i, a1r = l1r, a1i = l1i;
#pragma unroll
        for (int i = 0; i < 8; ++i) { const float t0 = a0r * a0r - a0i * a0i, t1 = 2.f * a0r * a0i; a0r = t0; a0i = t1; const float t2 = a1r * a1r - a1i * a1i, t3 = 2.f * a1r * a1i; a1r = t2; a1i = t3; }
        const float* si = state_in + ((((size_t)(b * 2 + layer) * 2 + DIR) * 2) * 32 + g) * 64;
        h0r = si[c]; h0i = si[2048 + c]; h1r = si[32 + c]; h1i = si[2048 + 32 + c];
        const int n = DIR == 0 ? seg : 7 - seg;
        for (int jj = 0; jj < n; ++jj) { const int j = DIR == 0 ? jj : 7 - jj;
            const float* sp = sseg_r + ((((size_t)(b * 8 + j) * 2 + DIR) * 32 + g) * 64) * 2;
            const float s0r = sp[c * 2], s0i = sp[c * 2 + 1], s1r = sp[(32 + c) * 2], s1i = sp[(32 + c) * 2 + 1];
            const float n0r = a0r * h0r - a0i * h0i + s0r, n0i = a0r * h0i + a0i * h0r + s0i; h0r = n0r; h0i = n0i;
            const float n1r = a1r * h1r - a1i * h1i + s1r, n1i = a1r * h1i + a1i * h1r + s1i; h1r = n1r; h1i = n1i; }
    }
    const int seq_r = (c >> 2) & 1, q_r = (c & 3) + 4 * (c >> 3);
    const bf16_t* ua_ptr = U + ((size_t)((2 * pr + seq_r) * 256 + q_r)) * 512 + g * 16 + 8 * hh;
    f32x16 zero16;
#pragma unroll
    for (int i = 0; i < 16; ++i) zero16[i] = 0.f;
    auto ldu = [&](int ch) -> bf16x8 { return __builtin_bit_cast(bf16x8, ldg16(ua_ptr + (size_t)(DIR ? 240 - 16 * ch : 16 * ch) * 512)); };
    auto body = [&](const bf16x8 ua, int ch) {
        const int cb = DIR ? 240 - 16 * ch : 16 * ch;
        f32x16 x[4];
#pragma unroll
        for (int i = 0; i < 4; ++i) x[i] = mfma32(ua, bm[i], zero16);
#pragma unroll
        for (int i = 0; i < 16; ++i) { const int reg = DIR ? 15 - i : i;
            const float n0r = __builtin_fmaf(l0r, h0r, __builtin_fmaf(-l0i, h0i, x[0][reg])), n0i = __builtin_fmaf(l0r, h0i, __builtin_fmaf(l0i, h0r, x[1][reg])); h0r = n0r; h0i = n0i;
            const float n1r = __builtin_fmaf(l1r, h1r, __builtin_fmaf(-l1i, h1i, x[2][reg])), n1i = __builtin_fmaf(l1r, h1i, __builtin_fmaf(l1i, h1r, x[3][reg])); h1r = n1r; h1i = n1i;
            if (FULL) { unsigned* hrow = (unsigned*)(hl + (hh * 16 + reg) * 272); hrow[c] = pk2(h0r, h0i); hrow[32 + c] = pk2(h1r, h1i); } }
        if (FULL) {
#pragma unroll
            for (int sq = 0; sq < 2; ++sq) { f32x4 y = (f32x4){0.f, 0.f, 0.f, 0.f};
#pragma unroll
                for (int ks = 0; ks < 4; ++ks) { const bf16x8 af = *(const bf16x8*)(hl + (sq * 16 + fr) * 272 + (32 * ks + 8 * kq) * 2); y = mfma16(cm[ks], af, y); }
                { u32x2 pw; pw.x = pk2(y[0], y[1]); pw.y = pk2(y[2], y[3]); stg8((bf16_t*)YF + ((size_t)((2 * pr + sq) * 256 + cb + fr)) * 512 + g * 16 + 4 * kq, pw); } }
        }
    };
    bf16x8 u0 = ldu(0), u1 = ldu(1), u2 = ldu(2), u3 = ldu(3);
#pragma unroll 1
    for (int c4 = 0; c4 < 16; c4 += 4) {
        const bool more = c4 + 4 < 16;
        body(u0, c4);     if (more) u0 = ldu(c4 + 4);
        body(u1, c4 + 1); if (more) u1 = ldu(c4 + 5);
        body(u2, c4 + 2); if (more) u2 = ldu(c4 + 6);
        body(u3, c4 + 3); if (more) u3 = ldu(c4 + 7);
    }
    if (FULL) { if (pr < 16) { float* os = out_state + ((((size_t)(s * 2 + layer) * 2 + DIR) * 2) * 32 + g) * 64; os[c] = h0r; os[2048 + c] = h0i; os[32 + c] = h1r; os[2048 + 32 + c] = h1i; } }
    else { float* sw = sseg_w + ((((size_t)(s - 32) * 2 + DIR) * 32 + g) * 64) * 2; sw[c * 2] = h0r; sw[c * 2 + 1] = h0i; sw[(32 + c) * 2] = h1r; sw[(32 + c) * 2 + 1] = h1i; }
}

#define XB_TMO      128
#define XB_XCNT(j)  (256  + 64 * (j))
#define XB_XSUB(j)  (1280 + 64 * (j))
#define XB_XGEN(j)  (2304 + 64 * (j))
#define XB_TOP      3328
#define XB_TOPGEN   3392
#define XCD_BAR_WORDS 3456
#define XB_SPIN_CAP (1u << 18)
#define LAS __attribute__((address_space(3)))

__device__ __forceinline__ unsigned xb_ld(unsigned* p)              { return __hip_atomic_load(p, __ATOMIC_RELAXED, __HIP_MEMORY_SCOPE_AGENT); }
__device__ __forceinline__ unsigned xb_add(unsigned* p, unsigned v) { return __hip_atomic_fetch_add(p, v, __ATOMIC_RELAXED, __HIP_MEMORY_SCOPE_AGENT); }
__device__ __forceinline__ unsigned xb_xcc_id() { return (unsigned)__builtin_amdgcn_s_getreg((3 << 11) | 20) & 0xFu; }
#define XB_SPIN(cond, bar) do { unsigned _sp = 0; while (cond) { __builtin_amdgcn_s_sleep(1); \
    if ((++_sp & 255u) == 0u) { if (xb_ld(&(bar)[XB_TMO])) break; if (_sp > XB_SPIN_CAP) { atomicAdd(&(bar)[XB_TMO], 1u); break; } } } } while (0)

struct XcdBarrier {
    unsigned* bar; unsigned x;
    volatile LAS unsigned* st;
};

__device__ __forceinline__ XcdBarrier xcd_barrier_post(unsigned* bar, volatile LAS unsigned* st) {
    XcdBarrier b; b.bar = bar; b.x = xb_xcc_id(); b.st = st;
    if (threadIdx.x == 0) (void)xb_add(&bar[XB_XCNT(b.x)], 1u);
    return b;
}
__device__ __forceinline__ void xcd_barrier_complete(unsigned* bar, unsigned x, unsigned& nloc, unsigned& nx) {
    const unsigned G = gridDim.x * gridDim.y * gridDim.z;
    unsigned sum, cnt, mine, sp = 0u;
    for (;;) {
        sum = 0u; cnt = 0u; mine = 0u;
#pragma unroll
        for (unsigned j = 0; j < 16; ++j) { const unsigned c = xb_ld(&bar[XB_XCNT(j)]); sum += c; cnt += (c > 0u) ? 1u : 0u; mine = (j == x) ? c : mine; }
        if (sum == G) break;
        __builtin_amdgcn_s_sleep(1);
        if ((++sp & 255u) == 0u) { if (xb_ld(&bar[XB_TMO])) break; if (sp > XB_SPIN_CAP) { atomicAdd(&bar[XB_TMO], 1u); break; } }
    }
    nloc = mine > 0u ? mine : 1u; nx = cnt > 0u ? cnt : 1u;
}

__device__ __forceinline__ void xcd_barrier(const XcdBarrier& b) {
    asm volatile("s_waitcnt vmcnt(0)" ::: "memory");
    __syncthreads();
    if (threadIdx.x == 0) {
        unsigned* bar = b.bar;
        __builtin_amdgcn_s_waitcnt(0);
        unsigned nloc = b.st[0], nx = b.st[1];
        if (nloc == 0u) { xcd_barrier_complete(bar, b.x, nloc, nx); b.st[0] = nloc; b.st[1] = nx; }
        const unsigned old = xb_add(&bar[XB_XSUB(b.x)], 1u);
        const unsigned gen = old / nloc;
        if (old + 1u == (gen + 1u) * nloc) {
            __builtin_amdgcn_fence(__ATOMIC_RELEASE, "agent");
            asm volatile("s_waitcnt vmcnt(0)" ::: "memory");
            const unsigned og = xb_add(&bar[XB_TOP], 1u);
            const unsigned tg = og / nx;
            if (og + 1u == (tg + 1u) * nx) xb_add(&bar[XB_TOPGEN], 1u);
            else XB_SPIN(xb_ld(&bar[XB_TOPGEN]) == tg, bar);
            __builtin_amdgcn_fence(__ATOMIC_ACQUIRE, "agent");
            xb_add(&bar[XB_XGEN(b.x)], 1u);
            asm volatile("s_waitcnt vmcnt(0)" ::: "memory");
        } else {
            XB_SPIN(xb_ld(&bar[XB_XGEN(b.x)]) == gen, bar);
            __builtin_amdgcn_fence(__ATOMIC_ACQUIRE, "agent");
            asm volatile("s_waitcnt vmcnt(0)" ::: "memory");
        }
    }
    __syncthreads();
}


typedef const __attribute__((address_space(4))) Params* KParamsPtr;
DI KParamsPtr kparams() { KParamsPtr p = (KParamsPtr)__builtin_amdgcn_kernarg_segment_ptr(); asm volatile("" : "+s"(p)); return p; }
#define PKP (kparams())
__global__ __launch_bounds__(512, 2) void mega_fwd(Params P) {
    extern __shared__ __attribute__((aligned(16))) unsigned char shm[];
    cg::grid_group grid = cg::this_grid();
#define WSP_ (opaque_ptr(PKP->ws))
#define XP_ ((float*)opaque_ptr((unsigned char*)PKP->out))
#define MODS_ ((const float*)(WSP_ + WS_MODS))
#define HB_ ((bf16_t*)(WSP_ + WS_H))
#define YFP_ ((float*)(WSP_ + WS_H))
#define QB_ ((bf16_t*)(WSP_ + WS_Q))
#define UB_ ((bf16_t*)(WSP_ + WS_U))
#define MIXB_ ((bf16_t*)(WSP_ + WS_MIX))
#define GB_ ((bf16_t*)(WSP_ + WS_G))
#define ACTB_ ((bf16_t*)(WSP_ + WS_ACT))
#define KCTX_ ((bf16_t*)(WSP_ + WS_KCTX))
#define VCTX_ ((bf16_t*)(WSP_ + WS_VCTX))
    const int w = __builtin_amdgcn_readfirstlane(threadIdx.x >> 6);
    if (PKP->ws == nullptr) grid.sync();
    if (threadIdx.x == 0) { ((volatile LAS unsigned*)(shm + 131072))[0] = 0u; ((volatile LAS unsigned*)(shm + 131072))[1] = 0u; }
    __syncthreads();
    (void)xcd_barrier_post((unsigned*)(WSP_ + WS_BAR), (volatile LAS unsigned*)(shm + 131072));
#define GSYNC() do { XcdBarrier b_; b_.bar = (unsigned*)(opaque_ptr(PKP->ws) + WS_BAR); b_.x = xb_xcc_id(); b_.st = (volatile LAS unsigned*)(shm + 131072); xcd_barrier(b_); } while (0)

    { Params Pl; for (int i = 0; i < 28; ++i) Pl.in[i] = PKP->in[i]; Pl.out = PKP->out; Pl.ws = PKP->ws; phase0(Pl, shm, w); }
    GSYNC();
    { const int tid = ltid(w); const float* rcg = (const float*)(WSP_ + WS_ROPEC); const float* rsg = (const float*)(WSP_ + WS_ROPES); float* lrw = (float*)(shm + LDS_ROPE);
      { const int e = tid, r = e >> 4, i = e & 15; lrw[e] = rcg[(64 * r) * 32 + i]; lrw[512 + e] = rsg[(64 * r) * 32 + i]; }
      for (int e = tid; e < 1024; e += 512) { const int cidx = e >> 4, i = e & 15; lrw[1024 + e] = rcg[cidx * 32 + 16 + i]; lrw[2048 + e] = rsg[cidx * 32 + 16 + i]; }
      __syncthreads(); }
#pragma unroll 1
    for (int l = 0; l < 2; ++l) {
#define MODSL_ (MODS_ + l * 5 * 6144)
#define XA_ (PKP->in[0])
#define XH_ ((bf16_t*)(WSP_ + WS_XB))
#define XB_ (PKP->in[1])
#define KLAT_ ((bf16_t*)(WSP_ + WS_KLAT + l * SZ_KLAT))
#define VLAT_ ((bf16_t*)(WSP_ + WS_VLAT + l * SZ_KLAT))
        if (l == 0) {
            const int tid = ltid(w); const float* part = (const float*)(WSP_ + WS_MODP); const float* bm_ = PKP->in[8]; float* mw = (float*)(WSP_ + WS_MODS); float* ldsf = (float*)opaque_ptr(shm);
            for (int idx = blockIdx.x * 512 + tid; idx < 61440; idx += gridDim.x * 512) { const int ll = idx / 30720, n = idx % 6144;
                mw[idx] = part[idx] + part[61440 + idx] + part[2 * 61440 + idx] + part[3 * 61440 + idx] + bm_[ll * 6144 + n]; }
            for (int e = tid; e < 10240; e += 512) { const int j = e >> 11, r = e & 2047; const int idx = j * 6144 + r;
                ldsf[e] = part[idx] + part[61440 + idx] + part[2 * 61440 + idx] + part[3 * 61440 + idx] + bm_[r]; }
            __syncthreads();
            for (int rep = 0; rep < REP_NORM; ++rep) norm_phase(XA_, XB_, nullptr, PKP->in[9], ldsf, 2048, 0, 1024, HB_, w);
        } else
        for (int rep = 0; rep < REP_NORM; ++rep) norm_phase(XA_, XB_, XH_, PKP->in[9] + l * 1024, MODSL_, 6144, 0, 1024, HB_, w);
        GSYNC();
        { EpiIn E; E.layer = l; E.qn = PKP->in[12] + l * 64; E.kn = PKP->in[13] + l * 64; E.lr = (const PG8_LAS float*)(shm + LDS_ROPE);
          E.Q = QB_; E.U = UB_; E.Kctx = KCTX_; E.Vctx = VCTX_; E.Klat = KLAT_; E.Vlat = VLAT_; E.outk = PKP->out + OUT_K; E.outv = PKP->out + OUT_V;
          { pg8::Gemm g; g.A = HB_; g.Bt = (const bf16_t*)(WSP_ + WS_WIN + l * SZ_WIN); g.M = NTOK; g.N = 1280; g.K = 1024;
            ListOrder S; S.count = 256; S.G = (int)gridDim.x; S.c = (int)blockIdx.x; S.mode = 0;
            pg8::gemm_phase<EpiIn, ListOrder, false>((PG8_LAS unsigned char*)shm, g, S, E, nullptr, w); }
          GSYNC();
          { pg8::Gemm g; g.A = HB_; g.Bt = (const bf16_t*)(WSP_ + WS_WIN + l * SZ_WIN); g.M = NTOK; g.N = 1280; g.K = 1024;
            ListOrder S; S.count = 64; S.G = (int)gridDim.x; S.c = (int)blockIdx.x; S.mode = 1;
            pg8::gemm_phase<EpiIn, ListOrder, false>((PG8_LAS unsigned char*)shm, g, S, E, nullptr, w); } }
        { const int nb = gridDim.x > 64 ? 64 : 0;
          if ((int)blockIdx.x >= nb)
          for (int it = blockIdx.x - nb; it < 384; it += gridDim.x - nb) {
            __syncthreads();
            if (it < 256) { const int qc = it & 3, kvh = (it >> 2) & 1, b = it >> 3;
                attn_item(QB_, KCTX_ + ((size_t)(b * 2 + kvh) * 256) * 64, VCTX_ + ((size_t)(b * 2 + kvh) * 64) * 256, 256, 256, b * 256 + qc * 64, kvh, MIXB_, shm, w); }
            else { const int wi = (it - 256) * 8 + w; const int dir = wi & 1, g = (wi >> 1) & 31, pr = 16 + (wi >> 6);
                if (dir == 0) ssm_pass<0, false>(l, pr, g, UB_, (const bf16x8*)(WSP_ + WS_SSMB), (const bf16x8*)(WSP_ + WS_SSMC), (const float*)(WSP_ + WS_SSML), PKP->in[4], nullptr, (float*)(WSP_ + WS_SSEG), nullptr, nullptr, nullptr, nullptr, nullptr, w);
                else ssm_pass<1, false>(l, pr, g, UB_, (const bf16x8*)(WSP_ + WS_SSMB), (const bf16x8*)(WSP_ + WS_SSMC), (const float*)(WSP_ + WS_SSML), PKP->in[4], nullptr, (float*)(WSP_ + WS_SSEG), nullptr, nullptr, nullptr, nullptr, nullptr, w); }
          } }
        GSYNC();
        for (int rep = 0; rep < REP_ATT4; ++rep)
        for (int it = blockIdx.x; it < 512; it += gridDim.x) {
            __syncthreads();
            if (it < 256) { const int qc = it >> 3, kvh = it & 1, b = (it >> 1) & 3;
                attn_item(QB_, KLAT_ + ((size_t)(b * 2 + kvh) * 2560) * 64, VLAT_ + ((size_t)(b * 2 + kvh) * 64) * 2560, 2560, 2560, NCTX + b * 2048 + qc * 64, kvh, MIXB_, shm, w); }
            else { const int si = it - 256, pr = si >> 3, gq = si & 7, g = gq * 4 + (w & 3);
                if (w < 4) ssm_pass<0, true>(l, pr, g, UB_, (const bf16x8*)(WSP_ + WS_SSMB), (const bf16x8*)(WSP_ + WS_SSMC), (const float*)(WSP_ + WS_SSML), PKP->in[4], (const float*)(WSP_ + WS_SSEG), nullptr, YFP_, nullptr, nullptr, PKP->out + OUT_S, shm + w * 8704, w);
                else ssm_pass<1, true>(l, pr, g, UB_, (const bf16x8*)(WSP_ + WS_SSMB), (const bf16x8*)(WSP_ + WS_SSMC), (const float*)(WSP_ + WS_SSML), PKP->in[4], (const float*)(WSP_ + WS_SSEG), nullptr, (float*)(WSP_ + WS_YB), nullptr, nullptr, PKP->out + OUT_S, shm + w * 8704, w);
                __syncthreads();
                { const int tid = ltid(w); const float* YBp = (const float*)(WSP_ + WS_YB); const float* dsk = PKP->in[21] + l * 512;
#pragma unroll 4
                  for (int i = 0; i < 8; ++i) { const int idx = i * 512 + tid, tk = pr * 512 + (idx >> 3), ch = gq * 64 + (idx & 7) * 8; const size_t o = (size_t)tk * 512 + ch;
                      const u32x4 yfw = *(const u32x4*)((const bf16_t*)YFP_ + o), ybw = *(const u32x4*)((const bf16_t*)YBp + o), uw = *(const u32x4*)(UB_ + o); const f32x4 d0 = *(const f32x4*)(dsk + ch), d1 = *(const f32x4*)(dsk + ch + 4);
                      const f32x2 g0 = gelu_pk((f32x2){bflo(yfw.x) + bflo(ybw.x) + d0[0] * bflo(uw.x), bfhi(yfw.x) + bfhi(ybw.x) + d0[1] * bfhi(uw.x)});
                      const f32x2 g1 = gelu_pk((f32x2){bflo(yfw.y) + bflo(ybw.y) + d0[2] * bflo(uw.y), bfhi(yfw.y) + bfhi(ybw.y) + d0[3] * bfhi(uw.y)});
                      const f32x2 g2 = gelu_pk((f32x2){bflo(yfw.z) + bflo(ybw.z) + d1[0] * bflo(uw.z), bfhi(yfw.z) + bfhi(ybw.z) + d1[1] * bfhi(uw.z)});
                      const f32x2 g3 = gelu_pk((f32x2){bflo(yfw.w) + bflo(ybw.w) + d1[2] * bflo(uw.w), bfhi(yfw.w) + bfhi(ybw.w) + d1[3] * bfhi(uw.w)});
                      u32x4 pw; pw.x = pk2(g0.x, g0.y); pw.y = pk2(g1.x, g1.y); pw.z = pk2(g2.x, g2.y); pw.w = pk2(g3.x, g3.y); *(u32x4*)(GB_ + o) = pw; } } }
        }
        GSYNC();
        { EpiGlu E; E.G = GB_; E.bias = PKP->in[23] + l * 512; E.MIX = MIXB_; for (int rep = 0; rep < REP_GLU; ++rep) run_gemm(shm, GB_, (const bf16_t*)(WSP_ + WS_WGLU + l * SZ_WGLU), 512, 512, E, w); }
        GSYNC();
        { EpiRes E; E.xa = XA_; E.xb = XB_; E.xh = l == 0 ? nullptr : XH_; E.Xo = XH_; E.gate = MODSL_ + 2 * 1024; run_gemm(shm, MIXB_, (const bf16_t*)(WSP_ + WS_WOUT + l * SZ_WOUT), 1024, 1024, E, w); }
        GSYNC();
        for (int rep = 0; rep < REP_NORM; ++rep) norm_phase(XA_, XB_, XH_, PKP->in[10] + l * 1024, MODSL_, 6144, 3 * 1024, 4 * 1024, HB_, w);
        GSYNC();
        { EpiFfn1 E; E.ACT = ACTB_; for (int rep = 0; rep < REP_F1; ++rep) run_gemm(shm, HB_, (const bf16_t*)(WSP_ + WS_WF1 + l * SZ_WF1), 5632, 1024, E, w); }
        GSYNC();
        { EpiRes E; E.xa = XA_; E.xb = XB_; E.xh = XH_; E.Xo = XH_; E.gate = MODSL_ + 5 * 1024; run_gemm(shm, ACTB_, (const bf16_t*)(WSP_ + WS_WF2 + l * SZ_WF2), 1024, 2816, E, w); }
        GSYNC();
    }
    final_norm_phase(XH_, XP_, PKP->in[27], w);
}
#undef WSP_
#undef XP_
#undef MODS_
#undef HB_
#undef YFP_
#undef QB_
#undef UB_
#undef MIXB_
#undef GB_
#undef ACTB_
#undef KCTX_
#undef VCTX_
#undef MODSL_
#undef XA_
#undef XH_
#undef XB_
#undef KLAT_
#undef VLAT_

extern "C" void kernel_launch(void* const* d_in, const int* in_sizes, int n_in, void* d_out, int out_size, void* d_ws, size_t ws_size, hipStream_t stream) {
    static int grid_blocks = 0;
    if (grid_blocks == 0) {
        if (n_in < 28 || ws_size < WS_END) { fprintf(stderr, "kernel_launch: need 28 inputs and %zu bytes of workspace (got %d, %zu)\n", (size_t)WS_END, n_in, ws_size); grid_blocks = -1; return; }
        int dev = 0, cus = 0, per_cu = 0;
        (void)hipGetDevice(&dev);
        (void)hipDeviceGetAttribute(&cus, hipDeviceAttributeMultiprocessorCount, dev);
        if (hipFuncSetAttribute((const void*)mega_fwd, hipFuncAttributeMaxDynamicSharedMemorySize, LDS_BYTES) != hipSuccess) fprintf(stderr, "kernel_launch: hipFuncSetAttribute failed\n");
        if (hipOccupancyMaxActiveBlocksPerMultiprocessor(&per_cu, (const void*)mega_fwd, 512, LDS_BYTES) != hipSuccess || per_cu < 1) { per_cu = 1; (void)hipGetLastError(); }
        if (per_cu > 1) per_cu = 1;
        grid_blocks = cus * per_cu;
    }
    if (grid_blocks < 0) return;
    (void)hipMemsetAsync((unsigned char*)d_ws + WS_BAR, 0, SZ_BAR, stream);
    Params p{};
    for (int i = 0; i < 28; ++i) p.in[i] = (const float*)d_in[i];
    p.out = (float*)d_out; p.ws = (unsigned char*)d_ws;
    void* args[] = {&p};
    hipError_t e = hipLaunchCooperativeKernel((const void*)mega_fwd, dim3(grid_blocks), dim3(512), args, LDS_BYTES, stream);
    if (e != hipSuccess) fprintf(stderr, "cooperative launch failed: %s (grid %d)\n", hipGetErrorString(e), grid_blocks);
}
```

```cpp
#include <hip/hip_runtime.h>
#include <hip/hip_cooperative_groups.h>
#include <cstdio>
namespace cg = cooperative_groups;
#define DI __device__ __forceinline__
DI unsigned char* opaque_ptr(unsigned char* p) { asm volatile("" : "+s"(p)); return p; }
DI float shx(float v, int m, int lane) { return __int_as_float(__builtin_amdgcn_ds_bpermute((lane ^ m) << 2, __float_as_int(v))); }
DI int lane_now() { int l; asm volatile("v_mbcnt_lo_u32_b32 %0, -1, 0\n\tv_mbcnt_hi_u32_b32 %0, -1, %0" : "=v"(l)); return l; }
DI int ltid(int wv) { return wv * 64 + lane_now(); }

namespace pg8 {
#define PG8_LAS __attribute__((address_space(3)))
typedef unsigned short bf16_t;
typedef short bf16x8 __attribute__((ext_vector_type(8)));
typedef float f32x4 __attribute__((ext_vector_type(4)));
typedef unsigned u32x4 __attribute__((ext_vector_type(4)));
constexpr int BM = 256, BK = 64, HALF = 128, HTB = HALF * BK * 2  , STAGE_BYTES = 8 * HTB, NXCD = 8, WGM = 1;

__host__ __device__ __forceinline__ int lds_byte(int r, int c) { const int st = (r >> 4) * 2 + (c >> 5), rr = r & 15, cc = c & 31, ob = rr * 64 + cc * 2; return st * 1024 + (ob ^ (((ob >> 9) & 1) << 5)); }
__host__ __device__ __forceinline__ void stage_rc(int b, int& R, int& C) { const int st = b / 1024, sb = b % 1024, swz = sb ^ (((sb >> 9) & 1) << 5); R = (st >> 1) * 16 + swz / 64; C = (st & 1) * 32 + (swz % 64) / 2; }
__host__ __device__ __forceinline__ int perm32(int rho) { const int n = rho >> 4, i = rho & 15; return 8 * (i >> 2) + 4 * n + (i & 3); }

struct Unit { int pm, pn; };
struct Gemm { const bf16_t* A; const bf16_t* Bt; int M, N, K; };

struct StaticOrder {
    int nM, nN, nwg, G, c;
    __host__ __device__ void init(int M, int N, int G_, int c_) { nM = M / BM; nN = N / BM; nwg = nM * nN; G = G_; c = c_; }
    __host__ __device__ bool next(int i, Unit& u) const {
        const long L = (long)i * G + c; if (L >= nwg) return false;
        int wgid = (int)L; { const int q = nwg / NXCD, r = nwg % NXCD, xcd = wgid % NXCD, off = wgid / NXCD; wgid = (xcd < r ? xcd * (q + 1) : r * (q + 1) + (xcd - r) * q) + off; }
        const int nig = WGM * nN, gid = wgid / nig, fm = gid * WGM, gsz = (nM - fm) < WGM ? (nM - fm) : WGM;
        u.pm = fm + ((wgid % nig) % gsz); u.pn = (wgid % nig) / gsz; return true;
    }
    __device__ __forceinline__ void a_ready(const Unit&) const {}
    __device__ __forceinline__ void done(const Unit&) const {}
};

template <class Epi, class Sched, bool STAMP = false>
__device__ __forceinline__ void gemm_phase(PG8_LAS unsigned char* lds, const Gemm g, const Sched& S, const Epi& E, unsigned long long* stamps, int wv) {
    int tid_l; asm volatile("v_mbcnt_lo_u32_b32 %0, -1, 0\n\tv_mbcnt_hi_u32_b32 %0, -1, %0" : "=v"(tid_l)); tid_l += wv * 64;
    const int tid = tid_l, wid = __builtin_amdgcn_readfirstlane(tid >> 6), lane = tid & 63, wr = wid >> 2, wc = wid & 3, fr = lane & 15, fq = lane >> 4;
    const int K = g.K, nt = K / BK;
    int ts_lo = 0, ts_hi = 0, nts = 0; const unsigned long long rt_entry = STAMP ? (unsigned long long)wall_clock64() : 0ull;
#define PG8_STAMP() do { if (STAMP && wid == 0 && nts < 64) { const unsigned long long _c = (unsigned long long)clock64(); \
        ts_lo = (lane == nts) ? (int)(unsigned)_c : ts_lo; ts_hi = (lane == nts) ? (int)(unsigned)(_c >> 32) : ts_hi; ++nts; } } while (0)
    PG8_STAMP();
    unsigned voffA[2], voffB[2];
#pragma unroll
    for (int i = 0; i < 2; ++i) { int R, C; stage_rc(tid * 16 + i * 8192, R, C); const int Rb = Epi::PERM ? ((R & ~31) + perm32(R & 31)) : R;
        voffA[i] = (unsigned)(R * K + C) * 2u; voffB[i] = (unsigned)(Rb * K + C) * 2u; }
    const size_t kstep = (size_t)(BK * 2);
    const size_t hstep = (size_t)HALF * K * 2;
    const size_t tstep = 2 * hstep;
    const unsigned ldsw = (unsigned)wid * 1024u;
    const int aoff = lds_byte(wr * 64 + fr, fq * 8), boff = lds_byte(wc * 32 + fr, fq * 8);
#define PG8_SA(b, h) (((b) * 2 + (h)) * HTB)
#define PG8_SB(b, h) ((4 + (b) * 2 + (h)) * HTB)
#define PG8_STAGE(bufoff, gbase, voff) do { _Pragma("unroll") for (int _i = 0; _i < 2; ++_i) \
        __builtin_amdgcn_global_load_lds((const unsigned*)((const char*)(gbase) + (voff)[_i]), (PG8_LAS unsigned*)(lds + (bufoff) + ldsw + _i * 8192), 16, 0, 0); } while (0)
#define PG8_LDA(dst, b, h) do { _Pragma("unroll") for (int m = 0; m < 4; ++m) _Pragma("unroll") for (int k = 0; k < 2; ++k) dst[m][k] = *(const PG8_LAS bf16x8*)(lds + PG8_SA(b, h) + aoff + m * 2048 + k * 1024); } while (0)
#define PG8_LDB(dst, b, h) do { _Pragma("unroll") for (int n = 0; n < 2; ++n) _Pragma("unroll") for (int k = 0; k < 2; ++k) dst[n][k] = *(const PG8_LAS bf16x8*)(lds + PG8_SB(b, h) + boff + n * 2048 + k * 1024); } while (0)
#define PG8_MMA(ai, bj, At, Bt) do { __builtin_amdgcn_s_setprio(1); _Pragma("unroll") for (int m = 0; m < 4; ++m) _Pragma("unroll") for (int n = 0; n < 2; ++n) _Pragma("unroll") for (int k = 0; k < 2; ++k) \
        acc[ai][bj][m][n] = __builtin_amdgcn_mfma_f32_16x16x32_bf16(Bt[n][k], At[m][k], acc[ai][bj][m][n], 0, 0, 0); __builtin_amdgcn_s_setprio(0); } while (0)
#define PG8_WAIT_V(n) asm volatile("s_waitcnt vmcnt(" #n ")" ::: "memory")
#define PG8_WAIT_L(n) asm volatile("s_waitcnt lgkmcnt(" #n ")" ::: "memory")
#define PG8_BAR __builtin_amdgcn_s_barrier()
#define PG8_SCHED __builtin_amdgcn_sched_barrier(0)
    Unit cur, nxt; int ui = 0;
    if (!S.next(0, cur)) return;
    f32x4 acc[2][2][4][2];
#pragma unroll
    for (int a = 0; a < 2; ++a)
#pragma unroll
        for (int b = 0; b < 2; ++b)
#pragma unroll
            for (int m = 0; m < 4; ++m)
#pragma unroll
                for (int n = 0; n < 2; ++n) acc[a][b][m][n] = (f32x4){0.f, 0.f, 0.f, 0.f};
    bf16x8 At[4][2], B0[2][2], B1[2][2];
    const char* cA = (const char*)g.A + (size_t)cur.pm * tstep; const char* cB = (const char*)g.Bt + (size_t)cur.pn * tstep;
    S.a_ready(cur);
    PG8_STAGE(PG8_SB(0, 0), cB, voffB); PG8_STAGE(PG8_SA(0, 0), cA, voffA); PG8_STAGE(PG8_SB(0, 1), cB + hstep, voffB); PG8_STAGE(PG8_SA(0, 1), cA + hstep, voffA);
    if (wr == 1) PG8_BAR;
    PG8_WAIT_V(4); PG8_BAR;
    PG8_STAGE(PG8_SB(1, 0), cB + kstep, voffB); PG8_STAGE(PG8_SA(1, 0), cA + kstep, voffA); PG8_STAGE(PG8_SB(1, 1), cB + hstep + kstep, voffB);
    PG8_WAIT_V(6); PG8_BAR;
    PG8_STAMP();
    for (;;) {
        const bool has_next = S.next(ui + 1, nxt);
        const char* nA = has_next ? (const char*)g.A + (size_t)nxt.pm * tstep : cA; const char* nB = has_next ? (const char*)g.Bt + (size_t)nxt.pn * tstep : cB;
        for (int t = 0; t < nt; t += 2) {
            const bool last = (t == nt - 2);
            const char* a1 = cA + (size_t)(t + 1) * kstep;
            const char* a2 = last ? nA : cA + (size_t)(t + 2) * kstep; const char* b2 = last ? nB : cB + (size_t)(t + 2) * kstep;
            const char* a3 = a2 + kstep; const char* b3 = b2 + kstep;
            if (last && has_next) S.a_ready(nxt);
            PG8_LDB(B0, 0, 0); PG8_SCHED; PG8_LDA(At, 0, 0); PG8_STAGE(PG8_SA(1, 1), a1 + hstep, voffA);
            PG8_WAIT_L(8); PG8_BAR; PG8_WAIT_L(0); PG8_MMA(0, 0, At, B0); PG8_BAR; PG8_SCHED;
            PG8_LDB(B1, 0, 1); PG8_STAGE(PG8_SB(0, 0), b2, voffB);
            PG8_BAR; PG8_WAIT_L(0); PG8_MMA(0, 1, At, B1); PG8_BAR;
            PG8_LDA(At, 0, 1); PG8_STAGE(PG8_SA(0, 0), a2, voffA);
            PG8_BAR; PG8_WAIT_L(0); PG8_MMA(1, 0, At, B0); PG8_BAR; PG8_SCHED;
            PG8_STAGE(PG8_SB(0, 1), b2 + hstep, voffB);
            PG8_WAIT_V(6); PG8_BAR; PG8_MMA(1, 1, At, B1); PG8_BAR;
            PG8_LDB(B0, 1, 0); PG8_SCHED; PG8_LDA(At, 1, 0); PG8_STAGE(PG8_SA(0, 1), a2 + hstep, voffA);
            PG8_WAIT_L(8); PG8_BAR; PG8_WAIT_L(0); PG8_MMA(0, 0, At, B0); PG8_BAR; PG8_SCHED;
            PG8_LDB(B1, 1, 1); PG8_STAGE(PG8_SB(1, 0), b3, voffB);
            PG8_BAR; PG8_WAIT_L(0); PG8_MMA(0, 1, At, B1); PG8_BAR;
            PG8_LDA(At, 1, 1); PG8_STAGE(PG8_SA(1, 0), a3, voffA);
            PG8_BAR; PG8_WAIT_L(0); PG8_MMA(1, 0, At, B0); PG8_BAR; PG8_SCHED;
            PG8_STAGE(PG8_SB(1, 1), b3 + hstep, voffB);
            PG8_WAIT_V(6); PG8_BAR; PG8_MMA(1, 1, At, B1); PG8_BAR;
        }
        PG8_STAMP();
        if constexpr (!Epi::AFTER_DRAIN) { E(acc, cur, wr, wc, fr, fq); S.done(cur); }
        PG8_STAMP();
        if (!has_next) break;
#pragma unroll
        for (int a = 0; a < 2; ++a)
#pragma unroll
            for (int b = 0; b < 2; ++b)
#pragma unroll
                for (int m = 0; m < 4; ++m)
#pragma unroll
                    for (int n = 0; n < 2; ++n) acc[a][b][m][n] = (f32x4){0.f, 0.f, 0.f, 0.f};
        cur = nxt; cA = nA; cB = nB; ++ui;
    }
    PG8_WAIT_V(0);
    if (wr == 0) PG8_BAR;
    PG8_BAR;
    if constexpr (Epi::AFTER_DRAIN) { E.fused(acc, cur, wr, wc, fr, fq, lds, wid, lane); S.done(cur); }
    PG8_STAMP();
    if (STAMP && wid == 0) { stamps[lane] = lane < nts ? (((unsigned long long)(unsigned)ts_hi << 32) | (unsigned)ts_lo) : 0ull;
        if (lane == 62) stamps[62] = rt_entry; if (lane == 63) stamps[63] = (unsigned long long)wall_clock64(); }
#undef PG8_STAMP
#undef PG8_SA
#undef PG8_SB
#undef PG8_STAGE
#undef PG8_LDA
#undef PG8_LDB
#undef PG8_MMA
#undef PG8_WAIT_V
#undef PG8_WAIT_L
#undef PG8_BAR
#undef PG8_SCHED
}
}

typedef unsigned short bf16_t;
typedef short bf16x8 __attribute__((ext_vector_type(8)));
typedef short s16x4 __attribute__((ext_vector_type(4)));
typedef float f32x4 __attribute__((ext_vector_type(4)));
typedef float f32x2 __attribute__((ext_vector_type(2)));
typedef float f32x16 __attribute__((ext_vector_type(16)));
typedef unsigned u32x4 __attribute__((ext_vector_type(4)));
typedef unsigned u32x2 __attribute__((ext_vector_type(2)));
typedef __bf16 bf16x2_t __attribute__((ext_vector_type(2)));

constexpr int NTOK = 16384, DM = 1024, NCTX = 8192;
constexpr size_t SZ_WIN = (size_t)1280 * 1024 * 2, SZ_WGLU = (size_t)512 * 512 * 2, SZ_WOUT = (size_t)1024 * 1024 * 2, SZ_WF1 = (size_t)5632 * 1024 * 2, SZ_WF2 = (size_t)1024 * 2816 * 2;
constexpr size_t WS_WIN = 0, WS_WGLU = WS_WIN + 2 * SZ_WIN, WS_WOUT = WS_WGLU + 2 * SZ_WGLU, WS_WF1 = WS_WOUT + 2 * SZ_WOUT, WS_WF2 = WS_WF1 + 2 * SZ_WF1;
constexpr size_t WS_H = WS_WF2 + 2 * SZ_WF2;
constexpr size_t WS_Q = WS_H + (size_t)NTOK * 1024 * 2;
constexpr size_t WS_U = WS_Q + (size_t)NTOK * 512 * 2;
constexpr size_t WS_MIX = WS_U + (size_t)NTOK * 512 * 2;
constexpr size_t WS_G = WS_MIX + (size_t)NTOK * 1024 * 2;
constexpr size_t WS_ACT = WS_Q;
constexpr size_t WS_KLAT = WS_ACT + (size_t)NTOK * 2816 * 2;
constexpr size_t SZ_KLAT = (size_t)4 * 2 * 2560 * 64 * 2;
constexpr size_t WS_VLAT = WS_KLAT + 2 * SZ_KLAT;
constexpr size_t WS_KCTX = WS_VLAT + 2 * SZ_KLAT;
constexpr size_t SZ_KCTX = (size_t)32 * 2 * 256 * 64 * 2;
constexpr size_t WS_VCTX = WS_KCTX + SZ_KCTX;
constexpr size_t WS_MODS = WS_VCTX + SZ_KCTX;
constexpr size_t SZ_MODS = (size_t)2 * 5 * 6144 * 4;
constexpr size_t WS_BAR = WS_MODS + SZ_MODS;
constexpr size_t SZ_BAR = (size_t)3456 * 4;
constexpr size_t WS_ROPEC = WS_BAR + SZ_BAR;
constexpr size_t WS_ROPES = WS_ROPEC + (size_t)2048 * 32 * 4;
constexpr size_t WS_SSMB = WS_ROPES + (size_t)2048 * 32 * 4;
constexpr size_t WS_SSMC = WS_SSMB + (size_t)128 * 4096;
constexpr size_t WS_SSML = WS_SSMC + (size_t)128 * 4096;
constexpr size_t WS_SSEG = WS_SSML + (size_t)128 * 512;
constexpr size_t WS_YB = WS_SSEG + (size_t)32 * 2 * 32 * 64 * 2 * 4;
constexpr size_t WS_MODP = WS_YB + (size_t)NTOK * 512 * 4;
constexpr size_t WS_XB = WS_MODP + (size_t)4 * 61440 * 4;
constexpr size_t WS_END = WS_XB + (size_t)NTOK * 1024 * 2;
constexpr size_t OUT_K = (size_t)2 * 8388608, OUT_V = OUT_K + 2097152, OUT_S = OUT_V + 2097152;
constexpr int LDS_ROPE = 131072 + 16;
constexpr int LDS_BYTES = LDS_ROPE + 12288;

#ifndef REP_NORM
#define REP_NORM 1
#endif
#ifndef REP_IN
#define REP_IN 1
#endif
#ifndef REP_ATT3
#define REP_ATT3 1
#endif
#ifndef REP_ATT4
#define REP_ATT4 1
#endif
#ifndef REP_GLU
#define REP_GLU 1
#endif
#ifndef REP_F1
#define REP_F1 1
#endif
#ifndef REP_P0
#define REP_P0 1
#endif
struct Params { const float* in[28]; float* out; unsigned char* ws; };

DI unsigned pk2(float lo, float hi) { f32x2 v = {lo, hi}; return __builtin_bit_cast(unsigned, __builtin_convertvector(v, bf16x2_t)); }
DI float bf2f(bf16_t b) { return __uint_as_float(((unsigned)b) << 16); }
DI float bflo(unsigned w) { return __uint_as_float(w << 16); }
DI float bfhi(unsigned w) { return __uint_as_float(w & 0xffff0000u); }
DI bf16x8 pack8(float a0, float a1, float a2, float a3, float a4, float a5, float a6, float a7) {
    u32x4 p; p.x = pk2(a0, a1); p.y = pk2(a2, a3); p.z = pk2(a4, a5); p.w = pk2(a6, a7); return __builtin_bit_cast(bf16x8, p); }
DI f32x16 mfma32(bf16x8 a, bf16x8 b, f32x16 c) { return __builtin_amdgcn_mfma_f32_32x32x16_bf16(a, b, c, 0, 0, 0); }
DI f32x16 mfma32p(bf16x8 a, bf16x8 b, f32x16 c) { __builtin_amdgcn_s_setprio(1); f32x16 r = __builtin_amdgcn_mfma_f32_32x32x16_bf16(a, b, c, 0, 0, 0); __builtin_amdgcn_s_setprio(0); return r; }
DI f32x4 mfma16(bf16x8 a, bf16x8 b, f32x4 c) { return __builtin_amdgcn_mfma_f32_16x16x32_bf16(a, b, c, 0, 0, 0); }
DI f32x2 gelu_pk(f32x2 v) {
    const f32x2 av = __builtin_elementwise_abs(v), d = av * 0.2316418882f + 1.0f;
    f32x2 t; t.x = __builtin_amdgcn_rcpf(d.x); t.y = __builtin_amdgcn_rcpf(d.y);
    f32x2 q = t * 0.5307027145f + (-0.7265760135f); q = q * t + 0.7107068705f; q = q * t + (-0.142248368f); q = q * t + 0.127414796f; q = q * t;
    const f32x2 sq = (v * v) * (-0.72134752044f);
    f32x2 e; e.x = __builtin_amdgcn_exp2f(sq.x); e.y = __builtin_amdgcn_exp2f(sq.y);
    const f32x2 m = v * (q * e), r = v - m;
    f32x2 o; o.x = v.x < 0.f ? m.x : r.x; o.y = v.y < 0.f ? m.y : r.y; return o;
}
#define GAS __attribute__((address_space(1)))
DI u32x2 ldg8(const void* p) { return *(const GAS u32x2*)p; }
DI u32x4 ldg16(const void* p) { return *(const GAS u32x4*)p; }
DI f32x4 ldg16f(const void* p) { return *(const GAS f32x4*)p; }
DI f32x2 ldg8f(const void* p) { return *(const GAS f32x2*)p; }
DI void stg8(void* p, u32x2 v) { *(GAS u32x2*)p = v; }
DI void stg16(void* p, u32x4 v) { *(GAS u32x4*)p = v; }
DI void stg16f(void* p, f32x4 v) { *(GAS f32x4*)p = v; }
DI float sigmoidf_(float x) { return __builtin_amdgcn_rcpf(1.0f + __expf(-x)); }

DI void tconv_tile(const float* __restrict__ src, size_t sld, int ca, int cb, bf16_t* __restrict__ dst, size_t dld, float* lds, int wv) {
    const int tid = ltid(wv);
#pragma unroll
    for (int i = 0; i < 8; ++i) { const int idx = i * 512 + tid, kk = idx >> 6, nn = idx & 63; const int col = nn < 32 ? ca + nn : cb + nn - 32;
        lds[nn * 65 + kk] = src[(size_t)kk * sld + col]; }
    __syncthreads();
    { const int nn = tid >> 3, k8 = (tid & 7) * 8; const float* r = lds + nn * 65 + k8;
      u32x4 w; w.x = pk2(r[0], r[1]); w.y = pk2(r[2], r[3]); w.z = pk2(r[4], r[5]); w.w = pk2(r[6], r[7]);
      *(u32x4*)(dst + (size_t)nn * dld + k8) = w; }
    __syncthreads();
}
DI int srccol_in(int np) { const int pn = np >> 8, cpos = np & 255, bj = cpos >> 7, wc = (cpos >> 5) & 3, w = cpos & 31; return pn * 256 + wc * 64 + bj * 32 + w; }
DI int srccol_f1(int np) { const int tile = np >> 8, bj = (np >> 7) & 1, i = np & 127; return bj * 2816 + tile * 128 + i; }

DI void wconv_task(const Params& P, int t, float* lds, int wv) {
    const int l = t / 2752; int r = t % 2752;
    unsigned char* ws = P.ws;
    if (r < 320) { const int kt = r & 15, ntl = r >> 4, n0 = ntl * 64, k0 = kt * 64;
        tconv_tile(P.in[11] + ((size_t)l * 1024 + k0) * 1280, 1280, srccol_in(n0), srccol_in(n0 + 32), (bf16_t*)(ws + WS_WIN + l * SZ_WIN) + (size_t)n0 * 1024 + k0, 1024, lds, wv); return; }
    r -= 320;
    if (r < 64) { const int kt = r & 7, ntl = r >> 3, n0 = ntl * 64, k0 = kt * 64;
        tconv_tile(P.in[22] + ((size_t)l * 512 + k0) * 512, 512, n0, n0 + 32, (bf16_t*)(ws + WS_WGLU + l * SZ_WGLU) + (size_t)n0 * 512 + k0, 512, lds, wv); return; }
    r -= 64;
    if (r < 256) { const int kt = r & 15, ntl = r >> 4, n0 = ntl * 64, k0 = kt * 64;
        tconv_tile(P.in[24] + ((size_t)l * 1024 + k0) * 1024, 1024, n0, n0 + 32, (bf16_t*)(ws + WS_WOUT + l * SZ_WOUT) + (size_t)n0 * 1024 + k0, 1024, lds, wv); return; }
    r -= 256;
    if (r < 1408) { const int kt = r & 15, ntl = r >> 4, n0 = ntl * 64, k0 = kt * 64;
        tconv_tile(P.in[25] + ((size_t)l * 1024 + k0) * 5632, 5632, srccol_f1(n0), srccol_f1(n0 + 32), (bf16_t*)(ws + WS_WF1 + l * SZ_WF1) + (size_t)n0 * 1024 + k0, 1024, lds, wv); return; }
    r -= 1408;
    { const int kt = r % 44, ntl = r / 44, n0 = ntl * 64, k0 = kt * 64;
        tconv_tile(P.in[26] + ((size_t)l * 2816 + k0) * 1024, 1024, n0, n0 + 32, (bf16_t*)(ws + WS_WF2 + l * SZ_WF2) + (size_t)n0 * 2816 + k0, 2816, lds, wv); }
}

DI void adaln_task(const Params& P, int task, float* lds, int wv) {
    const int tid = ltid(wv), w = tid >> 6, lane = tid & 63;
    const int kc = task & 3, cgp = (task >> 2) % 24, l = task / 96;
    const int n = cgp * 256 + lane * 4;
    const int k0 = kc * 256 + w * 32;
    const float* wm = P.in[7] + ((size_t)l * 1024 + k0) * 6144 + n;
    const float* cc = P.in[5]; const float* cx = P.in[6];
    f32x4 wrow[32];
#pragma unroll
    for (int kk = 0; kk < 32; ++kk) wrow[kk] = *(const f32x4*)(wm + (size_t)kk * 6144);
    f32x4 acc[5];
#pragma unroll
    for (int j = 0; j < 5; ++j) acc[j] = (f32x4){0.f, 0.f, 0.f, 0.f};
#pragma unroll
    for (int kk = 0; kk < 32; ++kk) { const int k = k0 + kk;
#pragma unroll
        for (int j = 0; j < 5; ++j) { const float cv = (j == 0) ? cx[k] : cc[(j - 1) * 1024 + k]; const float sv = cv / (1.0f + __expf(-cv)); acc[j] += wrow[kk] * sv; } }
#pragma unroll
    for (int j = 0; j < 5; ++j) *(f32x4*)(lds + (w * 5 + j) * 256 + lane * 4) = acc[j];
    __syncthreads();
    float* part = (float*)(P.ws + WS_MODP) + (size_t)kc * 61440;
    for (int e = tid; e < 1280; e += 512) { const int j = e >> 8, col = e & 255; float sm = 0.f;
#pragma unroll
        for (int ww = 0; ww < 8; ++ww) sm += lds[(ww * 5 + j) * 256 + col];
        part[(l * 5 + j) * 6144 + cgp * 256 + col] = sm; }
    __syncthreads();
}

DI void ssmconst_task(const Params& P, int task, int wv) {
    const int idx = task * 512 + ltid(wv); const int p = idx & 63, ldg = idx >> 6;
    const double dt = exp((double)P.in[16][ldg]); const double ar = (double)P.in[14][ldg * 64 + p], ai = (double)P.in[15][ldg * 64 + p];
    const double mag = exp(ar * dt); double sn, cs; sincos(ai * dt, &sn, &cs);
    const double lr = mag * cs, li = mag * sn, den = ar * ar + ai * ai;
    const double zr = ((lr - 1.0) * ar + li * ai) / den, zi = (li * ar - (lr - 1.0) * ai) / den;
    float* lam = (float*)(P.ws + WS_SSML); lam[(ldg * 64 + p) * 2] = (float)lr; lam[(ldg * 64 + p) * 2 + 1] = (float)li;
    bf16_t* Bm = (bf16_t*)(P.ws + WS_SSMB); bf16_t* Cm = (bf16_t*)(P.ws + WS_SSMC);
    const float* bre = P.in[17] + ((size_t)ldg * 64 + p) * 16; const float* bim = P.in[18] + ((size_t)ldg * 64 + p) * 16;
    const int ntb = (p >= 32) ? 2 : 0;
    for (int h = 0; h < 16; ++h) { const double br = bre[h], bi = bim[h]; const float bbr = (float)(zr * br - zi * bi), bbi = (float)(zr * bi + zi * br);
        const int ln = (p & 31) + 32 * (h >> 3), j = h & 7;
        Bm[(((size_t)ldg * 4 + ntb) * 64 + ln) * 8 + j] = (bf16_t)(pk2(bbr, 0.f) & 0xffffu);
        Bm[(((size_t)ldg * 4 + ntb + 1) * 64 + ln) * 8 + j] = (bf16_t)(pk2(bbi, 0.f) & 0xffffu); }
    for (int hp = 0; hp < 16; ++hp) { const float cr = P.in[19][((size_t)ldg * 16 + hp) * 64 + p], ci = P.in[20][((size_t)ldg * 16 + hp) * 64 + p];
#pragma unroll
        for (int ri = 0; ri < 2; ++ri) { const int pp = 2 * p + ri, ks = pp >> 5, kq = (pp >> 3) & 3, j = pp & 7;
            Cm[(((size_t)ldg * 4 + ks) * 64 + kq * 16 + hp) * 8 + j] = (bf16_t)(pk2(ri ? -ci : cr, 0.f) & 0xffffu); } }
}

DI void phase0(const Params& P, unsigned char* shm, int wv) {
    float* lds = (float*)shm;
    constexpr int T_ADA = 192, T_W = 5504, T_V = 128, T_K = 128, T_S = 16, T_R = 128;
    constexpr int T_TOTAL = T_ADA + T_W + T_V + T_K + T_S + T_R;
    for (int rep = 0; rep < REP_P0; ++rep)
    for (int t = blockIdx.x; t < T_TOTAL; t += gridDim.x) {
        int r = t;
        if (r < T_ADA) { adaln_task(P, r, lds, wv); continue; }
        r -= T_ADA;
        if (r < T_W) { wconv_task(P, r, lds, wv); continue; }
        r -= T_W;
        if (r < T_V) { const int s8 = r & 7, kvh = (r >> 3) & 1, b = (r >> 4) & 3, l = r >> 6;
            tconv_tile(P.in[3] + (((size_t)(b * 2 + l) * 512 + s8 * 64) * 2 + kvh) * 64, 128, 0, 32,
                       (bf16_t*)(P.ws + WS_VLAT + l * SZ_KLAT) + ((size_t)(b * 2 + kvh) * 64) * 2560 + s8 * 64, 2560, lds, wv); continue; }
        r -= T_V;
        if (r < T_K) { const int idx = r * 4096 + ltid(wv) * 8; const int d = idx & 63, s = (idx >> 6) & 511, kvh = (idx >> 15) & 1, b = (idx >> 16) & 3, l = idx >> 18;
            const float* src = P.in[2] + ((((size_t)(b * 2 + l) * 512 + s) * 2 + kvh) * 64 + d);
            const f32x4 a = *(const f32x4*)src, c = *(const f32x4*)(src + 4);
            u32x4 w; w.x = pk2(a[0], a[1]); w.y = pk2(a[2], a[3]); w.z = pk2(c[0], c[1]); w.w = pk2(c[2], c[3]);
            *(u32x4*)((bf16_t*)(P.ws + WS_KLAT + l * SZ_KLAT) + ((size_t)(b * 2 + kvh) * 2560 + s) * 64 + d) = w; continue; }
        r -= T_K;
        if (r < T_S) { ssmconst_task(P, r, wv); continue; }
        r -= T_S;
        { const int idx = r * 512 + ltid(wv); const int tt = idx >> 5, i = idx & 31; const int pos = (i < 16) ? (tt >> 6) : (tt & 63); const int f = i & 15;
          const double inv = pow(10000.0, -(2.0 * f) / 32.0); double sn, cs; sincos((double)pos * inv, &sn, &cs);
          ((float*)(P.ws + WS_ROPEC))[idx] = (float)cs; ((float*)(P.ws + WS_ROPES))[idx] = (float)sn; }
    }
}

DI float wave_sum(float v, int lane) {
    v += shx(v, 32, lane); v += shx(v, 16, lane); v += shx(v, 8, lane); v += shx(v, 4, lane); v += shx(v, 2, lane); v += shx(v, 1, lane); return v; }

DI void norm_phase(const float* __restrict__ xa, const float* __restrict__ xb, const bf16_t* __restrict__ xh, const float* __restrict__ gw, const float* mbase, int jstride, int sh_off, int sc_off, bf16_t* __restrict__ H, int wv) {
    const int tidl = ltid(wv); const int lane = tidl & 63, w = tidl >> 6;
    for (int base = (blockIdx.x * 8 + w) * 8; base < NTOK; base += gridDim.x * 64) {
        const int j = base < NCTX ? 0 : 1 + ((base - NCTX) >> 11);
        f32x4 wv4[4], sh4[4];
#pragma unroll
        for (int i = 0; i < 4; ++i) { const int col = i * 256 + lane * 4;
            const f32x4 g4 = ldg16f(gw + col), sc = *(const f32x4*)(mbase + j * jstride + sc_off + col); sh4[i] = *(const f32x4*)(mbase + j * jstride + sh_off + col); wv4[i] = g4 * (sc + 1.0f); }
#pragma unroll
        for (int hb = 0; hb < 2; ++hb) {
            f32x4 v[4][4]; float ss[4];
            if (xh) { u32x2 t[4][4];
#pragma unroll
                for (int r = 0; r < 4; ++r)
#pragma unroll
                    for (int i = 0; i < 4; ++i) t[r][i] = ldg8(xh + (size_t)(base + hb * 4 + r) * 1024 + i * 256 + lane * 4);
#pragma unroll
                for (int r = 0; r < 4; ++r)
#pragma unroll
                    for (int i = 0; i < 4; ++i) v[r][i] = (f32x4){bflo(t[r][i].x), bfhi(t[r][i].x), bflo(t[r][i].y), bfhi(t[r][i].y)};
            } else { const float* xr = base < NCTX ? xa + (size_t)(base + hb * 4) * 1024 : xb + (size_t)(base + hb * 4 - NCTX) * 1024;
#pragma unroll
                for (int r = 0; r < 4; ++r)
#pragma unroll
                    for (int i = 0; i < 4; ++i) v[r][i] = ldg16f(xr + (size_t)r * 1024 + i * 256 + lane * 4); }
#pragma unroll
            for (int r = 0; r < 4; ++r) { float a = 0.f;
#pragma unroll
                for (int i = 0; i < 4; ++i) a += v[r][i][0] * v[r][i][0] + v[r][i][1] * v[r][i][1] + v[r][i][2] * v[r][i][2] + v[r][i][3] * v[r][i][3];
                ss[r] = a; }
#pragma unroll
            for (int mk = 32; mk >= 1; mk >>= 1)
#pragma unroll
                for (int r = 0; r < 4; ++r) ss[r] += shx(ss[r], mk, lane);
#pragma unroll
            for (int r = 0; r < 4; ++r) { const float rstd = rsqrtf(ss[r] * (1.0f / 1024.0f) + 1e-6f);
#pragma unroll
                for (int i = 0; i < 4; ++i) { const f32x4 o = v[r][i] * rstd * wv4[i] + sh4[i];
                    u32x2 pw; pw.x = pk2(o[0], o[1]); pw.y = pk2(o[2], o[3]); stg8(H + (size_t)(base + hb * 4 + r) * 1024 + i * 256 + lane * 4, pw); } }
        }
    }
}

DI void final_norm_phase(const bf16_t* __restrict__ xh, float* __restrict__ Y, const float* __restrict__ gw, int wv) {
    const int tidl = ltid(wv); const int lane = tidl & 63, w = tidl >> 6;
    for (int base = (blockIdx.x * 8 + w) * 8; base < NTOK; base += gridDim.x * 64) {
        f32x4 g4[4];
#pragma unroll
        for (int i = 0; i < 4; ++i) g4[i] = ldg16f(gw + i * 256 + lane * 4);
#pragma unroll
        for (int hb = 0; hb < 2; ++hb) {
            u32x2 t[4][4]; float ss[4];
#pragma unroll
            for (int r = 0; r < 4; ++r)
#pragma unroll
                for (int i = 0; i < 4; ++i) t[r][i] = ldg8(xh + (size_t)(base + hb * 4 + r) * 1024 + i * 256 + lane * 4);
            f32x4 v[4][4];
#pragma unroll
            for (int r = 0; r < 4; ++r) { float a = 0.f;
#pragma unroll
                for (int i = 0; i < 4; ++i) { v[r][i] = (f32x4){bflo(t[r][i].x), bfhi(t[r][i].x), bflo(t[r][i].y), bfhi(t[r][i].y)}; a += v[r][i][0] * v[r][i][0] + v[r][i][1] * v[r][i][1] + v[r][i][2] * v[r][i][2] + v[r][i][3] * v[r][i][3]; }
                ss[r] = a; }
#pragma unroll
            for (int mk = 32; mk >= 1; mk >>= 1)
#pragma unroll
                for (int r = 0; r < 4; ++r) ss[r] += shx(ss[r], mk, lane);
#pragma unroll
            for (int r = 0; r < 4; ++r) { const float rstd = rsqrtf(ss[r] * (1.0f / 1024.0f) + 1e-6f);
#pragma unroll
                for (int i = 0; i < 4; ++i) stg16f(Y + (size_t)(base + hb * 4 + r) * 1024 + i * 256 + lane * 4, v[r][i] * rstd * g4[i]); }
        }
    }
}

struct EpiIn {
    static constexpr bool PERM = true, AFTER_DRAIN = false;
    int layer; const float* qn; const float* kn; const PG8_LAS float* lr;
    bf16_t* Q; bf16_t* U; bf16_t* Kctx; bf16_t* Vctx; bf16_t* Klat; bf16_t* Vlat; float* outk; float* outv;
    DI void operator()(const f32x4 (&acc)[2][2][4][2], const pg8::Unit& u, int wr, int wc, int fr, int fq) const {
        asm volatile("" : "+v"(fr), "+v"(fq));
        const bool lat = u.pm >= 32; const int pn = u.pn;
        if (pn >= 3) {
#pragma unroll
            for (int ai = 0; ai < 2; ++ai)
#pragma unroll
                for (int m = 0; m < 4; ++m) { const int row = u.pm * 256 + ai * 128 + wr * 64 + m * 16 + fr;
#pragma unroll
                    for (int bj = 0; bj < 2; ++bj) { const int col = (pn - 3) * 256 + 64 * wc + 32 * bj + 8 * fq; const f32x4 a0 = acc[ai][bj][m][0], a1 = acc[ai][bj][m][1];
                        u32x4 pw; pw.x = pk2(a0[0], a0[1]); pw.y = pk2(a0[2], a0[3]); pw.z = pk2(a1[0], a1[1]); pw.w = pk2(a1[2], a1[3]); stg16(U + (size_t)row * 512 + col, pw); } }
            return;
        }
        if (pn == 2 && wc >= 2) {
            const int kvh = wc - 2;
#pragma unroll
            for (int ai = 0; ai < 2; ++ai)
#pragma unroll
                for (int m = 0; m < 4; ++m) { const int row = u.pm * 256 + ai * 128 + wr * 64 + m * 16 + fr;
                    if (!lat) { const int b = row >> 8, t = row & 255; float* ov = outv + (((size_t)(b * 2 + layer) * 256 + t) * 2 + kvh) * 64; bf16_t* vt = Vctx + ((size_t)(b * 2 + kvh) * 64) * 256 + t;
#pragma unroll
                        for (int bj = 0; bj < 2; ++bj)
#pragma unroll
                            for (int n = 0; n < 2; ++n) { const int d = 32 * bj + 8 * fq + 4 * n; const f32x4 a = acc[ai][bj][m][n]; stg16f(ov + d, a);
                                const unsigned p0 = pk2(a[0], a[1]), p1 = pk2(a[2], a[3]);
                                vt[(size_t)(d + 0) * 256] = (bf16_t)(p0 & 0xffffu); vt[(size_t)(d + 1) * 256] = (bf16_t)(p0 >> 16); vt[(size_t)(d + 2) * 256] = (bf16_t)(p1 & 0xffffu); vt[(size_t)(d + 3) * 256] = (bf16_t)(p1 >> 16); } }
                    else { const int rl = row - NCTX, b = rl >> 11, t = rl & 2047; bf16_t* vt = Vlat + ((size_t)(b * 2 + kvh) * 64) * 2560 + 512 + t;
#pragma unroll
                        for (int bj = 0; bj < 2; ++bj)
#pragma unroll
                            for (int n = 0; n < 2; ++n) { const int d = 32 * bj + 8 * fq + 4 * n; const f32x4 a = acc[ai][bj][m][n];
                                const unsigned p0 = pk2(a[0], a[1]), p1 = pk2(a[2], a[3]);
                                vt[(size_t)(d + 0) * 2560] = (bf16_t)(p0 & 0xffffu); vt[(size_t)(d + 1) * 2560] = (bf16_t)(p0 >> 16); vt[(size_t)(d + 2) * 2560] = (bf16_t)(p1 & 0xffffu); vt[(size_t)(d + 3) * 2560] = (bf16_t)(p1 >> 16); } } }
            return;
        }
        const bool isq = pn < 2; const float* nw = isq ? qn : kn;
        f32x4 w4[2][2];
#pragma unroll
        for (int bj = 0; bj < 2; ++bj)
#pragma unroll
            for (int n = 0; n < 2; ++n) w4[bj][n] = ldg16f(nw + 32 * bj + 8 * fq + 4 * n);
        const float qscale = isq ? 0.125f * 1.4426950408889634f : 1.0f;
        const int T0r = ((u.pm * 256 - NCTX) & 2047) >> 6;
#pragma unroll
        for (int ai = 0; ai < 2; ++ai)
#pragma unroll
            for (int m = 0; m < 4; ++m) { const int row = u.pm * 256 + ai * 128 + wr * 64 + m * 16 + fr;
                float ss = 0.f;
#pragma unroll
                for (int bj = 0; bj < 2; ++bj)
#pragma unroll
                    for (int n = 0; n < 2; ++n) { const f32x4 a = acc[ai][bj][m][n]; ss += a[0] * a[0] + a[1] * a[1] + a[2] * a[2] + a[3] * a[3]; }
                ss += shx(ss, 16, fq * 16 + fr); ss += shx(ss, 32, fq * 16 + fr);
                const float rstd = rsqrtf(ss * (1.0f / 64.0f) + 1e-6f);
                f32x4 v[2][2];
#pragma unroll
                for (int bj = 0; bj < 2; ++bj)
#pragma unroll
                    for (int n = 0; n < 2; ++n) v[bj][n] = acc[ai][bj][m][n] * rstd * w4[bj][n];
                if (!lat) {
                    const int b = row >> 8, t = row & 255;
                    if (isq) { bf16_t* qp = Q + (size_t)row * 512 + (pn * 4 + wc) * 64;
#pragma unroll
                        for (int bj = 0; bj < 2; ++bj) { const f32x4 a0 = v[bj][0] * qscale, a1 = v[bj][1] * qscale;
                            u32x4 pw; pw.x = pk2(a0[0], a0[1]); pw.y = pk2(a0[2], a0[3]); pw.z = pk2(a1[0], a1[1]); pw.w = pk2(a1[2], a1[3]); stg16(qp + 32 * bj + 8 * fq, pw); } }
                    else { const int kvh = wc; float* ok = outk + (((size_t)(b * 2 + layer) * 256 + t) * 2 + kvh) * 64; bf16_t* kp = Kctx + ((size_t)(b * 2 + kvh) * 256 + t) * 64;
#pragma unroll
                        for (int bj = 0; bj < 2; ++bj) { const int d = 32 * bj + 8 * fq; const f32x4 a0 = v[bj][0], a1 = v[bj][1]; stg16f(ok + d, a0); stg16f(ok + d + 4, a1);
                            u32x4 pw; pw.x = pk2(a0[0], a0[1]); pw.y = pk2(a0[2], a0[3]); pw.z = pk2(a1[0], a1[1]); pw.w = pk2(a1[2], a1[3]); stg16(kp + d, pw); } }
                } else {
                    const int rl = row - NCTX, b = rl >> 11, t = rl & 2047;
                    bf16_t* dst = isq ? Q + (size_t)row * 512 + (pn * 4 + wc) * 64 : Klat + ((size_t)(b * 2 + wc) * 2560 + 512 + t) * 64;
                    const int grow = T0r + 2 * ai + wr, gcol = 16 * m + fr;
#pragma unroll
                    for (int bj = 0; bj < 2; ++bj) { u32x4 pw;
#pragma unroll
                        for (int n = 0; n < 2; ++n) { const int o = (bj == 0 ? grow * 16 : 1024 + gcol * 16) + 4 * fq + 2 * n;
                            const f32x2 c2 = *(const PG8_LAS f32x2*)(lr + o), s2 = *(const PG8_LAS f32x2*)(lr + o + (bj == 0 ? 512 : 1024)); const f32x4 a = v[bj][n];
                            const float o0 = (a[0] * c2[0] - a[1] * s2[0]) * qscale, o1 = (a[0] * s2[0] + a[1] * c2[0]) * qscale, o2 = (a[2] * c2[1] - a[3] * s2[1]) * qscale, o3 = (a[2] * s2[1] + a[3] * c2[1]) * qscale;
                            if (n == 0) { pw.x = pk2(o0, o1); pw.y = pk2(o2, o3); } else { pw.z = pk2(o0, o1); pw.w = pk2(o2, o3); } }
                        stg16(dst + 32 * bj + 8 * fq, pw); }
                }
            }
    }
};

struct EpiGlu {
    static constexpr bool PERM = true, AFTER_DRAIN = false;
    const bf16_t* G; const float* bias; bf16_t* MIX;
    DI void operator()(const f32x4 (&acc)[2][2][4][2], const pg8::Unit& u, int wr, int wc, int fr, int fq) const {
        asm volatile("" : "+v"(fr), "+v"(fq));
        const int cb = u.pn * 256 + 32 * wc + 8 * fq, rb = u.pm * 256 + wr * 64 + fr;
        f32x4 bv[2][2]; u32x4 gw[2][4][2];
#pragma unroll
        for (int bj = 0; bj < 2; ++bj) { bv[bj][0] = ldg16f(bias + cb + 128 * bj); bv[bj][1] = ldg16f(bias + cb + 128 * bj + 4); }
#pragma unroll
        for (int ai = 0; ai < 2; ++ai)
#pragma unroll
            for (int m = 0; m < 4; ++m)
#pragma unroll
                for (int bj = 0; bj < 2; ++bj) gw[ai][m][bj] = ldg16(G + (size_t)(rb + 128 * ai + 16 * m) * 512 + cb + 128 * bj);
#pragma unroll
        for (int ai = 0; ai < 2; ++ai)
#pragma unroll
            for (int m = 0; m < 4; ++m)
#pragma unroll
                for (int bj = 0; bj < 2; ++bj) { const u32x4 g4 = gw[ai][m][bj];
                    const f32x4 v0 = acc[ai][bj][m][0] + bv[bj][0], v1 = acc[ai][bj][m][1] + bv[bj][1];
                    u32x4 o;
                    o.x = pk2(bflo(g4.x) * sigmoidf_(v0[0]), bfhi(g4.x) * sigmoidf_(v0[1])); o.y = pk2(bflo(g4.y) * sigmoidf_(v0[2]), bfhi(g4.y) * sigmoidf_(v0[3]));
                    o.z = pk2(bflo(g4.z) * sigmoidf_(v1[0]), bfhi(g4.z) * sigmoidf_(v1[1])); o.w = pk2(bflo(g4.w) * sigmoidf_(v1[2]), bfhi(g4.w) * sigmoidf_(v1[3]));
                    stg16(MIX + (size_t)(rb + 128 * ai + 16 * m) * 1024 + 512 + cb + 128 * bj, o); }
    }
};

struct EpiRes {
    static constexpr bool PERM = true, AFTER_DRAIN = false;
    const float* xa; const float* xb; const bf16_t* xh; bf16_t* Xo; const float* gate;
    DI void operator()(const f32x4 (&acc)[2][2][4][2], const pg8::Unit& u, int wr, int wc, int fr, int fq) const {
        asm volatile("" : "+v"(fr), "+v"(fq));
        const int j = u.pm < 32 ? 0 : 1 + ((u.pm - 32) >> 3);
        const int cb = u.pn * 256 + 32 * wc + 8 * fq, rb = u.pm * 256 + wr * 64 + fr;
        const float* gt = gate + j * 6144 + cb;
        f32x4 gv[2][2];
#pragma unroll
        for (int bj = 0; bj < 2; ++bj)
#pragma unroll
            for (int n = 0; n < 2; ++n) gv[bj][n] = ldg16f(gt + 128 * bj + 4 * n);
        if (xh) {
#pragma unroll
            for (int ai = 0; ai < 2; ++ai) {
                u32x4 xr[4][2];
#pragma unroll
                for (int m = 0; m < 4; ++m)
#pragma unroll
                    for (int bj = 0; bj < 2; ++bj) xr[m][bj] = ldg16(xh + (size_t)(rb + 128 * ai + 16 * m) * 1024 + cb + 128 * bj);
#pragma unroll
                for (int m = 0; m < 4; ++m)
#pragma unroll
                    for (int bj = 0; bj < 2; ++bj) { const u32x4 t = xr[m][bj];
                        const f32x4 x0 = (f32x4){bflo(t.x), bfhi(t.x), bflo(t.y), bfhi(t.y)} + gv[bj][0] * acc[ai][bj][m][0];
                        const f32x4 x1 = (f32x4){bflo(t.z), bfhi(t.z), bflo(t.w), bfhi(t.w)} + gv[bj][1] * acc[ai][bj][m][1];
                        u32x4 pw; pw.x = pk2(x0[0], x0[1]); pw.y = pk2(x0[2], x0[3]); pw.z = pk2(x1[0], x1[1]); pw.w = pk2(x1[2], x1[3]);
                        stg16(Xo + (size_t)(rb + 128 * ai + 16 * m) * 1024 + cb + 128 * bj, pw); }
            }
        } else {
            const float* xs = u.pm < 32 ? xa + (size_t)rb * 1024 : xb + (size_t)(rb - NCTX) * 1024;
#pragma unroll
            for (int ai = 0; ai < 2; ++ai) {
                f32x4 xr[4][2][2];
#pragma unroll
                for (int m = 0; m < 4; ++m)
#pragma unroll
                    for (int bj = 0; bj < 2; ++bj)
#pragma unroll
                        for (int n = 0; n < 2; ++n) xr[m][bj][n] = ldg16f(xs + (size_t)(128 * ai + 16 * m) * 1024 + cb + 128 * bj + 4 * n);
#pragma unroll
                for (int m = 0; m < 4; ++m)
#pragma unroll
                    for (int bj = 0; bj < 2; ++bj) { const f32x4 x0 = xr[m][bj][0] + gv[bj][0] * acc[ai][bj][m][0], x1 = xr[m][bj][1] + gv[bj][1] * acc[ai][bj][m][1];
                        u32x4 pw; pw.x = pk2(x0[0], x0[1]); pw.y = pk2(x0[2], x0[3]); pw.z = pk2(x1[0], x1[1]); pw.w = pk2(x1[2], x1[3]);
                        stg16(Xo + (size_t)(rb + 128 * ai + 16 * m) * 1024 + cb + 128 * bj, pw); }
            }
        }
    }
};

struct EpiFfn1 {
    static constexpr bool PERM = true, AFTER_DRAIN = false;
    bf16_t* ACT;
    DI void operator()(const f32x4 (&acc)[2][2][4][2], const pg8::Unit& u, int wr, int wc, int fr, int fq) const {
        asm volatile("" : "+v"(fr), "+v"(fq));
#pragma unroll
        for (int ai = 0; ai < 2; ++ai)
#pragma unroll
            for (int m = 0; m < 4; ++m) { const int row = u.pm * 256 + ai * 128 + wr * 64 + m * 16 + fr; const int a0 = u.pn * 128 + 32 * wc + 8 * fq;
                const f32x4 g0 = acc[ai][0][m][0], g1 = acc[ai][0][m][1], u0 = acc[ai][1][m][0], u1 = acc[ai][1][m][1];
                u32x4 o;
                o.x = pk2(g0[0] * sigmoidf_(g0[0]) * u0[0], g0[1] * sigmoidf_(g0[1]) * u0[1]); o.y = pk2(g0[2] * sigmoidf_(g0[2]) * u0[2], g0[3] * sigmoidf_(g0[3]) * u0[3]);
                o.z = pk2(g1[0] * sigmoidf_(g1[0]) * u1[0], g1[1] * sigmoidf_(g1[1]) * u1[1]); o.w = pk2(g1[2] * sigmoidf_(g1[2]) * u1[2], g1[3] * sigmoidf_(g1[3]) * u1[3]);
                *(u32x4*)(ACT + (size_t)row * 2816 + a0) = o; }
    }
};

struct ListOrder {
    int count, G, c, mode;
    DI bool next(int i, pg8::Unit& u) const {
        const int L0 = i * G + c; if (L0 >= count) return false;
        const int L = (L0 & 7) * (count >> 3) + (L0 >> 3);
        if (mode == 0) { const int pm = L >> 2, vn = L & 3; if (vn < 3) { u.pm = pm; u.pn = vn; } else { u.pm = 32 + (pm >> 1); u.pn = 3 + (pm & 1); } }
        else { u.pm = L >> 1; u.pn = 3 + (L & 1); }
        return true;
    }
    DI void a_ready(const pg8::Unit&) const {}
    DI void done(const pg8::Unit&) const {}
};

template <class Epi> DI void run_gemm(unsigned char* shm, const bf16_t* A, const bf16_t* Bt, int N, int K, const Epi& E, int wv) {
    pg8::Gemm g; g.A = A; g.Bt = Bt; g.M = NTOK; g.N = N; g.K = K;
    pg8::StaticOrder S; S.init(NTOK, N, (int)gridDim.x, (int)blockIdx.x);
    pg8::gemm_phase<Epi, pg8::StaticOrder, false>((PG8_LAS unsigned char*)shm, g, S, E, nullptr, wv);
}

DI void attn_item(const bf16_t* __restrict__ Q, const bf16_t* __restrict__ Kp, const bf16_t* __restrict__ Vp, int vld, int nkeys, int qtok0, int kvh, bf16_t* __restrict__ MIX, unsigned char* lds, int wv) {
    const int tid = ltid(wv), w = tid >> 6, lane = tid & 63, c = lane & 31, hh = lane >> 5;
    const int hq = kvh * 4 + (w & 3), qtok = qtok0 + 32 * (w >> 2) + c;
    bf16x8 qf[4];
#pragma unroll
    for (int s = 0; s < 4; ++s) qf[s] = __builtin_bit_cast(bf16x8, ldg16(Q + (size_t)qtok * 512 + hq * 64 + 16 * s + 8 * hh));
    unsigned char* Kb = lds; unsigned char* Vb = lds + 2 * 9216;
    const int srow = tid >> 3, sseg = tid & 7;
    const bf16_t* kg = Kp + (size_t)srow * 64 + sseg * 8;
    const bf16_t* vg = Vp + (size_t)srow * vld + sseg * 8;
    u32x4 kr = ldg16(kg), vr = ldg16(vg);
    *(u32x4*)(Kb + srow * 144 + sseg * 16) = kr;
    { u32x2* d = (u32x2*)(Vb + srow * 136 + sseg * 16); u32x2 a; a.x = vr.x; a.y = vr.y; u32x2 b; b.x = vr.z; b.y = vr.w; d[0] = a; d[1] = b; }
    __syncthreads();
    f32x16 ot[2];
#pragma unroll
    for (int i = 0; i < 16; ++i) { ot[0][i] = 0.f; ot[1][i] = 0.f; }
    float mrun = -1e30f, lsum = 0.f;
    const int nt = nkeys >> 6;
    for (int it = 0; it < nt; ++it) {
        const int cur = it & 1;
        if (it + 1 < nt) { kr = ldg16(kg + (size_t)(it + 1) * 4096); vr = ldg16(vg + (it + 1) * 64); }
        const unsigned char* kb = Kb + cur * 9216; const unsigned char* vb = Vb + cur * 8704;
        f32x16 st[2]; bf16x8 kf[2][4];
#pragma unroll
        for (int kt = 0; kt < 2; ++kt)
#pragma unroll
            for (int s = 0; s < 4; ++s) kf[kt][s] = *(const PG8_LAS bf16x8*)(const PG8_LAS unsigned char*)(kb + (32 * kt + c) * 144 + (16 * s + 8 * hh) * 2);
#pragma unroll
        for (int kt = 0; kt < 2; ++kt) {
#pragma unroll
            for (int i = 0; i < 16; ++i) st[kt][i] = 0.f;
#pragma unroll
            for (int s = 0; s < 4; ++s) st[kt] = mfma32p(kf[kt][s], qf[s], st[kt]); }
        float mx = fmaxf(fmaxf(st[0][0], st[0][1]), st[0][2]);
#pragma unroll
        for (int i = 3; i < 15; i += 2) mx = fmaxf(fmaxf(mx, st[0][i]), st[0][i + 1]);
        mx = fmaxf(mx, st[0][15]);
#pragma unroll
        for (int i = 0; i < 16; i += 2) mx = fmaxf(fmaxf(mx, st[1][i]), st[1][i + 1]);
        mx = fmaxf(mx, shx(mx, 32, lane));
        const float mnew = fmaxf(mrun, mx), alpha = __builtin_amdgcn_exp2f(mrun - mnew); mrun = mnew;
        f32x2 ps2 = (f32x2){0.f, 0.f}; const f32x2 mn2 = (f32x2){mnew, mnew};
#pragma unroll
        for (int kt = 0; kt < 2; ++kt)
#pragma unroll
            for (int i = 0; i < 16; i += 2) { f32x2 d = (f32x2){st[kt][i], st[kt][i + 1]} - mn2; f32x2 pp; pp.x = __builtin_amdgcn_exp2f(d.x); pp.y = __builtin_amdgcn_exp2f(d.y); st[kt][i] = pp.x; st[kt][i + 1] = pp.y; ps2 += pp; }
        const float ps = ps2.x + ps2.y;
        lsum = lsum * alpha + ps;
        if (__builtin_amdgcn_ballot_w64(alpha != 1.0f) != 0ull) {
#pragma unroll
            for (int i = 0; i < 16; ++i) { ot[0][i] *= alpha; ot[1][i] *= alpha; } }
        s16x4 vlo[2][2][2], vhi[2][2][2];
#pragma unroll
        for (int kt = 0; kt < 2; ++kt)
#pragma unroll
            for (int sp = 0; sp < 2; ++sp)
#pragma unroll
                for (int dt = 0; dt < 2; ++dt) { const PG8_LAS unsigned char* vrow = (const PG8_LAS unsigned char*)(vb + (32 * dt + c) * 136 + (32 * kt + 16 * sp + 4 * hh) * 2);
                    vlo[kt][sp][dt] = *(const PG8_LAS s16x4*)vrow; vhi[kt][sp][dt] = *(const PG8_LAS s16x4*)(vrow + 16); }
#pragma unroll
        for (int kt = 0; kt < 2; ++kt)
#pragma unroll
            for (int sp = 0; sp < 2; ++sp) {
                const bf16x8 pk = pack8(st[kt][8 * sp], st[kt][8 * sp + 1], st[kt][8 * sp + 2], st[kt][8 * sp + 3], st[kt][8 * sp + 4], st[kt][8 * sp + 5], st[kt][8 * sp + 6], st[kt][8 * sp + 7]);
#pragma unroll
                for (int dt = 0; dt < 2; ++dt) { const bf16x8 va = __builtin_shufflevector(vlo[kt][sp][dt], vhi[kt][sp][dt], 0, 1, 2, 3, 4, 5, 6, 7); ot[dt] = mfma32p(va, pk, ot[dt]); } }
        if (it + 1 < nt) { const int nx = cur ^ 1;
            *(u32x4*)(Kb + nx * 9216 + srow * 144 + sseg * 16) = kr;
            u32x2* d = (u32x2*)(Vb + nx * 8704 + srow * 136 + sseg * 16); u32x2 a; a.x = vr.x; a.y = vr.y; u32x2 b; b.x = vr.z; b.y = vr.w; d[0] = a; d[1] = b; }
        __syncthreads();
    }
    const float ltot = lsum + shx(lsum, 32, lane); const float inv = 1.0f / ltot;
    bf16_t* op = MIX + (size_t)qtok * 1024 + hq * 64;
#pragma unroll
    for (int dt = 0; dt < 2; ++dt)
#pragma unroll
        for (int g4 = 0; g4 < 4; ++g4) { u32x2 pw; pw.x = pk2(ot[dt][4 * g4] * inv, ot[dt][4 * g4 + 1] * inv); pw.y = pk2(ot[dt][4 * g4 + 2] * inv, ot[dt][4 * g4 + 3] * inv);
            stg8(op + 32 * dt + 8 * g4 + 4 * hh, pw); }
}

template <int DIR, bool FULL>
DI void ssm_pass(int layer, int pr, int g, const bf16_t* __restrict__ U, const bf16x8* __restrict__ Bm, const bf16x8* __restrict__ Cm, const float* __restrict__ lam,
                 const float* __restrict__ state_in, const float* sseg_r, float* sseg_w, float* YF, bf16_t* __restrict__ G, const float* __restrict__ dskip,
                 float* __restrict__ out_state, unsigned char* hl, int wv) {
    const int lane = ltid(wv) & 63, c = lane & 31, hh = lane >> 5, fr = lane & 15, kq = lane >> 4;
    const int ldg = (layer * 2 + DIR) * 32 + g;
    bf16x8 bm[4], cm[4];
#pragma unroll
    for (int i = 0; i < 4; ++i) { bm[i] = Bm[(ldg * 4 + i) * 64 + lane]; if (FULL) cm[i] = Cm[(ldg * 4 + i) * 64 + lane]; }
    const float l0r = lam[(ldg * 64 + c) * 2], l0i = lam[(ldg * 64 + c) * 2 + 1], l1r = lam[(ldg * 64 + 32 + c) * 2], l1i = lam[(ldg * 64 + 32 + c) * 2 + 1];
    const int s = 2 * pr + hh;
    float h0r = 0.f, h0i = 0.f, h1r = 0.f, h1i = 0.f;
    if (FULL && pr >= 16) {
        const int sl = s - 32, b = sl >> 3, seg = sl & 7;
        float a0r = l0r, a0i = l0i, a1r = l1r, a1i = l1i;
#pragma unroll
        for (int i = 0; i < 8; ++i) { const float t0 = a0r * a0r - a0i * a0i, t1 = 2.f * a0r * a0i; a0r = t0; a0i = t1; const float t2 = a1r * a1r - a1i * a1i, t3 = 2.f * a1r * a1i; a1r = t2; a1i = t3; }
        const float* si = state_in + ((((size_t)(b * 2 + layer) * 2 + DIR) * 2) * 32 + g) * 64;
        h0r = si[c]; h0i = si[2048 + c]; h1r = si[32 + c]; h1i = si[2048 + 32 + c];
        const int n = DIR == 0 ? seg : 7 - seg;
        for (int jj = 0; jj < n; ++jj) { const int j = DIR == 0 ? jj : 7 - jj;
            const float* sp = sseg_r + ((((size_t)(b * 8 + j) * 2 + DIR) * 32 + g) * 64) * 2;
            const float s0r = sp[c * 2], s0i = sp[c * 2 + 1], s1r = sp[(32 + c) * 2], s1i = sp[(32 + c) * 2 + 1];
            const float n0r = a0r * h0r - a0i * h0i + s0r, n0i = a0r * h0i + a0i * h0r + s0i; h0r = n0r; h0i = n0i;
            const float n1r = a1r * h1r - a1i * h1i + s1r, n1i = a1r * h1i + a1i * h1r + s1i; h1r = n1r; h1i = n1i; }
    }
    const int seq_r = (c >> 2) & 1, q_r = (c & 3) + 4 * (c >> 3);
    const bf16_t* ua_ptr = U + ((size_t)((2 * pr + seq_r) * 256 + q_r)) * 512 + g * 16 + 8 * hh;
    f32x16 zero16;
#pragma unroll
    for (int i = 0; i < 16; ++i) zero16[i] = 0.f;
    auto ldu = [&](int ch) -> bf16x8 { return __builtin_bit_cast(bf16x8, ldg16(ua_ptr + (size_t)(DIR ? 240 - 16 * ch : 16 * ch) * 512)); };
    auto body = [&](const bf16x8 ua, int ch) {
        const int cb = DIR ? 240 - 16 * ch : 16 * ch;
        f32x16 x[4];
#pragma unroll
        for (int i = 0; i < 4; ++i) x[i] = mfma32(ua, bm[i], zero16);
#pragma unroll
        for (int i = 0; i < 16; ++i) { const int reg = DIR ? 15 - i : i;
            const float n0r = __builtin_fmaf(l0r, h0r, __builtin_fmaf(-l0i, h0i, x[0][reg])), n0i = __builtin_fmaf(l0r, h0i, __builtin_fmaf(l0i, h0r, x[1][reg])); h0r = n0r; h0i = n0i;
            const float n1r = __builtin_fmaf(l1r, h1r, __builtin_fmaf(-l1i, h1i, x[2][reg])), n1i = __builtin_fmaf(l1r, h1i, __builtin_fmaf(l1i, h1r, x[3][reg])); h1r = n1r; h1i = n1i;
            if (FULL) { unsigned* hrow = (unsigned*)(hl + (hh * 16 + reg) * 272); hrow[c] = pk2(h0r, h0i); hrow[32 + c] = pk2(h1r, h1i); } }
        if (FULL) {
#pragma unroll
            for (int sq = 0; sq < 2; ++sq) { f32x4 y = (f32x4){0.f, 0.f, 0.f, 0.f};
#pragma unroll
                for (int ks = 0; ks < 4; ++ks) { const bf16x8 af = *(const bf16x8*)(hl + (sq * 16 + fr) * 272 + (32 * ks + 8 * kq) * 2); y = mfma16(cm[ks], af, y); }
                { u32x2 pw; pw.x = pk2(y[0], y[1]); pw.y = pk2(y[2], y[3]); stg8((bf16_t*)YF + ((size_t)((2 * pr + sq) * 256 + cb + fr)) * 512 + g * 16 + 4 * kq, pw); } }
        }
    };
    bf16x8 u0 = ldu(0), u1 = ldu(1), u2 = ldu(2), u3 = ldu(3);
#pragma unroll 1
    for (int c4 = 0; c4 < 16; c4 += 4) {
        const bool more = c4 + 4 < 16;
        body(u0, c4);     if (more) u0 = ldu(c4 + 4);
        body(u1, c4 + 1); if (more) u1 = ldu(c4 + 5);
        body(u2, c4 + 2); if (more) u2 = ldu(c4 + 6);
        body(u3, c4 + 3); if (more) u3 = ldu(c4 + 7);
    }
    if (FULL) { if (pr < 16) { float* os = out_state + ((((size_t)(s * 2 + layer) * 2 + DIR) * 2) * 32 + g) * 64; os[c] = h0r; os[2048 + c] = h0i; os[32 + c] = h1r; os[2048 + 32 + c] = h1i; } }
    else { float* sw = sseg_w + ((((size_t)(s - 32) * 2 + DIR) * 32 + g) * 64) * 2; sw[c * 2] = h0r; sw[c * 2 + 1] = h0i; sw[(32 + c) * 2] = h1r; sw[(32 + c) * 2 + 1] = h1i; }
}

#define XB_TMO      128
#define XB_XCNT(j)  (256  + 64 * (j))
#define XB_XSUB(j)  (1280 + 64 * (j))
#define XB_XGEN(j)  (2304 + 64 * (j))
#define XB_TOP      3328
#define XB_TOPGEN   3392
#define XCD_BAR_WORDS 3456
#define XB_SPIN_CAP (1u << 18)
#define LAS __attribute__((address_space(3)))

__device__ __forceinline__ unsigned xb_ld(unsigned* p)              { return __hip_atomic_load(p, __ATOMIC_RELAXED, __HIP_MEMORY_SCOPE_AGENT); }
__device__ __forceinline__ unsigned xb_add(unsigned* p, unsigned v) { return __hip_atomic_fetch_add(p, v, __ATOMIC_RELAXED, __HIP_MEMORY_SCOPE_AGENT); }
__device__ __forceinline__ unsigned xb_xcc_id() { return (unsigned)__builtin_amdgcn_s_getreg((3 << 11) | 20) & 0xFu; }
#define XB_SPIN(cond, bar) do { unsigned _sp = 0; while (cond) { __builtin_amdgcn_s_sleep(1); \
    if ((++_sp & 255u) == 0u) { if (xb_ld(&(bar)[XB_TMO])) break; if (_sp > XB_SPIN_CAP) { atomicAdd(&(bar)[XB_TMO], 1u); break; } } } } while (0)

struct XcdBarrier {
    unsigned* bar; unsigned x;
    volatile LAS unsigned* st;
};

__device__ __forceinline__ XcdBarrier xcd_barrier_post(unsigned* bar, volatile LAS unsigned* st) {
    XcdBarrier b; b.bar = bar; b.x = xb_xcc_id(); b.st = st;
    if (threadIdx.x == 0) (void)xb_add(&bar[XB_XCNT(b.x)], 1u);
    return b;
}
__device__ __forceinline__ void xcd_barrier_complete(unsigned* bar, unsigned x, unsigned& nloc, unsigned& nx) {
    const unsigned G = gridDim.x * gridDim.y * gridDim.z;
    unsigned sum, cnt, mine, sp = 0u;
    for (;;) {
        sum = 0u; cnt = 0u; mine = 0u;
#pragma unroll
        for (unsigned j = 0; j < 16; ++j) { const unsigned c = xb_ld(&bar[XB_XCNT(j)]); sum += c; cnt += (c > 0u) ? 1u : 0u; mine = (j == x) ? c : mine; }
        if (sum == G) break;
        __builtin_amdgcn_s_sleep(1);
        if ((++sp & 255u) == 0u) { if (xb_ld(&bar[XB_TMO])) break; if (sp > XB_SPIN_CAP) { atomicAdd(&bar[XB_TMO], 1u); break; } }
    }
    nloc = mine > 0u ? mine : 1u; nx = cnt > 0u ? cnt : 1u;
}

__device__ __forceinline__ void xcd_barrier(const XcdBarrier& b) {
    asm volatile("s_waitcnt vmcnt(0)" ::: "memory");
    __syncthreads();
    if (threadIdx.x == 0) {
        unsigned* bar = b.bar;
        __builtin_amdgcn_s_waitcnt(0);
        unsigned nloc = b.st[0], nx = b.st[1];
        if (nloc == 0u) { xcd_barrier_complete(bar, b.x, nloc, nx); b.st[0] = nloc; b.st[1] = nx; }
        const unsigned old = xb_add(&bar[XB_XSUB(b.x)], 1u);
        const unsigned gen = old / nloc;
        if (old + 1u == (gen + 1u) * nloc) {
            __builtin_amdgcn_fence(__ATOMIC_RELEASE, "agent");
            asm volatile("s_waitcnt vmcnt(0)" ::: "memory");
            const unsigned og = xb_add(&bar[XB_TOP], 1u);
            const unsigned tg = og / nx;
            if (og + 1u == (tg + 1u) * nx) xb_add(&bar[XB_TOPGEN], 1u);
            else XB_SPIN(xb_ld(&bar[XB_TOPGEN]) == tg, bar);
            __builtin_amdgcn_fence(__ATOMIC_ACQUIRE, "agent");
            xb_add(&bar[XB_XGEN(b.x)], 1u);
            asm volatile("s_waitcnt vmcnt(0)" ::: "memory");
        } else {
            XB_SPIN(xb_ld(&bar[XB_XGEN(b.x)]) == gen, bar);
            __builtin_amdgcn_fence(__ATOMIC_ACQUIRE, "agent");
            asm volatile("s_waitcnt vmcnt(0)" ::: "memory");
        }
    }
    __syncthreads();
}


typedef const __attribute__((address_space(4))) Params* KParamsPtr;
DI KParamsPtr kparams() { KParamsPtr p = (KParamsPtr)__builtin_amdgcn_kernarg_segment_ptr(); asm volatile("" : "+s"(p)); return p; }
#define PKP (kparams())
__global__ __launch_bounds__(512, 2) void mega_fwd(Params P) {
    extern __shared__ __attribute__((aligned(16))) unsigned char shm[];
    cg::grid_group grid = cg::this_grid();
#define WSP_ (opaque_ptr(PKP->ws))
#define XP_ ((float*)opaque_ptr((unsigned char*)PKP->out))
#define MODS_ ((const float*)(WSP_ + WS_MODS))
#define HB_ ((bf16_t*)(WSP_ + WS_H))
#define YFP_ ((float*)(WSP_ + WS_H))
#define QB_ ((bf16_t*)(WSP_ + WS_Q))
#define UB_ ((bf16_t*)(WSP_ + WS_U))
#define MIXB_ ((bf16_t*)(WSP_ + WS_MIX))
#define GB_ ((bf16_t*)(WSP_ + WS_G))
#define ACTB_ ((bf16_t*)(WSP_ + WS_ACT))
#define KCTX_ ((bf16_t*)(WSP_ + WS_KCTX))
#define VCTX_ ((bf16_t*)(WSP_ + WS_VCTX))
    const int w = __builtin_amdgcn_readfirstlane(threadIdx.x >> 6);
    if (PKP->ws == nullptr) grid.sync();
    if (threadIdx.x == 0) { ((volatile LAS unsigned*)(shm + 131072))[0] = 0u; ((volatile LAS unsigned*)(shm + 131072))[1] = 0u; }
    __syncthreads();
    (void)xcd_barrier_post((unsigned*)(WSP_ + WS_BAR), (volatile LAS unsigned*)(shm + 131072));
#define GSYNC() do { XcdBarrier b_; b_.bar = (unsigned*)(opaque_ptr(PKP->ws) + WS_BAR); b_.x = xb_xcc_id(); b_.st = (volatile LAS unsigned*)(shm + 131072); xcd_barrier(b_); } while (0)

    { Params Pl; for (int i = 0; i < 28; ++i) Pl.in[i] = PKP->in[i]; Pl.out = PKP->out; Pl.ws = PKP->ws; phase0(Pl, shm, w); }
    GSYNC();
    { const int tid = ltid(w); const float* rcg = (const float*)(WSP_ + WS_ROPEC); const float* rsg = (const float*)(WSP_ + WS_ROPES); float* lrw = (float*)(shm + LDS_ROPE);
      { const int e = tid, r = e >> 4, i = e & 15; lrw[e] = rcg[(64 * r) * 32 + i]; lrw[512 + e] = rsg[(64 * r) * 32 + i]; }
      for (int e = tid; e < 1024; e += 512) { const int cidx = e >> 4, i = e & 15; lrw[1024 + e] = rcg[cidx * 32 + 16 + i]; lrw[2048 + e] = rsg[cidx * 32 + 16 + i]; }
      __syncthreads(); }
#pragma unroll 1
    for (int l = 0; l < 2; ++l) {
#define MODSL_ (MODS_ + l * 5 * 6144)
#define XA_ (PKP->in[0])
#define XH_ ((bf16_t*)(WSP_ + WS_XB))
#define XB_ (PKP->in[1])
#define KLAT_ ((bf16_t*)(WSP_ + WS_KLAT + l * SZ_KLAT))
#define VLAT_ ((bf16_t*)(WSP_ + WS_VLAT + l * SZ_KLAT))
        if (l == 0) {
            const int tid = ltid(w); const float* part = (const float*)(WSP_ + WS_MODP); const float* bm_ = PKP->in[8]; float* mw = (float*)(WSP_ + WS_MODS); float* ldsf = (float*)opaque_ptr(shm);
            for (int idx = blockIdx.x * 512 + tid; idx < 61440; idx += gridDim.x * 512) { const int ll = idx / 30720, n = idx % 6144;
                mw[idx] = part[idx] + part[61440 + idx] + part[2 * 61440 + idx] + part[3 * 61440 + idx] + bm_[ll * 6144 + n]; }
#pragma unroll
            for (int it = 0; it < 20; ++it) { const int e = it * 512 + tid; const int j = e >> 11, r = e & 2047; const int idx = j * 6144 + r;
                ldsf[e] = part[idx] + part[61440 + idx] + part[2 * 61440 + idx] + part[3 * 61440 + idx] + bm_[r]; }
            __syncthreads();
            for (int rep = 0; rep < REP_NORM; ++rep) norm_phase(XA_, XB_, nullptr, PKP->in[9], ldsf, 2048, 0, 1024, HB_, w);
        } else
        for (int rep = 0; rep < REP_NORM; ++rep) norm_phase(XA_, XB_, XH_, PKP->in[9] + l * 1024, MODSL_, 6144, 0, 1024, HB_, w);
        GSYNC();
        { EpiIn E; E.layer = l; E.qn = PKP->in[12] + l * 64; E.kn = PKP->in[13] + l * 64; E.lr = (const PG8_LAS float*)(shm + LDS_ROPE);
          E.Q = QB_; E.U = UB_; E.Kctx = KCTX_; E.Vctx = VCTX_; E.Klat = KLAT_; E.Vlat = VLAT_; E.outk = PKP->out + OUT_K; E.outv = PKP->out + OUT_V;
          { pg8::Gemm g; g.A = HB_; g.Bt = (const bf16_t*)(WSP_ + WS_WIN + l * SZ_WIN); g.M = NTOK; g.N = 1280; g.K = 1024;
            ListOrder S; S.count = 256; S.G = (int)gridDim.x; S.c = (int)blockIdx.x; S.mode = 0;
            pg8::gemm_phase<EpiIn, ListOrder, false>((PG8_LAS unsigned char*)shm, g, S, E, nullptr, w); }
          GSYNC();
          { pg8::Gemm g; g.A = HB_; g.Bt = (const bf16_t*)(WSP_ + WS_WIN + l * SZ_WIN); g.M = NTOK; g.N = 1280; g.K = 1024;
            ListOrder S; S.count = 64; S.G = (int)gridDim.x; S.c = (int)blockIdx.x; S.mode = 1;
            pg8::gemm_phase<EpiIn, ListOrder, false>((PG8_LAS unsigned char*)shm, g, S, E, nullptr, w); } }
        { const int nb = gridDim.x > 64 ? 64 : 0;
          if ((int)blockIdx.x >= nb)
          for (int it = blockIdx.x - nb; it < 384; it += gridDim.x - nb) {
            __syncthreads();
            if (it < 256) { const int qc = it & 3, kvh = (it >> 2) & 1, b = it >> 3;
                attn_item(QB_, KCTX_ + ((size_t)(b * 2 + kvh) * 256) * 64, VCTX_ + ((size_t)(b * 2 + kvh) * 64) * 256, 256, 256, b * 256 + qc * 64, kvh, MIXB_, shm, w); }
            else { const int wi = (it - 256) * 8 + w; const int dir = wi & 1, g = (wi >> 1) & 31, pr = 16 + (wi >> 6);
                if (dir == 0) ssm_pass<0, false>(l, pr, g, UB_, (const bf16x8*)(WSP_ + WS_SSMB), (const bf16x8*)(WSP_ + WS_SSMC), (const float*)(WSP_ + WS_SSML), PKP->in[4], nullptr, (float*)(WSP_ + WS_SSEG), nullptr, nullptr, nullptr, nullptr, nullptr, w);
                else ssm_pass<1, false>(l, pr, g, UB_, (const bf16x8*)(WSP_ + WS_SSMB), (const bf16x8*)(WSP_ + WS_SSMC), (const float*)(WSP_ + WS_SSML), PKP->in[4], nullptr, (float*)(WSP_ + WS_SSEG), nullptr, nullptr, nullptr, nullptr, nullptr, w); }
          } }
        GSYNC();
        for (int rep = 0; rep < REP_ATT4; ++rep)
        for (int it = blockIdx.x; it < 512; it += gridDim.x) {
            __syncthreads();
            if (it < 256) { const int qc = it >> 3, kvh = it & 1, b = (it >> 1) & 3;
                attn_item(QB_, KLAT_ + ((size_t)(b * 2 + kvh) * 2560) * 64, VLAT_ + ((size_t)(b * 2 + kvh) * 64) * 2560, 2560, 2560, NCTX + b * 2048 + qc * 64, kvh, MIXB_, shm, w); }
            else { const int si = it - 256, pr = si >> 3, gq = si & 7, g = gq * 4 + (w & 3);
                if (w < 4) ssm_pass<0, true>(l, pr, g, UB_, (const bf16x8*)(WSP_ + WS_SSMB), (const bf16x8*)(WSP_ + WS_SSMC), (const float*)(WSP_ + WS_SSML), PKP->in[4], (const float*)(WSP_ + WS_SSEG), nullptr, YFP_, nullptr, nullptr, PKP->out + OUT_S, shm + w * 8704, w);
                else ssm_pass<1, true>(l, pr, g, UB_, (const bf16x8*)(WSP_ + WS_SSMB), (const bf16x8*)(WSP_ + WS_SSMC), (const float*)(WSP_ + WS_SSML), PKP->in[4], (const float*)(WSP_ + WS_SSEG), nullptr, (float*)(WSP_ + WS_YB), nullptr, nullptr, PKP->out + OUT_S, shm + w * 8704, w);
                __syncthreads();
                { const int tid = ltid(w); const float* YBp = (const float*)(WSP_ + WS_YB); const float* dsk = PKP->in[21] + l * 512;
#pragma unroll 4
                  for (int i = 0; i < 8; ++i) { const int idx = i * 512 + tid, tk = pr * 512 + (idx >> 3), ch = gq * 64 + (idx & 7) * 8; const size_t o = (size_t)tk * 512 + ch;
                      const u32x4 yfw = *(const u32x4*)((const bf16_t*)YFP_ + o), ybw = *(const u32x4*)((const bf16_t*)YBp + o), uw = *(const u32x4*)(UB_ + o); const f32x4 d0 = *(const f32x4*)(dsk + ch), d1 = *(const f32x4*)(dsk + ch + 4);
                      const f32x2 g0 = gelu_pk((f32x2){bflo(yfw.x) + bflo(ybw.x) + d0[0] * bflo(uw.x), bfhi(yfw.x) + bfhi(ybw.x) + d0[1] * bfhi(uw.x)});
                      const f32x2 g1 = gelu_pk((f32x2){bflo(yfw.y) + bflo(ybw.y) + d0[2] * bflo(uw.y), bfhi(yfw.y) + bfhi(ybw.y) + d0[3] * bfhi(uw.y)});
                      const f32x2 g2 = gelu_pk((f32x2){bflo(yfw.z) + bflo(ybw.z) + d1[0] * bflo(uw.z), bfhi(yfw.z) + bfhi(ybw.z) + d1[1] * bfhi(uw.z)});
                      const f32x2 g3 = gelu_pk((f32x2){bflo(yfw.w) + bflo(ybw.w) + d1[2] * bflo(uw.w), bfhi(yfw.w) + bfhi(ybw.w) + d1[3] * bfhi(uw.w)});
                      u32x4 pw; pw.x = pk2(g0.x, g0.y); pw.y = pk2(g1.x, g1.y); pw.z = pk2(g2.x, g2.y); pw.w = pk2(g3.x, g3.y); *(u32x4*)(GB_ + o) = pw; } } }
        }
        GSYNC();
        { EpiGlu E; E.G = GB_; E.bias = PKP->in[23] + l * 512; E.MIX = MIXB_; for (int rep = 0; rep < REP_GLU; ++rep) run_gemm(shm, GB_, (const bf16_t*)(WSP_ + WS_WGLU + l * SZ_WGLU), 512, 512, E, w); }
        GSYNC();
        { EpiRes E; E.xa = XA_; E.xb = XB_; E.xh = l == 0 ? nullptr : XH_; E.Xo = XH_; E.gate = MODSL_ + 2 * 1024; run_gemm(shm, MIXB_, (const bf16_t*)(WSP_ + WS_WOUT + l * SZ_WOUT), 1024, 1024, E, w); }
        GSYNC();
        for (int rep = 0; rep < REP_NORM; ++rep) norm_phase(XA_, XB_, XH_, PKP->in[10] + l * 1024, MODSL_, 6144, 3 * 1024, 4 * 1024, HB_, w);
        GSYNC();
        { EpiFfn1 E; E.ACT = ACTB_; for (int rep = 0; rep < REP_F1; ++rep) run_gemm(shm, HB_, (const bf16_t*)(WSP_ + WS_WF1 + l * SZ_WF1), 5632, 1024, E, w); }
        GSYNC();
        { EpiRes E; E.xa = XA_; E.xb = XB_; E.xh = XH_; E.Xo = XH_; E.gate = MODSL_ + 5 * 1024; run_gemm(shm, ACTB_, (const bf16_t*)(WSP_ + WS_WF2 + l * SZ_WF2), 1024, 2816, E, w); }
        GSYNC();
    }
    final_norm_phase(XH_, XP_, PKP->in[27], w);
}
#undef WSP_
#undef XP_
#undef MODS_
#undef HB_
#undef YFP_
#undef QB_
#undef UB_
#undef MIXB_
#undef GB_
#undef ACTB_
#undef KCTX_
#undef VCTX_
#undef MODSL_
#undef XA_
#undef XH_
#undef XB_
#undef KLAT_
#undef VLAT_

extern "C" void kernel_launch(void* const* d_in, const int* in_sizes, int n_in, void* d_out, int out_size, void* d_ws, size_t ws_size, hipStream_t stream) {
    static int grid_blocks = 0;
    if (grid_blocks == 0) {
        if (n_in < 28 || ws_size < WS_END) { fprintf(stderr, "kernel_launch: need 28 inputs and %zu bytes of workspace (got %d, %zu)\n", (size_t)WS_END, n_in, ws_size); grid_blocks = -1; return; }
        int dev = 0, cus = 0, per_cu = 0;
        (void)hipGetDevice(&dev);
        (void)hipDeviceGetAttribute(&cus, hipDeviceAttributeMultiprocessorCount, dev);
        if (hipFuncSetAttribute((const void*)mega_fwd, hipFuncAttributeMaxDynamicSharedMemorySize, LDS_BYTES) != hipSuccess) fprintf(stderr, "kernel_launch: hipFuncSetAttribute failed\n");
        if (hipOccupancyMaxActiveBlocksPerMultiprocessor(&per_cu, (const void*)mega_fwd, 512, LDS_BYTES) != hipSuccess || per_cu < 1) { per_cu = 1; (void)hipGetLastError(); }
        if (per_cu > 1) per_cu = 1;
        grid_blocks = cus * per_cu;
    }
    if (grid_blocks < 0) return;
    (void)hipMemsetAsync((unsigned char*)d_ws + WS_BAR, 0, SZ_BAR, stream);
    Params p{};
    for (int i = 0; i < 28; ++i) p.in[i] = (const float*)d_in[i];
    p.out = (float*)d_out; p.ws = (unsigned char*)d_ws;
    void* args[] = {&p};
    hipError_t e = hipLaunchCooperativeKernel((const void*)mega_fwd, dim3(grid_blocks), dim3(512), args, LDS_BYTES, stream);
    if (e != hipSuccess) fprintf(stderr, "cooperative launch failed: %s (grid %d)\n", hipGetErrorString(e), grid_blocks);
}
```

```cpp
#include <hip/hip_runtime.h>
#include <hip/hip_cooperative_groups.h>
#include <cstdio>
namespace cg = cooperative_groups;
#define DI __device__ __forceinline__
DI unsigned char* opaque_ptr(unsigned char* p) { asm volatile("" : "+s"(p)); return p; }
DI float shx(float v, int m, int lane) { return __int_as_float(__builtin_amdgcn_ds_bpermute((lane ^ m) << 2, __float_as_int(v))); }
DI int lane_now() { int l; asm volatile("v_mbcnt_lo_u32_b32 %0, -1, 0\n\tv_mbcnt_hi_u32_b32 %0, -1, %0" : "=v"(l)); return l; }
DI int ltid(int wv) { return wv * 64 + lane_now(); }

namespace pg8 {
#define PG8_LAS __attribute__((address_space(3)))
typedef unsigned short bf16_t;
typedef short bf16x8 __attribute__((ext_vector_type(8)));
typedef float f32x4 __attribute__((ext_vector_type(4)));
typedef unsigned u32x4 __attribute__((ext_vector_type(4)));
constexpr int BM = 256, BK = 64, HALF = 128, HTB = HALF * BK * 2  , STAGE_BYTES = 8 * HTB, NXCD = 8, WGM = 1;

__host__ __device__ __forceinline__ int lds_byte(int r, int c) { const int st = (r >> 4) * 2 + (c >> 5), rr = r & 15, cc = c & 31, ob = rr * 64 + cc * 2; return st * 1024 + (ob ^ (((ob >> 9) & 1) << 5)); }
__host__ __device__ __forceinline__ void stage_rc(int b, int& R, int& C) { const int st = b / 1024, sb = b % 1024, swz = sb ^ (((sb >> 9) & 1) << 5); R = (st >> 1) * 16 + swz / 64; C = (st & 1) * 32 + (swz % 64) / 2; }
__host__ __device__ __forceinline__ int perm32(int rho) { const int n = rho >> 4, i = rho & 15; return 8 * (i >> 2) + 4 * n + (i & 3); }

struct Unit { int pm, pn; };
struct Gemm { const bf16_t* A; const bf16_t* Bt; int M, N, K; };

struct StaticOrder {
    int nM, nN, nwg, G, c;
    __host__ __device__ void init(int M, int N, int G_, int c_) { nM = M / BM; nN = N / BM; nwg = nM * nN; G = G_; c = c_; }
    __host__ __device__ bool next(int i, Unit& u) const {
        const long L = (long)i * G + c; if (L >= nwg) return false;
        int wgid = (int)L; { const int q = nwg / NXCD, r = nwg % NXCD, xcd = wgid % NXCD, off = wgid / NXCD; wgid = (xcd < r ? xcd * (q + 1) : r * (q + 1) + (xcd - r) * q) + off; }
        const int nig = WGM * nN, gid = wgid / nig, fm = gid * WGM, gsz = (nM - fm) < WGM ? (nM - fm) : WGM;
        u.pm = fm + ((wgid % nig) % gsz); u.pn = (wgid % nig) / gsz; return true;
    }
    __device__ __forceinline__ void a_ready(const Unit&) const {}
    __device__ __forceinline__ void done(const Unit&) const {}
};

template <class Epi, class Sched, bool STAMP = false>
__device__ __forceinline__ void gemm_phase(PG8_LAS unsigned char* lds, const Gemm g, const Sched& S, const Epi& E, unsigned long long* stamps, int wv) {
    int tid_l; asm volatile("v_mbcnt_lo_u32_b32 %0, -1, 0\n\tv_mbcnt_hi_u32_b32 %0, -1, %0" : "=v"(tid_l)); tid_l += wv * 64;
    const int tid = tid_l, wid = __builtin_amdgcn_readfirstlane(tid >> 6), lane = tid & 63, wr = wid >> 2, wc = wid & 3, fr = lane & 15, fq = lane >> 4;
    const int K = g.K, nt = K / BK;
    int ts_lo = 0, ts_hi = 0, nts = 0; const unsigned long long rt_entry = STAMP ? (unsigned long long)wall_clock64() : 0ull;
#define PG8_STAMP() do { if (STAMP && wid == 0 && nts < 64) { const unsigned long long _c = (unsigned long long)clock64(); \
        ts_lo = (lane == nts) ? (int)(unsigned)_c : ts_lo; ts_hi = (lane == nts) ? (int)(unsigned)(_c >> 32) : ts_hi; ++nts; } } while (0)
    PG8_STAMP();
    unsigned voffA[2], voffB[2];
#pragma unroll
    for (int i = 0; i < 2; ++i) { int R, C; stage_rc(tid * 16 + i * 8192, R, C); const int Rb = Epi::PERM ? ((R & ~31) + perm32(R & 31)) : R;
        voffA[i] = (unsigned)(R * K + C) * 2u; voffB[i] = (unsigned)(Rb * K + C) * 2u; }
    const size_t kstep = (size_t)(BK * 2);
    const size_t hstep = (size_t)HALF * K * 2;
    const size_t tstep = 2 * hstep;
    const unsigned ldsw = (unsigned)wid * 1024u;
    const int aoff = lds_byte(wr * 64 + fr, fq * 8), boff = lds_byte(wc * 32 + fr, fq * 8);
#define PG8_SA(b, h) (((b) * 2 + (h)) * HTB)
#define PG8_SB(b, h) ((4 + (b) * 2 + (h)) * HTB)
#define PG8_STAGE(bufoff, gbase, voff) do { _Pragma("unroll") for (int _i = 0; _i < 2; ++_i) \
        __builtin_amdgcn_global_load_lds((const unsigned*)((const char*)(gbase) + (voff)[_i]), (PG8_LAS unsigned*)(lds + (bufoff) + ldsw + _i * 8192), 16, 0, 0); } while (0)
#define PG8_LDA(dst, b, h) do { _Pragma("unroll") for (int m = 0; m < 4; ++m) _Pragma("unroll") for (int k = 0; k < 2; ++k) dst[m][k] = *(const PG8_LAS bf16x8*)(lds + PG8_SA(b, h) + aoff + m * 2048 + k * 1024); } while (0)
#define PG8_LDB(dst, b, h) do { _Pragma("unroll") for (int n = 0; n < 2; ++n) _Pragma("unroll") for (int k = 0; k < 2; ++k) dst[n][k] = *(const PG8_LAS bf16x8*)(lds + PG8_SB(b, h) + boff + n * 2048 + k * 1024); } while (0)
#define PG8_MMA(ai, bj, At, Bt) do { __builtin_amdgcn_s_setprio(1); _Pragma("unroll") for (int m = 0; m < 4; ++m) _Pragma("unroll") for (int n = 0; n < 2; ++n) _Pragma("unroll") for (int k = 0; k < 2; ++k) \
        acc[ai][bj][m][n] = __builtin_amdgcn_mfma_f32_16x16x32_bf16(Bt[n][k], At[m][k], acc[ai][bj][m][n], 0, 0, 0); __builtin_amdgcn_s_setprio(0); } while (0)
#define PG8_WAIT_V(n) asm volatile("s_waitcnt vmcnt(" #n ")" ::: "memory")
#define PG8_WAIT_L(n) asm volatile("s_waitcnt lgkmcnt(" #n ")" ::: "memory")
#define PG8_BAR __builtin_amdgcn_s_barrier()
#define PG8_SCHED __builtin_amdgcn_sched_barrier(0)
    Unit cur, nxt; int ui = 0;
    if (!S.next(0, cur)) return;
    f32x4 acc[2][2][4][2];
#pragma unroll
    for (int a = 0; a < 2; ++a)
#pragma unroll
        for (int b = 0; b < 2; ++b)
#pragma unroll
            for (int m = 0; m < 4; ++m)
#pragma unroll
                for (int n = 0; n < 2; ++n) acc[a][b][m][n] = (f32x4){0.f, 0.f, 0.f, 0.f};
    bf16x8 At[4][2], B0[2][2], B1[2][2];
    const char* cA = (const char*)g.A + (size_t)cur.pm * tstep; const char* cB = (const char*)g.Bt + (size_t)cur.pn * tstep;
    S.a_ready(cur);
    PG8_STAGE(PG8_SB(0, 0), cB, voffB); PG8_STAGE(PG8_SA(0, 0), cA, voffA); PG8_STAGE(PG8_SB(0, 1), cB + hstep, voffB); PG8_STAGE(PG8_SA(0, 1), cA + hstep, voffA);
    if (wr == 1) PG8_BAR;
    PG8_WAIT_V(4); PG8_BAR;
    PG8_STAGE(PG8_SB(1, 0), cB + kstep, voffB); PG8_STAGE(PG8_SA(1, 0), cA + kstep, voffA); PG8_STAGE(PG8_SB(1, 1), cB + hstep + kstep, voffB);
    PG8_WAIT_V(6); PG8_BAR;
    PG8_STAMP();
    for (;;) {
        const bool has_next = S.next(ui + 1, nxt);
        const char* nA = has_next ? (const char*)g.A + (size_t)nxt.pm * tstep : cA; const char* nB = has_next ? (const char*)g.Bt + (size_t)nxt.pn * tstep : cB;
        for (int t = 0; t < nt; t += 2) {
            const bool last = (t == nt - 2);
            const char* a1 = cA + (size_t)(t + 1) * kstep;
            const char* a2 = last ? nA : cA + (size_t)(t + 2) * kstep; const char* b2 = last ? nB : cB + (size_t)(t + 2) * kstep;
            const char* a3 = a2 + kstep; const char* b3 = b2 + kstep;
            if (last && has_next) S.a_ready(nxt);
            PG8_LDB(B0, 0, 0); PG8_SCHED; PG8_LDA(At, 0, 0); PG8_STAGE(PG8_SA(1, 1), a1 + hstep, voffA);
            PG8_WAIT_L(8); PG8_BAR; PG8_WAIT_L(0); PG8_MMA(0, 0, At, B0); PG8_BAR; PG8_SCHED;
            PG8_LDB(B1, 0, 1); PG8_STAGE(PG8_SB(0, 0), b2, voffB);
            PG8_BAR; PG8_WAIT_L(0); PG8_MMA(0, 1, At, B1); PG8_BAR;
            PG8_LDA(At, 0, 1); PG8_STAGE(PG8_SA(0, 0), a2, voffA);
            PG8_BAR; PG8_WAIT_L(0); PG8_MMA(1, 0, At, B0); PG8_BAR; PG8_SCHED;
            PG8_STAGE(PG8_SB(0, 1), b2 + hstep, voffB);
            PG8_WAIT_V(6); PG8_BAR; PG8_MMA(1, 1, At, B1); PG8_BAR;
            PG8_LDB(B0, 1, 0); PG8_SCHED; PG8_LDA(At, 1, 0); PG8_STAGE(PG8_SA(0, 1), a2 + hstep, voffA);
            PG8_WAIT_L(8); PG8_BAR; PG8_WAIT_L(0); PG8_MMA(0, 0, At, B0); PG8_BAR; PG8_SCHED;
            PG8_LDB(B1, 1, 1); PG8_STAGE(PG8_SB(1, 0), b3, voffB);
            PG8_BAR; PG8_WAIT_L(0); PG8_MMA(0, 1, At, B1); PG8_BAR;
            PG8_LDA(At, 1, 1); PG8_STAGE(PG8_SA(1, 0), a3, voffA);
            PG8_BAR; PG8_WAIT_L(0); PG8_MMA(1, 0, At, B0); PG8_BAR; PG8_SCHED;
            PG8_STAGE(PG8_SB(1, 1), b3 + hstep, voffB);
            PG8_WAIT_V(6); PG8_BAR; PG8_MMA(1, 1, At, B1); PG8_BAR;
        }
        PG8_STAMP();
        if constexpr (!Epi::AFTER_DRAIN) { E(acc, cur, wr, wc, fr, fq); S.done(cur); }
        PG8_STAMP();
        if (!has_next) break;
#pragma unroll
        for (int a = 0; a < 2; ++a)
#pragma unroll
            for (int b = 0; b < 2; ++b)
#pragma unroll
                for (int m = 0; m < 4; ++m)
#pragma unroll
                    for (int n = 0; n < 2; ++n) acc[a][b][m][n] = (f32x4){0.f, 0.f, 0.f, 0.f};
        cur = nxt; cA = nA; cB = nB; ++ui;
    }
    PG8_WAIT_V(0);
    if (wr == 0) PG8_BAR;
    PG8_BAR;
    if constexpr (Epi::AFTER_DRAIN) { E.fused(acc, cur, wr, wc, fr, fq, lds, wid, lane); S.done(cur); }
    PG8_STAMP();
    if (STAMP && wid == 0) { stamps[lane] = lane < nts ? (((unsigned long long)(unsigned)ts_hi << 32) | (unsigned)ts_lo) : 0ull;
        if (lane == 62) stamps[62] = rt_entry; if (lane == 63) stamps[63] = (unsigned long long)wall_clock64(); }
#undef PG8_STAMP
#undef PG8_SA
#undef PG8_SB
#undef PG8_STAGE
#undef PG8_LDA
#undef PG8_LDB
#undef PG8_MMA
#undef PG8_WAIT_V
#undef PG8_WAIT_L
#undef PG8_BAR
#undef PG8_SCHED
}
}

typedef unsigned short bf16_t;
typedef short bf16x8 __attribute__((ext_vector_type(8)));
typedef short s16x4 __attribute__((ext_vector_type(4)));
typedef float f32x4 __attribute__((ext_vector_type(4)));
typedef float f32x2 __attribute__((ext_vector_type(2)));
typedef float f32x16 __attribute__((ext_vector_type(16)));
typedef unsigned u32x4 __attribute__((ext_vector_type(4)));
typedef unsigned u32x2 __attribute__((ext_vector_type(2)));
typedef __bf16 bf16x2_t __attribute__((ext_vector_type(2)));

constexpr int NTOK = 16384, DM = 1024, NCTX = 8192;
constexpr size_t SZ_WIN = (size_t)1280 * 1024 * 2, SZ_WGLU = (size_t)512 * 512 * 2, SZ_WOUT = (size_t)1024 * 1024 * 2, SZ_WF1 = (size_t)5632 * 1024 * 2, SZ_WF2 = (size_t)1024 * 2816 * 2;
constexpr size_t WS_WIN = 0, WS_WGLU = WS_WIN + 2 * SZ_WIN, WS_WOUT = WS_WGLU + 2 * SZ_WGLU, WS_WF1 = WS_WOUT + 2 * SZ_WOUT, WS_WF2 = WS_WF1 + 2 * SZ_WF1;
constexpr size_t WS_H = WS_WF2 + 2 * SZ_WF2;
constexpr size_t WS_Q = WS_H + (size_t)NTOK * 1024 * 2;
constexpr size_t WS_U = WS_Q + (size_t)NTOK * 512 * 2;
constexpr size_t WS_MIX = WS_U + (size_t)NTOK * 512 * 2;
constexpr size_t WS_G = WS_MIX + (size_t)NTOK * 1024 * 2;
constexpr size_t WS_ACT = WS_Q;
constexpr size_t WS_KLAT = WS_ACT + (size_t)NTOK * 2816 * 2;
constexpr size_t SZ_KLAT = (size_t)4 * 2 * 2560 * 64 * 2;
constexpr size_t WS_VLAT = WS_KLAT + 2 * SZ_KLAT;
constexpr size_t WS_KCTX = WS_VLAT + 2 * SZ_KLAT;
constexpr size_t SZ_KCTX = (size_t)32 * 2 * 256 * 64 * 2;
constexpr size_t WS_VCTX = WS_KCTX + SZ_KCTX;
constexpr size_t WS_MODS = WS_VCTX + SZ_KCTX;
constexpr size_t SZ_MODS = (size_t)2 * 5 * 6144 * 4;
constexpr size_t WS_BAR = WS_MODS + SZ_MODS;
constexpr size_t SZ_BAR = (size_t)3456 * 4;
constexpr size_t WS_ROPEC = WS_BAR + SZ_BAR;
constexpr size_t WS_ROPES = WS_ROPEC + (size_t)2048 * 32 * 4;
constexpr size_t WS_SSMB = WS_ROPES + (size_t)2048 * 32 * 4;
constexpr size_t WS_SSMC = WS_SSMB + (size_t)128 * 4096;
constexpr size_t WS_SSML = WS_SSMC + (size_t)128 * 4096;
constexpr size_t WS_SSEG = WS_SSML + (size_t)128 * 512;
constexpr size_t WS_YB = WS_SSEG + (size_t)32 * 2 * 32 * 64 * 2 * 4;
constexpr size_t WS_MODP = WS_YB + (size_t)NTOK * 512 * 4;
constexpr size_t WS_XB = WS_MODP + (size_t)4 * 61440 * 4;
constexpr size_t WS_END = WS_XB + (size_t)NTOK * 1024 * 2;
constexpr size_t OUT_K = (size_t)2 * 8388608, OUT_V = OUT_K + 2097152, OUT_S = OUT_V + 2097152;
constexpr int LDS_ROPE = 131072 + 16;
constexpr int LDS_BYTES = LDS_ROPE + 12288;

#ifndef REP_NORM
#define REP_NORM 1
#endif
#ifndef REP_IN
#define REP_IN 1
#endif
#ifndef REP_ATT3
#define REP_ATT3 1
#endif
#ifndef REP_ATT4
#define REP_ATT4 1
#endif
#ifndef REP_GLU
#define REP_GLU 1
#endif
#ifndef REP_F1
#define REP_F1 1
#endif
#ifndef REP_P0
#define REP_P0 1
#endif
struct Params { const float* in[28]; float* out; unsigned char* ws; };

DI unsigned pk2(float lo, float hi) { f32x2 v = {lo, hi}; return __builtin_bit_cast(unsigned, __builtin_convertvector(v, bf16x2_t)); }
DI float bf2f(bf16_t b) { return __uint_as_float(((unsigned)b) << 16); }
DI float bflo(unsigned w) { return __uint_as_float(w << 16); }
DI float bfhi(unsigned w) { return __uint_as_float(w & 0xffff0000u); }
DI bf16x8 pack8(float a0, float a1, float a2, float a3, float a4, float a5, float a6, float a7) {
    u32x4 p; p.x = pk2(a0, a1); p.y = pk2(a2, a3); p.z = pk2(a4, a5); p.w = pk2(a6, a7); return __builtin_bit_cast(bf16x8, p); }
DI f32x16 mfma32(bf16x8 a, bf16x8 b, f32x16 c) { return __builtin_amdgcn_mfma_f32_32x32x16_bf16(a, b, c, 0, 0, 0); }
DI f32x16 mfma32p(bf16x8 a, bf16x8 b, f32x16 c) { __builtin_amdgcn_s_setprio(1); f32x16 r = __builtin_amdgcn_mfma_f32_32x32x16_bf16(a, b, c, 0, 0, 0); __builtin_amdgcn_s_setprio(0); return r; }
DI f32x4 mfma16(bf16x8 a, bf16x8 b, f32x4 c) { return __builtin_amdgcn_mfma_f32_16x16x32_bf16(a, b, c, 0, 0, 0); }
DI f32x2 gelu_pk(f32x2 v) {
    const f32x2 av = __builtin_elementwise_abs(v), d = av * 0.2316418882f + 1.0f;
    f32x2 t; t.x = __builtin_amdgcn_rcpf(d.x); t.y = __builtin_amdgcn_rcpf(d.y);
    f32x2 q = t * 0.5307027145f + (-0.7265760135f); q = q * t + 0.7107068705f; q = q * t + (-0.142248368f); q = q * t + 0.127414796f; q = q * t;
    const f32x2 sq = (v * v) * (-0.72134752044f);
    f32x2 e; e.x = __builtin_amdgcn_exp2f(sq.x); e.y = __builtin_amdgcn_exp2f(sq.y);
    const f32x2 m = v * (q * e), r = v - m;
    f32x2 o; o.x = v.x < 0.f ? m.x : r.x; o.y = v.y < 0.f ? m.y : r.y; return o;
}
#define GAS __attribute__((address_space(1)))
DI u32x2 ldg8(const void* p) { return *(const GAS u32x2*)p; }
DI u32x4 ldg16(const void* p) { return *(const GAS u32x4*)p; }
DI f32x4 ldg16f(const void* p) { return *(const GAS f32x4*)p; }
DI f32x2 ldg8f(const void* p) { return *(const GAS f32x2*)p; }
DI void stg8(void* p, u32x2 v) { *(GAS u32x2*)p = v; }
DI void stg16(void* p, u32x4 v) { *(GAS u32x4*)p = v; }
DI void stg16f(void* p, f32x4 v) { *(GAS f32x4*)p = v; }
DI float sigmoidf_(float x) { return __builtin_amdgcn_rcpf(1.0f + __expf(-x)); }

DI void tconv_tile(const float* __restrict__ src, size_t sld, int ca, int cb, bf16_t* __restrict__ dst, size_t dld, float* lds, int wv) {
    const int tid = ltid(wv);
#pragma unroll
    for (int i = 0; i < 8; ++i) { const int idx = i * 512 + tid, kk = idx >> 6, nn = idx & 63; const int col = nn < 32 ? ca + nn : cb + nn - 32;
        lds[nn * 65 + kk] = src[(size_t)kk * sld + col]; }
    __syncthreads();
    { const int nn = tid >> 3, k8 = (tid & 7) * 8; const float* r = lds + nn * 65 + k8;
      u32x4 w; w.x = pk2(r[0], r[1]); w.y = pk2(r[2], r[3]); w.z = pk2(r[4], r[5]); w.w = pk2(r[6], r[7]);
      *(u32x4*)(dst + (size_t)nn * dld + k8) = w; }
    __syncthreads();
}
DI int srccol_in(int np) { const int pn = np >> 8, cpos = np & 255, bj = cpos >> 7, wc = (cpos >> 5) & 3, w = cpos & 31; return pn * 256 + wc * 64 + bj * 32 + w; }
DI int srccol_f1(int np) { const int tile = np >> 8, bj = (np >> 7) & 1, i = np & 127; return bj * 2816 + tile * 128 + i; }

DI void wconv_task(const Params& P, int t, float* lds, int wv) {
    const int l = t / 2752; int r = t % 2752;
    unsigned char* ws = P.ws;
    if (r < 320) { const int kt = r & 15, ntl = r >> 4, n0 = ntl * 64, k0 = kt * 64;
        tconv_tile(P.in[11] + ((size_t)l * 1024 + k0) * 1280, 1280, srccol_in(n0), srccol_in(n0 + 32), (bf16_t*)(ws + WS_WIN + l * SZ_WIN) + (size_t)n0 * 1024 + k0, 1024, lds, wv); return; }
    r -= 320;
    if (r < 64) { const int kt = r & 7, ntl = r >> 3, n0 = ntl * 64, k0 = kt * 64;
        tconv_tile(P.in[22] + ((size_t)l * 512 + k0) * 512, 512, n0, n0 + 32, (bf16_t*)(ws + WS_WGLU + l * SZ_WGLU) + (size_t)n0 * 512 + k0, 512, lds, wv); return; }
    r -= 64;
    if (r < 256) { const int kt = r & 15, ntl = r >> 4, n0 = ntl * 64, k0 = kt * 64;
        tconv_tile(P.in[24] + ((size_t)l * 1024 + k0) * 1024, 1024, n0, n0 + 32, (bf16_t*)(ws + WS_WOUT + l * SZ_WOUT) + (size_t)n0 * 1024 + k0, 1024, lds, wv); return; }
    r -= 256;
    if (r < 1408) { const int kt = r & 15, ntl = r >> 4, n0 = ntl * 64, k0 = kt * 64;
        tconv_tile(P.in[25] + ((size_t)l * 1024 + k0) * 5632, 5632, srccol_f1(n0), srccol_f1(n0 + 32), (bf16_t*)(ws + WS_WF1 + l * SZ_WF1) + (size_t)n0 * 1024 + k0, 1024, lds, wv); return; }
    r -= 1408;
    { const int kt = r % 44, ntl = r / 44, n0 = ntl * 64, k0 = kt * 64;
        tconv_tile(P.in[26] + ((size_t)l * 2816 + k0) * 1024, 1024, n0, n0 + 32, (bf16_t*)(ws + WS_WF2 + l * SZ_WF2) + (size_t)n0 * 2816 + k0, 2816, lds, wv); }
}

DI void adaln_task(const Params& P, int task, float* lds, int wv) {
    const int tid = ltid(wv), w = tid >> 6, lane = tid & 63;
    const int kc = task & 3, cgp = (task >> 2) % 24, l = task / 96;
    const int n = cgp * 256 + lane * 4;
    const int k0 = kc * 256 + w * 32;
    const float* wm = P.in[7] + ((size_t)l * 1024 + k0) * 6144 + n;
    const float* cc = P.in[5]; const float* cx = P.in[6];
    f32x4 wrow[32];
#pragma unroll
    for (int kk = 0; kk < 32; ++kk) wrow[kk] = *(const f32x4*)(wm + (size_t)kk * 6144);
    f32x4 acc[5];
#pragma unroll
    for (int j = 0; j < 5; ++j) acc[j] = (f32x4){0.f, 0.f, 0.f, 0.f};
#pragma unroll
    for (int kk = 0; kk < 32; ++kk) { const int k = k0 + kk;
#pragma unroll
        for (int j = 0; j < 5; ++j) { const float cv = (j == 0) ? cx[k] : cc[(j - 1) * 1024 + k]; const float sv = cv / (1.0f + __expf(-cv)); acc[j] += wrow[kk] * sv; } }
#pragma unroll
    for (int j = 0; j < 5; ++j) *(f32x4*)(lds + (w * 5 + j) * 256 + lane * 4) = acc[j];
    __syncthreads();
    float* part = (float*)(P.ws + WS_MODP) + (size_t)kc * 61440;
    for (int e = tid; e < 1280; e += 512) { const int j = e >> 8, col = e & 255; float sm = 0.f;
#pragma unroll
        for (int ww = 0; ww < 8; ++ww) sm += lds[(ww * 5 + j) * 256 + col];
        part[(l * 5 + j) * 6144 + cgp * 256 + col] = sm; }
    __syncthreads();
}

DI void ssmconst_task(const Params& P, int task, int wv) {
    const int idx = task * 512 + ltid(wv); const int p = idx & 63, ldg = idx >> 6;
    const double dt = exp((double)P.in[16][ldg]); const double ar = (double)P.in[14][ldg * 64 + p], ai = (double)P.in[15][ldg * 64 + p];
    const double mag = exp(ar * dt); double sn, cs; sincos(ai * dt, &sn, &cs);
    const double lr = mag * cs, li = mag * sn, den = ar * ar + ai * ai;
    const double zr = ((lr - 1.0) * ar + li * ai) / den, zi = (li * ar - (lr - 1.0) * ai) / den;
    float* lam = (float*)(P.ws + WS_SSML); lam[(ldg * 64 + p) * 2] = (float)lr; lam[(ldg * 64 + p) * 2 + 1] = (float)li;
    bf16_t* Bm = (bf16_t*)(P.ws + WS_SSMB); bf16_t* Cm = (bf16_t*)(P.ws + WS_SSMC);
    const float* bre = P.in[17] + ((size_t)ldg * 64 + p) * 16; const float* bim = P.in[18] + ((size_t)ldg * 64 + p) * 16;
    const int ntb = (p >= 32) ? 2 : 0;
    for (int h = 0; h < 16; ++h) { const double br = bre[h], bi = bim[h]; const float bbr = (float)(zr * br - zi * bi), bbi = (float)(zr * bi + zi * br);
        const int ln = (p & 31) + 32 * (h >> 3), j = h & 7;
        Bm[(((size_t)ldg * 4 + ntb) * 64 + ln) * 8 + j] = (bf16_t)(pk2(bbr, 0.f) & 0xffffu);
        Bm[(((size_t)ldg * 4 + ntb + 1) * 64 + ln) * 8 + j] = (bf16_t)(pk2(bbi, 0.f) & 0xffffu); }
    for (int hp = 0; hp < 16; ++hp) { const float cr = P.in[19][((size_t)ldg * 16 + hp) * 64 + p], ci = P.in[20][((size_t)ldg * 16 + hp) * 64 + p];
#pragma unroll
        for (int ri = 0; ri < 2; ++ri) { const int pp = 2 * p + ri, ks = pp >> 5, kq = (pp >> 3) & 3, j = pp & 7;
            Cm[(((size_t)ldg * 4 + ks) * 64 + kq * 16 + hp) * 8 + j] = (bf16_t)(pk2(ri ? -ci : cr, 0.f) & 0xffffu); } }
}

DI void phase0(const Params& P, unsigned char* shm, int wv) {
    float* lds = (float*)shm;
    constexpr int T_ADA = 192, T_W = 5504, T_V = 128, T_K = 128, T_S = 16, T_R = 128;
    constexpr int T_TOTAL = T_ADA + T_W + T_V + T_K + T_S + T_R;
    for (int rep = 0; rep < REP_P0; ++rep)
    for (int t = blockIdx.x; t < T_TOTAL; t += gridDim.x) {
        int r = t;
        if (r < T_ADA) { adaln_task(P, r, lds, wv); continue; }
        r -= T_ADA;
        if (r < T_W) { wconv_task(P, r, lds, wv); continue; }
        r -= T_W;
        if (r < T_V) { const int s8 = r & 7, kvh = (r >> 3) & 1, b = (r >> 4) & 3, l = r >> 6;
            tconv_tile(P.in[3] + (((size_t)(b * 2 + l) * 512 + s8 * 64) * 2 + kvh) * 64, 128, 0, 32,
                       (bf16_t*)(P.ws + WS_VLAT + l * SZ_KLAT) + ((size_t)(b * 2 + kvh) * 64) * 2560 + s8 * 64, 2560, lds, wv); continue; }
        r -= T_V;
        if (r < T_K) { const int idx = r * 4096 + ltid(wv) * 8; const int d = idx & 63, s = (idx >> 6) & 511, kvh = (idx >> 15) & 1, b = (idx >> 16) & 3, l = idx >> 18;
            const float* src = P.in[2] + ((((size_t)(b * 2 + l) * 512 + s) * 2 + kvh) * 64 + d);
            const f32x4 a = *(const f32x4*)src, c = *(const f32x4*)(src + 4);
            u32x4 w; w.x = pk2(a[0], a[1]); w.y = pk2(a[2], a[3]); w.z = pk2(c[0], c[1]); w.w = pk2(c[2], c[3]);
            *(u32x4*)((bf16_t*)(P.ws + WS_KLAT + l * SZ_KLAT) + ((size_t)(b * 2 + kvh) * 2560 + s) * 64 + d) = w; continue; }
        r -= T_K;
        if (r < T_S) { ssmconst_task(P, r, wv); continue; }
        r -= T_S;
        { const int idx = r * 512 + ltid(wv); const int tt = idx >> 5, i = idx & 31; const int pos = (i < 16) ? (tt >> 6) : (tt & 63); const int f = i & 15;
          const double inv = pow(10000.0, -(2.0 * f) / 32.0); double sn, cs; sincos((double)pos * inv, &sn, &cs);
          ((float*)(P.ws + WS_ROPEC))[idx] = (float)cs; ((float*)(P.ws + WS_ROPES))[idx] = (float)sn; }
    }
}

DI float wave_sum(float v, int lane) {
    v += shx(v, 32, lane); v += shx(v, 16, lane); v += shx(v, 8, lane); v += shx(v, 4, lane); v += shx(v, 2, lane); v += shx(v, 1, lane); return v; }

DI void norm_phase(const float* __restrict__ xa, const float* __restrict__ xb, const bf16_t* __restrict__ xh, const float* __restrict__ gw, const float* mbase, int jstride, int sh_off, int sc_off, bf16_t* __restrict__ H, int wv) {
    const int tidl = ltid(wv); const int lane = tidl & 63, w = tidl >> 6;
    for (int base = (blockIdx.x * 8 + w) * 8; base < NTOK; base += gridDim.x * 64) {
        const int j = base < NCTX ? 0 : 1 + ((base - NCTX) >> 11);
        f32x4 wv4[4], sh4[4];
#pragma unroll
        for (int k = 0; k < 4; ++k) { const int col = (k >> 1) * 512 + lane * 8 + (k & 1) * 4;
            const f32x4 g4 = ldg16f(gw + col), sc = *(const f32x4*)(mbase + j * jstride + sc_off + col); sh4[k] = *(const f32x4*)(mbase + j * jstride + sh_off + col); wv4[k] = g4 * (sc + 1.0f); }
#pragma unroll
        for (int hb = 0; hb < 2; ++hb) {
            f32x4 v[4][4]; float ss[4];
            if (xh) { u32x4 t[4][2];
#pragma unroll
                for (int r = 0; r < 4; ++r)
#pragma unroll
                    for (int i = 0; i < 2; ++i) t[r][i] = ldg16(xh + (size_t)(base + hb * 4 + r) * 1024 + i * 512 + lane * 8);
#pragma unroll
                for (int r = 0; r < 4; ++r)
#pragma unroll
                    for (int i = 0; i < 2; ++i) { v[r][2 * i] = (f32x4){bflo(t[r][i].x), bfhi(t[r][i].x), bflo(t[r][i].y), bfhi(t[r][i].y)}; v[r][2 * i + 1] = (f32x4){bflo(t[r][i].z), bfhi(t[r][i].z), bflo(t[r][i].w), bfhi(t[r][i].w)}; }
            } else { const float* xr = base < NCTX ? xa + (size_t)(base + hb * 4) * 1024 : xb + (size_t)(base + hb * 4 - NCTX) * 1024;
#pragma unroll
                for (int r = 0; r < 4; ++r)
#pragma unroll
                    for (int k = 0; k < 4; ++k) v[r][k] = ldg16f(xr + (size_t)r * 1024 + (k >> 1) * 512 + lane * 8 + (k & 1) * 4); }
#pragma unroll
            for (int r = 0; r < 4; ++r) { float a = 0.f;
#pragma unroll
                for (int k = 0; k < 4; ++k) a += v[r][k][0] * v[r][k][0] + v[r][k][1] * v[r][k][1] + v[r][k][2] * v[r][k][2] + v[r][k][3] * v[r][k][3];
                ss[r] = a; }
#pragma unroll
            for (int mk = 32; mk >= 1; mk >>= 1)
#pragma unroll
                for (int r = 0; r < 4; ++r) ss[r] += shx(ss[r], mk, lane);
#pragma unroll
            for (int r = 0; r < 4; ++r) { const float rstd = rsqrtf(ss[r] * (1.0f / 1024.0f) + 1e-6f);
#pragma unroll
                for (int i = 0; i < 2; ++i) { const f32x4 o0 = v[r][2 * i] * rstd * wv4[2 * i] + sh4[2 * i], o1 = v[r][2 * i + 1] * rstd * wv4[2 * i + 1] + sh4[2 * i + 1];
                    u32x4 pw; pw.x = pk2(o0[0], o0[1]); pw.y = pk2(o0[2], o0[3]); pw.z = pk2(o1[0], o1[1]); pw.w = pk2(o1[2], o1[3]); stg16(H + (size_t)(base + hb * 4 + r) * 1024 + i * 512 + lane * 8, pw); } }
        }
    }
}

DI void final_norm_phase(const bf16_t* __restrict__ xh, float* __restrict__ Y, const float* __restrict__ gw, int wv) {
    const int tidl = ltid(wv); const int lane = tidl & 63, w = tidl >> 6;
    for (int base = (blockIdx.x * 8 + w) * 8; base < NTOK; base += gridDim.x * 64) {
        f32x4 g4[4];
#pragma unroll
        for (int k = 0; k < 4; ++k) g4[k] = ldg16f(gw + (k >> 1) * 512 + lane * 8 + (k & 1) * 4);
#pragma unroll
        for (int hb = 0; hb < 2; ++hb) {
            u32x4 t[4][2]; float ss[4];
#pragma unroll
            for (int r = 0; r < 4; ++r)
#pragma unroll
                for (int i = 0; i < 2; ++i) t[r][i] = ldg16(xh + (size_t)(base + hb * 4 + r) * 1024 + i * 512 + lane * 8);
            f32x4 v[4][4];
#pragma unroll
            for (int r = 0; r < 4; ++r) { float a = 0.f;
#pragma unroll
                for (int i = 0; i < 2; ++i) { v[r][2 * i] = (f32x4){bflo(t[r][i].x), bfhi(t[r][i].x), bflo(t[r][i].y), bfhi(t[r][i].y)}; v[r][2 * i + 1] = (f32x4){bflo(t[r][i].z), bfhi(t[r][i].z), bflo(t[r][i].w), bfhi(t[r][i].w)}; }
#pragma unroll
                for (int k = 0; k < 4; ++k) a += v[r][k][0] * v[r][k][0] + v[r][k][1] * v[r][k][1] + v[r][k][2] * v[r][k][2] + v[r][k][3] * v[r][k][3];
                ss[r] = a; }
#pragma unroll
            for (int mk = 32; mk >= 1; mk >>= 1)
#pragma unroll
                for (int r = 0; r < 4; ++r) ss[r] += shx(ss[r], mk, lane);
#pragma unroll
            for (int r = 0; r < 4; ++r) { const float rstd = rsqrtf(ss[r] * (1.0f / 1024.0f) + 1e-6f);
#pragma unroll
                for (int k = 0; k < 4; ++k) stg16f(Y + (size_t)(base + hb * 4 + r) * 1024 + (k >> 1) * 512 + lane * 8 + (k & 1) * 4, v[r][k] * rstd * g4[k]); }
        }
    }
}

struct EpiIn {
    static constexpr bool PERM = true, AFTER_DRAIN = false;
    int layer; const float* qn; const float* kn; const PG8_LAS float* lr;
    bf16_t* Q; bf16_t* U; bf16_t* Kctx; bf16_t* Vctx; bf16_t* Klat; bf16_t* Vlat; float* outk; float* outv;
    DI void operator()(const f32x4 (&acc)[2][2][4][2], const pg8::Unit& u, int wr, int wc, int fr, int fq) const {
        asm volatile("" : "+v"(fr), "+v"(fq));
        const bool lat = u.pm >= 32; const int pn = u.pn;
        if (pn >= 3) {
#pragma unroll
            for (int ai = 0; ai < 2; ++ai)
#pragma unroll
                for (int m = 0; m < 4; ++m) { const int row = u.pm * 256 + ai * 128 + wr * 64 + m * 16 + fr;
#pragma unroll
                    for (int bj = 0; bj < 2; ++bj) { const int col = (pn - 3) * 256 + 64 * wc + 32 * bj + 8 * fq; const f32x4 a0 = acc[ai][bj][m][0], a1 = acc[ai][bj][m][1];
                        u32x4 pw; pw.x = pk2(a0[0], a0[1]); pw.y = pk2(a0[2], a0[3]); pw.z = pk2(a1[0], a1[1]); pw.w = pk2(a1[2], a1[3]); stg16(U + (size_t)row * 512 + col, pw); } }
            return;
        }
        if (pn == 2 && wc >= 2) {
            const int kvh = wc - 2;
#pragma unroll
            for (int ai = 0; ai < 2; ++ai)
#pragma unroll
                for (int m = 0; m < 4; ++m) { const int row = u.pm * 256 + ai * 128 + wr * 64 + m * 16 + fr;
                    if (!lat) { const int b = row >> 8, t = row & 255; float* ov = outv + (((size_t)(b * 2 + layer) * 256 + t) * 2 + kvh) * 64; bf16_t* vt = Vctx + ((size_t)(b * 2 + kvh) * 64) * 256 + t;
#pragma unroll
                        for (int bj = 0; bj < 2; ++bj)
#pragma unroll
                            for (int n = 0; n < 2; ++n) { const int d = 32 * bj + 8 * fq + 4 * n; const f32x4 a = acc[ai][bj][m][n]; stg16f(ov + d, a);
                                const unsigned p0 = pk2(a[0], a[1]), p1 = pk2(a[2], a[3]);
                                vt[(size_t)(d + 0) * 256] = (bf16_t)(p0 & 0xffffu); vt[(size_t)(d + 1) * 256] = (bf16_t)(p0 >> 16); vt[(size_t)(d + 2) * 256] = (bf16_t)(p1 & 0xffffu); vt[(size_t)(d + 3) * 256] = (bf16_t)(p1 >> 16); } }
                    else { const int rl = row - NCTX, b = rl >> 11, t = rl & 2047; bf16_t* vt = Vlat + ((size_t)(b * 2 + kvh) * 64) * 2560 + 512 + t;
#pragma unroll
                        for (int bj = 0; bj < 2; ++bj)
#pragma unroll
                            for (int n = 0; n < 2; ++n) { const int d = 32 * bj + 8 * fq + 4 * n; const f32x4 a = acc[ai][bj][m][n];
                                const unsigned p0 = pk2(a[0], a[1]), p1 = pk2(a[2], a[3]);
                                vt[(size_t)(d + 0) * 2560] = (bf16_t)(p0 & 0xffffu); vt[(size_t)(d + 1) * 2560] = (bf16_t)(p0 >> 16); vt[(size_t)(d + 2) * 2560] = (bf16_t)(p1 & 0xffffu); vt[(size_t)(d + 3) * 2560] = (bf16_t)(p1 >> 16); } } }
            return;
        }
        const bool isq = pn < 2; const float* nw = isq ? qn : kn;
        f32x4 w4[2][2];
#pragma unroll
        for (int bj = 0; bj < 2; ++bj)
#pragma unroll
            for (int n = 0; n < 2; ++n) w4[bj][n] = ldg16f(nw + 32 * bj + 8 * fq + 4 * n);
        const float qscale = isq ? 0.125f * 1.4426950408889634f : 1.0f;
        const int T0r = ((u.pm * 256 - NCTX) & 2047) >> 6;
#pragma unroll
        for (int ai = 0; ai < 2; ++ai)
#pragma unroll
            for (int m = 0; m < 4; ++m) { const int row = u.pm * 256 + ai * 128 + wr * 64 + m * 16 + fr;
                float ss = 0.f;
#pragma unroll
                for (int bj = 0; bj < 2; ++bj)
#pragma unroll
                    for (int n = 0; n < 2; ++n) { const f32x4 a = acc[ai][bj][m][n]; ss += a[0] * a[0] + a[1] * a[1] + a[2] * a[2] + a[3] * a[3]; }
                ss += shx(ss, 16, fq * 16 + fr); ss += shx(ss, 32, fq * 16 + fr);
                const float rstd = rsqrtf(ss * (1.0f / 64.0f) + 1e-6f);
                f32x4 v[2][2];
#pragma unroll
                for (int bj = 0; bj < 2; ++bj)
#pragma unroll
                    for (int n = 0; n < 2; ++n) v[bj][n] = acc[ai][bj][m][n] * rstd * w4[bj][n];
                if (!lat) {
                    const int b = row >> 8, t = row & 255;
                    if (isq) { bf16_t* qp = Q + (size_t)row * 512 + (pn * 4 + wc) * 64;
#pragma unroll
                        for (int bj = 0; bj < 2; ++bj) { const f32x4 a0 = v[bj][0] * qscale, a1 = v[bj][1] * qscale;
                            u32x4 pw; pw.x = pk2(a0[0], a0[1]); pw.y = pk2(a0[2], a0[3]); pw.z = pk2(a1[0], a1[1]); pw.w = pk2(a1[2], a1[3]); stg16(qp + 32 * bj + 8 * fq, pw); } }
                    else { const int kvh = wc; float* ok = outk + (((size_t)(b * 2 + layer) * 256 + t) * 2 + kvh) * 64; bf16_t* kp = Kctx + ((size_t)(b * 2 + kvh) * 256 + t) * 64;
#pragma unroll
                        for (int bj = 0; bj < 2; ++bj) { const int d = 32 * bj + 8 * fq; const f32x4 a0 = v[bj][0], a1 = v[bj][1]; stg16f(ok + d, a0); stg16f(ok + d + 4, a1);
                            u32x4 pw; pw.x = pk2(a0[0], a0[1]); pw.y = pk2(a0[2], a0[3]); pw.z = pk2(a1[0], a1[1]); pw.w = pk2(a1[2], a1[3]); stg16(kp + d, pw); } }
                } else {
                    const int rl = row - NCTX, b = rl >> 11, t = rl & 2047;
                    bf16_t* dst = isq ? Q + (size_t)row * 512 + (pn * 4 + wc) * 64 : Klat + ((size_t)(b * 2 + wc) * 2560 + 512 + t) * 64;
                    const int grow = T0r + 2 * ai + wr, gcol = 16 * m + fr;
#pragma unroll
                    for (int bj = 0; bj < 2; ++bj) { u32x4 pw;
#pragma unroll
                        for (int n = 0; n < 2; ++n) { const int o = (bj == 0 ? grow * 16 : 1024 + gcol * 16) + 4 * fq + 2 * n;
                            const f32x2 c2 = *(const PG8_LAS f32x2*)(lr + o), s2 = *(const PG8_LAS f32x2*)(lr + o + (bj == 0 ? 512 : 1024)); const f32x4 a = v[bj][n];
                            const float o0 = (a[0] * c2[0] - a[1] * s2[0]) * qscale, o1 = (a[0] * s2[0] + a[1] * c2[0]) * qscale, o2 = (a[2] * c2[1] - a[3] * s2[1]) * qscale, o3 = (a[2] * s2[1] + a[3] * c2[1]) * qscale;
                            if (n == 0) { pw.x = pk2(o0, o1); pw.y = pk2(o2, o3); } else { pw.z = pk2(o0, o1); pw.w = pk2(o2, o3); } }
                        stg16(dst + 32 * bj + 8 * fq, pw); }
                }
            }
    }
};

struct EpiGlu {
    static constexpr bool PERM = true, AFTER_DRAIN = false;
    const bf16_t* G; const float* bias; bf16_t* MIX;
    DI void operator()(const f32x4 (&acc)[2][2][4][2], const pg8::Unit& u, int wr, int wc, int fr, int fq) const {
        asm volatile("" : "+v"(fr), "+v"(fq));
        const int cb = u.pn * 256 + 32 * wc + 8 * fq, rb = u.pm * 256 + wr * 64 + fr;
        f32x4 bv[2][2]; u32x4 gw[2][4][2];
#pragma unroll
        for (int bj = 0; bj < 2; ++bj) { bv[bj][0] = ldg16f(bias + cb + 128 * bj); bv[bj][1] = ldg16f(bias + cb + 128 * bj + 4); }
#pragma unroll
        for (int ai = 0; ai < 2; ++ai)
#pragma unroll
            for (int m = 0; m < 4; ++m)
#pragma unroll
                for (int bj = 0; bj < 2; ++bj) gw[ai][m][bj] = ldg16(G + (size_t)(rb + 128 * ai + 16 * m) * 512 + cb + 128 * bj);
#pragma unroll
        for (int ai = 0; ai < 2; ++ai)
#pragma unroll
            for (int m = 0; m < 4; ++m)
#pragma unroll
                for (int bj = 0; bj < 2; ++bj) { const u32x4 g4 = gw[ai][m][bj];
                    const f32x4 v0 = acc[ai][bj][m][0] + bv[bj][0], v1 = acc[ai][bj][m][1] + bv[bj][1];
                    u32x4 o;
                    o.x = pk2(bflo(g4.x) * sigmoidf_(v0[0]), bfhi(g4.x) * sigmoidf_(v0[1])); o.y = pk2(bflo(g4.y) * sigmoidf_(v0[2]), bfhi(g4.y) * sigmoidf_(v0[3]));
                    o.z = pk2(bflo(g4.z) * sigmoidf_(v1[0]), bfhi(g4.z) * sigmoidf_(v1[1])); o.w = pk2(bflo(g4.w) * sigmoidf_(v1[2]), bfhi(g4.w) * sigmoidf_(v1[3]));
                    stg16(MIX + (size_t)(rb + 128 * ai + 16 * m) * 1024 + 512 + cb + 128 * bj, o); }
    }
};

struct EpiRes {
    static constexpr bool PERM = true, AFTER_DRAIN = false;
    const float* xa; const float* xb; const bf16_t* xh; bf16_t* Xo; const float* gate;
    DI void operator()(const f32x4 (&acc)[2][2][4][2], const pg8::Unit& u, int wr, int wc, int fr, int fq) const {
        asm volatile("" : "+v"(fr), "+v"(fq));
        const int j = u.pm < 32 ? 0 : 1 + ((u.pm - 32) >> 3);
        const int cb = u.pn * 256 + 32 * wc + 8 * fq, rb = u.pm * 256 + wr * 64 + fr;
        const float* gt = gate + j * 6144 + cb;
        f32x4 gv[2][2];
#pragma unroll
        for (int bj = 0; bj < 2; ++bj)
#pragma unroll
            for (int n = 0; n < 2; ++n) gv[bj][n] = ldg16f(gt + 128 * bj + 4 * n);
        if (xh) {
#pragma unroll
            for (int ai = 0; ai < 2; ++ai) {
                u32x4 xr[4][2];
#pragma unroll
                for (int m = 0; m < 4; ++m)
#pragma unroll
                    for (int bj = 0; bj < 2; ++bj) xr[m][bj] = ldg16(xh + (size_t)(rb + 128 * ai + 16 * m) * 1024 + cb + 128 * bj);
#pragma unroll
                for (int m = 0; m < 4; ++m)
#pragma unroll
                    for (int bj = 0; bj < 2; ++bj) { const u32x4 t = xr[m][bj];
                        const f32x4 x0 = (f32x4){bflo(t.x), bfhi(t.x), bflo(t.y), bfhi(t.y)} + gv[bj][0] * acc[ai][bj][m][0];
                        const f32x4 x1 = (f32x4){bflo(t.z), bfhi(t.z), bflo(t.w), bfhi(t.w)} + gv[bj][1] * acc[ai][bj][m][1];
                        u32x4 pw; pw.x = pk2(x0[0], x0[1]); pw.y = pk2(x0[2], x0[3]); pw.z = pk2(x1[0], x1[1]); pw.w = pk2(x1[2], x1[3]);
                        stg16(Xo + (size_t)(rb + 128 * ai + 16 * m) * 1024 + cb + 128 * bj, pw); }
            }
        } else {
            const float* xs = u.pm < 32 ? xa + (size_t)rb * 1024 : xb + (size_t)(rb - NCTX) * 1024;
#pragma unroll
            for (int ai = 0; ai < 2; ++ai) {
                f32x4 xr[4][2][2];
#pragma unroll
                for (int m = 0; m < 4; ++m)
#pragma unroll
                    for (int bj = 0; bj < 2; ++bj)
#pragma unroll
                        for (int n = 0; n < 2; ++n) xr[m][bj][n] = ldg16f(xs + (size_t)(128 * ai + 16 * m) * 1024 + cb + 128 * bj + 4 * n);
#pragma unroll
                for (int m = 0; m < 4; ++m)
#pragma unroll
                    for (int bj = 0; bj < 2; ++bj) { const f32x4 x0 = xr[m][bj][0] + gv[bj][0] * acc[ai][bj][m][0], x1 = xr[m][bj][1] + gv[bj][1] * acc[ai][bj][m][1];
                        u32x4 pw; pw.x = pk2(x0[0], x0[1]); pw.y = pk2(x0[2], x0[3]); pw.z = pk2(x1[0], x1[1]); pw.w = pk2(x1[2], x1[3]);
                        stg16(Xo + (size_t)(rb + 128 * ai + 16 * m) * 1024 + cb + 128 * bj, pw); }
            }
        }
    }
};

struct EpiFfn1 {
    static constexpr bool PERM = true, AFTER_DRAIN = false;
    bf16_t* ACT;
    DI void operator()(const f32x4 (&acc)[2][2][4][2], const pg8::Unit& u, int wr, int wc, int fr, int fq) const {
        asm volatile("" : "+v"(fr), "+v"(fq));
#pragma unroll
        for (int ai = 0; ai < 2; ++ai)
#pragma unroll
            for (int m = 0; m < 4; ++m) { const int row = u.pm * 256 + ai * 128 + wr * 64 + m * 16 + fr; const int a0 = u.pn * 128 + 32 * wc + 8 * fq;
                const f32x4 g0 = acc[ai][0][m][0], g1 = acc[ai][0][m][1], u0 = acc[ai][1][m][0], u1 = acc[ai][1][m][1];
                u32x4 o;
                o.x = pk2(g0[0] * sigmoidf_(g0[0]) * u0[0], g0[1] * sigmoidf_(g0[1]) * u0[1]); o.y = pk2(g0[2] * sigmoidf_(g0[2]) * u0[2], g0[3] * sigmoidf_(g0[3]) * u0[3]);
                o.z = pk2(g1[0] * sigmoidf_(g1[0]) * u1[0], g1[1] * sigmoidf_(g1[1]) * u1[1]); o.w = pk2(g1[2] * sigmoidf_(g1[2]) * u1[2], g1[3] * sigmoidf_(g1[3]) * u1[3]);
                *(u32x4*)(ACT + (size_t)row * 2816 + a0) = o; }
    }
};

struct ListOrder {
    int count, G, c, mode;
    DI bool next(int i, pg8::Unit& u) const {
        const int L0 = i * G + c; if (L0 >= count) return false;
        const int L = (L0 & 7) * (count >> 3) + (L0 >> 3);
        if (mode == 0) { const int pm = L >> 2, vn = L & 3; if (vn < 3) { u.pm = pm; u.pn = vn; } else { u.pm = 32 + (pm >> 1); u.pn = 3 + (pm & 1); } }
        else { u.pm = L >> 1; u.pn = 3 + (L & 1); }
        return true;
    }
    DI void a_ready(const pg8::Unit&) const {}
    DI void done(const pg8::Unit&) const {}
};

template <class Epi> DI void run_gemm(unsigned char* shm, const bf16_t* A, const bf16_t* Bt, int N, int K, const Epi& E, int wv) {
    pg8::Gemm g; g.A = A; g.Bt = Bt; g.M = NTOK; g.N = N; g.K = K;
    pg8::StaticOrder S; S.init(NTOK, N, (int)gridDim.x, (int)blockIdx.x);
    pg8::gemm_phase<Epi, pg8::StaticOrder, false>((PG8_LAS unsigned char*)shm, g, S, E, nullptr, wv);
}

DI void attn_item(const bf16_t* __restrict__ Q, const bf16_t* __restrict__ Kp, const bf16_t* __restrict__ Vp, int vld, int nkeys, int qtok0, int kvh, bf16_t* __restrict__ MIX, unsigned char* lds, int wv) {
    const int tid = ltid(wv), w = tid >> 6, lane = tid & 63, c = lane & 31, hh = lane >> 5;
    const int hq = kvh * 4 + (w & 3), qtok = qtok0 + 32 * (w >> 2) + c;
    bf16x8 qf[4];
#pragma unroll
    for (int s = 0; s < 4; ++s) qf[s] = __builtin_bit_cast(bf16x8, ldg16(Q + (size_t)qtok * 512 + hq * 64 + 16 * s + 8 * hh));
    unsigned char* Kb = lds; unsigned char* Vb = lds + 2 * 9216;
    const int srow = tid >> 3, sseg = tid & 7;
    const bf16_t* kg = Kp + (size_t)srow * 64 + sseg * 8;
    const bf16_t* vg = Vp + (size_t)srow * vld + sseg * 8;
    u32x4 kr = ldg16(kg), vr = ldg16(vg);
    *(u32x4*)(Kb + srow * 144 + sseg * 16) = kr;
    { u32x2* d = (u32x2*)(Vb + srow * 136 + sseg * 16); u32x2 a; a.x = vr.x; a.y = vr.y; u32x2 b; b.x = vr.z; b.y = vr.w; d[0] = a; d[1] = b; }
    __syncthreads();
    f32x16 ot[2];
#pragma unroll
    for (int i = 0; i < 16; ++i) { ot[0][i] = 0.f; ot[1][i] = 0.f; }
    float mrun = -1e30f, lsum = 0.f;
    const int nt = nkeys >> 6;
    for (int it = 0; it < nt; ++it) {
        const int cur = it & 1;
        if (it + 1 < nt) { kr = ldg16(kg + (size_t)(it + 1) * 4096); vr = ldg16(vg + (it + 1) * 64); }
        const unsigned char* kb = Kb + cur * 9216; const unsigned char* vb = Vb + cur * 8704;
        f32x16 st[2]; bf16x8 kf[2][4];
#pragma unroll
        for (int kt = 0; kt < 2; ++kt)
#pragma unroll
            for (int s = 0; s < 4; ++s) kf[kt][s] = *(const PG8_LAS bf16x8*)(const PG8_LAS unsigned char*)(kb + (32 * kt + c) * 144 + (16 * s + 8 * hh) * 2);
#pragma unroll
        for (int kt = 0; kt < 2; ++kt) {
#pragma unroll
            for (int i = 0; i < 16; ++i) st[kt][i] = 0.f;
#pragma unroll
            for (int s = 0; s < 4; ++s) st[kt] = mfma32p(kf[kt][s], qf[s], st[kt]); }
        float mx = fmaxf(fmaxf(st[0][0], st[0][1]), st[0][2]);
#pragma unroll
        for (int i = 3; i < 15; i += 2) mx = fmaxf(fmaxf(mx, st[0][i]), st[0][i + 1]);
        mx = fmaxf(mx, st[0][15]);
#pragma unroll
        for (int i = 0; i < 16; i += 2) mx = fmaxf(fmaxf(mx, st[1][i]), st[1][i + 1]);
        mx = fmaxf(mx, shx(mx, 32, lane));
        const float mnew = fmaxf(mrun, mx), alpha = __builtin_amdgcn_exp2f(mrun - mnew); mrun = mnew;
        f32x2 ps2 = (f32x2){0.f, 0.f}; const f32x2 mn2 = (f32x2){mnew, mnew};
#pragma unroll
        for (int kt = 0; kt < 2; ++kt)
#pragma unroll
            for (int i = 0; i < 16; i += 2) { f32x2 d = (f32x2){st[kt][i], st[kt][i + 1]} - mn2; f32x2 pp; pp.x = __builtin_amdgcn_exp2f(d.x); pp.y = __builtin_amdgcn_exp2f(d.y); st[kt][i] = pp.x; st[kt][i + 1] = pp.y; ps2 += pp; }
        const float ps = ps2.x + ps2.y;
        lsum = lsum * alpha + ps;
        if (__builtin_amdgcn_ballot_w64(alpha != 1.0f) != 0ull) {
#pragma unroll
            for (int i = 0; i < 16; ++i) { ot[0][i] *= alpha; ot[1][i] *= alpha; } }
        s16x4 vlo[2][2][2], vhi[2][2][2];
#pragma unroll
        for (int kt = 0; kt < 2; ++kt)
#pragma unroll
            for (int sp = 0; sp < 2; ++sp)
#pragma unroll
                for (int dt = 0; dt < 2; ++dt) { const PG8_LAS unsigned char* vrow = (const PG8_LAS unsigned char*)(vb + (32 * dt + c) * 136 + (32 * kt + 16 * sp + 4 * hh) * 2);
                    vlo[kt][sp][dt] = *(const PG8_LAS s16x4*)vrow; vhi[kt][sp][dt] = *(const PG8_LAS s16x4*)(vrow + 16); }
#pragma unroll
        for (int kt = 0; kt < 2; ++kt)
#pragma unroll
            for (int sp = 0; sp < 2; ++sp) {
                const bf16x8 pk = pack8(st[kt][8 * sp], st[kt][8 * sp + 1], st[kt][8 * sp + 2], st[kt][8 * sp + 3], st[kt][8 * sp + 4], st[kt][8 * sp + 5], st[kt][8 * sp + 6], st[kt][8 * sp + 7]);
#pragma unroll
                for (int dt = 0; dt < 2; ++dt) { const bf16x8 va = __builtin_shufflevector(vlo[kt][sp][dt], vhi[kt][sp][dt], 0, 1, 2, 3, 4, 5, 6, 7); ot[dt] = mfma32p(va, pk, ot[dt]); } }
        if (it + 1 < nt) { const int nx = cur ^ 1;
            *(u32x4*)(Kb + nx * 9216 + srow * 144 + sseg * 16) = kr;
            u32x2* d = (u32x2*)(Vb + nx * 8704 + srow * 136 + sseg * 16); u32x2 a; a.x = vr.x; a.y = vr.y; u32x2 b; b.x = vr.z; b.y = vr.w; d[0] = a; d[1] = b; }
        __syncthreads();
    }
    const float ltot = lsum + shx(lsum, 32, lane); const float inv = 1.0f / ltot;
    bf16_t* op = MIX + (size_t)qtok * 1024 + hq * 64;
#pragma unroll
    for (int dt = 0; dt < 2; ++dt)
#pragma unroll
        for (int g4 = 0; g4 < 4; ++g4) { u32x2 pw; pw.x = pk2(ot[dt][4 * g4] * inv, ot[dt][4 * g4 + 1] * inv); pw.y = pk2(ot[dt][4 * g4 + 2] * inv, ot[dt][4 * g4 + 3] * inv);
            stg8(op + 32 * dt + 8 * g4 + 4 * hh, pw); }
}

template <int DIR, bool FULL>
DI void ssm_pass(int layer, int pr, int g, const bf16_t* __restrict__ U, const bf16x8* __restrict__ Bm, const bf16x8* __restrict__ Cm, const float* __restrict__ lam,
                 const float* __restrict__ state_in, const float* sseg_r, float* sseg_w, float* YF, bf16_t* __restrict__ G, const float* __restrict__ dskip,
                 float* __restrict__ out_state, unsigned char* hl, int wv) {
    const int lane = ltid(wv) & 63, c = lane & 31, hh = lane >> 5, fr = lane & 15, kq = lane >> 4;
    const int ldg = (layer * 2 + DIR) * 32 + g;
    bf16x8 bm[4], cm[4];
#pragma unroll
    for (int i = 0; i < 4; ++i) { bm[i] = Bm[(ldg * 4 + i) * 64 + lane]; if (FULL) cm[i] = Cm[(ldg * 4 + i) * 64 + lane]; }
    const float l0r = lam[(ldg * 64 + c) * 2], l0i = lam[(ldg * 64 + c) * 2 + 1], l1r = lam[(ldg * 64 + 32 + c) * 2], l1i = lam[(ldg * 64 + 32 + c) * 2 + 1];
    const int s = 2 * pr + hh;
    float h0r = 0.f, h0i = 0.f, h1r = 0.f, h1i = 0.f;
    if (FULL && pr >= 16) {
        const int sl = s - 32, b = sl >> 3, seg = sl & 7;
        float a0r = l0r, a0i = l0i, a1r = l1r, a1i = l1i;
#pragma unroll
        for (int i = 0; i < 8; ++i) { const float t0 = a0r * a0r - a0i * a0i, t1 = 2.f * a0r * a0i; a0r = t0; a0i = t1; const float t2 = a1r * a1r - a1i * a1i, t3 = 2.f * a1r * a1i; a1r = t2; a1i = t3; }
        const float* si = state_in + ((((size_t)(b * 2 + layer) * 2 + DIR) * 2) * 32 + g) * 64;
        h0r = si[c]; h0i = si[2048 + c]; h1r = si[32 + c]; h1i = si[2048 + 32 + c];
        const int n = DIR == 0 ? seg : 7 - seg;
        for (int jj = 0; jj < n; ++jj) { const int j = DIR == 0 ? jj : 7 - jj;
            const float* sp = sseg_r + ((((size_t)(b * 8 + j) * 2 + DIR) * 32 + g) * 64) * 2;
            const float s0r = sp[c * 2], s0i = sp[c * 2 + 1], s1r = sp[(32 + c) * 2], s1i = sp[(32 + c) * 2 + 1];
            const float n0r = a0r * h0r - a0i * h0i + s0r, n0i = a0r * h0i + a0i * h0r + s0i; h0r = n0r; h0i = n0i;
            const float n1r = a1r * h1r - a1i * h1i + s1r, n1i = a1r * h1i + a1i * h1r + s1i; h1r = n1r; h1i = n1i; }
    }
    const int seq_r = (c >> 2) & 1, q_r = (c & 3) + 4 * (c >> 3);
    const bf16_t* ua_ptr = U + ((size_t)((2 * pr + seq_r) * 256 + q_r)) * 512 + g * 16 + 8 * hh;
    f32x16 zero16;
#pragma unroll
    for (int i = 0; i < 16; ++i) zero16[i] = 0.f;
    auto ldu = [&](int ch) -> bf16x8 { return __builtin_bit_cast(bf16x8, ldg16(ua_ptr + (size_t)(DIR ? 240 - 16 * ch : 16 * ch) * 512)); };
    auto body = [&](const bf16x8 ua, int ch) {
        const int cb = DIR ? 240 - 16 * ch : 16 * ch;
        f32x16 x[4];
#pragma unroll
        for (int i = 0; i < 4; ++i) x[i] = mfma32(ua, bm[i], zero16);
#pragma unroll
        for (int i = 0; i < 16; ++i) { const int reg = DIR ? 15 - i : i;
            const float n0r = __builtin_fmaf(l0r, h0r, __builtin_fmaf(-l0i, h0i, x[0][reg])), n0i = __builtin_fmaf(l0r, h0i, __builtin_fmaf(l0i, h0r, x[1][reg])); h0r = n0r; h0i = n0i;
            const float n1r = __builtin_fmaf(l1r, h1r, __builtin_fmaf(-l1i, h1i, x[2][reg])), n1i = __builtin_fmaf(l1r, h1i, __builtin_fmaf(l1i, h1r, x[3][reg])); h1r = n1r; h1i = n1i;
            if (FULL) { unsigned* hrow = (unsigned*)(hl + (hh * 16 + reg) * 272); hrow[c] = pk2(h0r, h0i); hrow[32 + c] = pk2(h1r, h1i); } }
        if (FULL) {
#pragma unroll
            for (int sq = 0; sq < 2; ++sq) { f32x4 y = (f32x4){0.f, 0.f, 0.f, 0.f};
#pragma unroll
                for (int ks = 0; ks < 4; ++ks) { const bf16x8 af = *(const bf16x8*)(hl + (sq * 16 + fr) * 272 + (32 * ks + 8 * kq) * 2); y = mfma16(cm[ks], af, y); }
                { u32x2 pw; pw.x = pk2(y[0], y[1]); pw.y = pk2(y[2], y[3]); stg8((bf16_t*)YF + ((size_t)((2 * pr + sq) * 256 + cb + fr)) * 512 + g * 16 + 4 * kq, pw); } }
        }
    };
    bf16x8 u0 = ldu(0), u1 = ldu(1), u2 = ldu(2), u3 = ldu(3);
#pragma unroll 1
    for (int c4 = 0; c4 < 16; c4 += 4) {
        const bool more = c4 + 4 < 16;
        body(u0, c4);     if (more) u0 = ldu(c4 + 4);
        body(u1, c4 + 1); if (more) u1 = ldu(c4 + 5);
        body(u2, c4 + 2); if (more) u2 = ldu(c4 + 6);
        body(u3, c4 + 3); if (more) u3 = ldu(c4 + 7);
    }
    if (FULL) { if (pr < 16) { float* os = out_state + ((((size_t)(s * 2 + layer) * 2 + DIR) * 2) * 32 + g) * 64; os[c] = h0r; os[2048 + c] = h0i; os[32 + c] = h1r; os[2048 + 32 + c] = h1i; } }
    else { float* sw = sseg_w + ((((size_t)(s - 32) * 2 + DIR) * 32 + g) * 64) * 2; sw[c * 2] = h0r; sw[c * 2 + 1] = h0i; sw[(32 + c) * 2] = h1r; sw[(32 + c) * 2 + 1] = h1i; }
}

#define XB_TMO      128
#define XB_XCNT(j)  (256  + 64 * (j))
#define XB_XSUB(j)  (1280 + 64 * (j))
#define XB_XGEN(j)  (2304 + 64 * (j))
#define XB_TOP      3328
#define XB_TOPGEN   3392
#define XCD_BAR_WORDS 3456
#define XB_SPIN_CAP (1u << 18)
#define LAS __attribute__((address_space(3)))

__device__ __forceinline__ unsigned xb_ld(unsigned* p)              { return __hip_atomic_load(p, __ATOMIC_RELAXED, __HIP_MEMORY_SCOPE_AGENT); }
__device__ __forceinline__ unsigned xb_add(unsigned* p, unsigned v) { return __hip_atomic_fetch_add(p, v, __ATOMIC_RELAXED, __HIP_MEMORY_SCOPE_AGENT); }
__device__ __forceinline__ unsigned xb_xcc_id() { return (unsigned)__builtin_amdgcn_s_getreg((3 << 11) | 20) & 0xFu; }
#define XB_SPIN(cond, bar) do { unsigned _sp = 0; while (cond) { __builtin_amdgcn_s_sleep(1); \
    if ((++_sp & 255u) == 0u) { if (xb_ld(&(bar)[XB_TMO])) break; if (_sp > XB_SPIN_CAP) { atomicAdd(&(bar)[XB_TMO], 1u); break; } } } } while (0)

struct XcdBarrier {
    unsigned* bar; unsigned x;
    volatile LAS unsigned* st;
};

__device__ __forceinline__ XcdBarrier xcd_barrier_post(unsigned* bar, volatile LAS unsigned* st) {
    XcdBarrier b; b.bar = bar; b.x = xb_xcc_id(); b.st = st;
    if (threadIdx.x == 0) (void)xb_add(&bar[XB_XCNT(b.x)], 1u);
    return b;
}
__device__ __forceinline__ void xcd_barrier_complete(unsigned* bar, unsigned x, unsigned& nloc, unsigned& nx) {
    const unsigned G = gridDim.x * gridDim.y * gridDim.z;
    unsigned sum, cnt, mine, sp = 0u;
    for (;;) {
        sum = 0u; cnt = 0u; mine = 0u;
#pragma unroll
        for (unsigned j = 0; j < 16; ++j) { const unsigned c = xb_ld(&bar[XB_XCNT(j)]); sum += c; cnt += (c > 0u) ? 1u : 0u; mine = (j == x) ? c : mine; }
        if (sum == G) break;
        __builtin_amdgcn_s_sleep(1);
        if ((++sp & 255u) == 0u) { if (xb_ld(&bar[XB_TMO])) break; if (sp > XB_SPIN_CAP) { atomicAdd(&bar[XB_TMO], 1u); break; } }
    }
    nloc = mine > 0u ? mine : 1u; nx = cnt > 0u ? cnt : 1u;
}

__device__ __forceinline__ void xcd_barrier(const XcdBarrier& b) {
    asm volatile("s_waitcnt vmcnt(0)" ::: "memory");
    __syncthreads();
    if (threadIdx.x == 0) {
        unsigned* bar = b.bar;
        __builtin_amdgcn_s_waitcnt(0);
        unsigned nloc = b.st[0], nx = b.st[1];
        if (nloc == 0u) { xcd_barrier_complete(bar, b.x, nloc, nx); b.st[0] = nloc; b.st[1] = nx; }
        const unsigned old = xb_add(&bar[XB_XSUB(b.x)], 1u);
        const unsigned gen = old / nloc;
        if (old + 1u == (gen + 1u) * nloc) {
            __builtin_amdgcn_fence(__ATOMIC_RELEASE, "agent");
            asm volatile("s_waitcnt vmcnt(0)" ::: "memory");
            const unsigned og = xb_add(&bar[XB_TOP], 1u);
            const unsigned tg = og / nx;
            if (og + 1u == (tg + 1u) * nx) xb_add(&bar[XB_TOPGEN], 1u);
            else XB_SPIN(xb_ld(&bar[XB_TOPGEN]) == tg, bar);
            __builtin_amdgcn_fence(__ATOMIC_ACQUIRE, "agent");
            xb_add(&bar[XB_XGEN(b.x)], 1u);
            asm volatile("s_waitcnt vmcnt(0)" ::: "memory");
        } else {
            XB_SPIN(xb_ld(&bar[XB_XGEN(b.x)]) == gen, bar);
            __builtin_amdgcn_fence(__ATOMIC_ACQUIRE, "agent");
            asm volatile("s_waitcnt vmcnt(0)" ::: "memory");
        }
    }
    __syncthreads();
}


typedef const __attribute__((address_space(4))) Params* KParamsPtr;
DI KParamsPtr kparams() { KParamsPtr p = (KParamsPtr)__builtin_amdgcn_kernarg_segment_ptr(); asm volatile("" : "+s"(p)); return p; }
#define PKP (kparams())
__global__ __launch_bounds__(512, 2) void mega_fwd(Params P) {
    extern __shared__ __attribute__((aligned(16))) unsigned char shm[];
    cg::grid_group grid = cg::this_grid();
#define WSP_ (opaque_ptr(PKP->ws))
#define XP_ ((float*)opaque_ptr((unsigned char*)PKP->out))
#define MODS_ ((const float*)(WSP_ + WS_MODS))
#define HB_ ((bf16_t*)(WSP_ + WS_H))
#define YFP_ ((float*)(WSP_ + WS_H))
#define QB_ ((bf16_t*)(WSP_ + WS_Q))
#define UB_ ((bf16_t*)(WSP_ + WS_U))
#define MIXB_ ((bf16_t*)(WSP_ + WS_MIX))
#define GB_ ((bf16_t*)(WSP_ + WS_G))
#define ACTB_ ((bf16_t*)(WSP_ + WS_ACT))
#define KCTX_ ((bf16_t*)(WSP_ + WS_KCTX))
#define VCTX_ ((bf16_t*)(WSP_ + WS_VCTX))
    const int w = __builtin_amdgcn_readfirstlane(threadIdx.x >> 6);
    if (PKP->ws == nullptr) grid.sync();
    if (threadIdx.x == 0) { ((volatile LAS unsigned*)(shm + 131072))[0] = 0u; ((volatile LAS unsigned*)(shm + 131072))[1] = 0u; }
    __syncthreads();
    (void)xcd_barrier_post((unsigned*)(WSP_ + WS_BAR), (volatile LAS unsigned*)(shm + 131072));
#define GSYNC() do { XcdBarrier b_; b_.bar = (unsigned*)(opaque_ptr(PKP->ws) + WS_BAR); b_.x = xb_xcc_id(); b_.st = (volatile LAS unsigned*)(shm + 131072); xcd_barrier(b_); } while (0)

    { Params Pl; for (int i = 0; i < 28; ++i) Pl.in[i] = PKP->in[i]; Pl.out = PKP->out; Pl.ws = PKP->ws; phase0(Pl, shm, w); }
    GSYNC();
    { const int tid = ltid(w); const float* rcg = (const float*)(WSP_ + WS_ROPEC); const float* rsg = (const float*)(WSP_ + WS_ROPES); float* lrw = (float*)(shm + LDS_ROPE);
      { const int e = tid, r = e >> 4, i = e & 15; lrw[e] = rcg[(64 * r) * 32 + i]; lrw[512 + e] = rsg[(64 * r) * 32 + i]; }
      for (int e = tid; e < 1024; e += 512) { const int cidx = e >> 4, i = e & 15; lrw[1024 + e] = rcg[cidx * 32 + 16 + i]; lrw[2048 + e] = rsg[cidx * 32 + 16 + i]; }
      __syncthreads(); }
#pragma unroll 1
    for (int l = 0; l < 2; ++l) {
#define MODSL_ (MODS_ + l * 5 * 6144)
#define XA_ (PKP->in[0])
#define XH_ ((bf16_t*)(WSP_ + WS_XB))
#define XB_ (PKP->in[1])
#define KLAT_ ((bf16_t*)(WSP_ + WS_KLAT + l * SZ_KLAT))
#define VLAT_ ((bf16_t*)(WSP_ + WS_VLAT + l * SZ_KLAT))
        if (l == 0) {
            const int tid = ltid(w); const float* part = (const float*)(WSP_ + WS_MODP); const float* bm_ = PKP->in[8]; float* mw = (float*)(WSP_ + WS_MODS); float* ldsf = (float*)opaque_ptr(shm);
            for (int idx = blockIdx.x * 512 + tid; idx < 61440; idx += gridDim.x * 512) { const int ll = idx / 30720, n = idx % 6144;
                mw[idx] = part[idx] + part[61440 + idx] + part[2 * 61440 + idx] + part[3 * 61440 + idx] + bm_[ll * 6144 + n]; }
#pragma unroll
            for (int it = 0; it < 20; ++it) { const int e = it * 512 + tid; const int j = e >> 11, r = e & 2047; const int idx = j * 6144 + r;
                ldsf[e] = part[idx] + part[61440 + idx] + part[2 * 61440 + idx] + part[3 * 61440 + idx] + bm_[r]; }
            __syncthreads();
            for (int rep = 0; rep < REP_NORM; ++rep) norm_phase(XA_, XB_, nullptr, PKP->in[9], ldsf, 2048, 0, 1024, HB_, w);
        } else
        for (int rep = 0; rep < REP_NORM; ++rep) norm_phase(XA_, XB_, XH_, PKP->in[9] + l * 1024, MODSL_, 6144, 0, 1024, HB_, w);
        GSYNC();
        { EpiIn E; E.layer = l; E.qn = PKP->in[12] + l * 64; E.kn = PKP->in[13] + l * 64; E.lr = (const PG8_LAS float*)(shm + LDS_ROPE);
          E.Q = QB_; E.U = UB_; E.Kctx = KCTX_; E.Vctx = VCTX_; E.Klat = KLAT_; E.Vlat = VLAT_; E.outk = PKP->out + OUT_K; E.outv = PKP->out + OUT_V;
          { pg8::Gemm g; g.A = HB_; g.Bt = (const bf16_t*)(WSP_ + WS_WIN + l * SZ_WIN); g.M = NTOK; g.N = 1280; g.K = 1024;
            ListOrder S; S.count = 256; S.G = (int)gridDim.x; S.c = (int)blockIdx.x; S.mode = 0;
            pg8::gemm_phase<EpiIn, ListOrder, false>((PG8_LAS unsigned char*)shm, g, S, E, nullptr, w); }
          GSYNC();
          { pg8::Gemm g; g.A = HB_; g.Bt = (const bf16_t*)(WSP_ + WS_WIN + l * SZ_WIN); g.M = NTOK; g.N = 1280; g.K = 1024;
            ListOrder S; S.count = 64; S.G = (int)gridDim.x; S.c = (int)blockIdx.x; S.mode = 1;
            pg8::gemm_phase<EpiIn, ListOrder, false>((PG8_LAS unsigned char*)shm, g, S, E, nullptr, w); } }
        { const int nb = gridDim.x > 64 ? 64 : 0;
          if ((int)blockIdx.x >= nb)
          for (int it = blockIdx.x - nb; it < 384; it += gridDim.x - nb) {
            __syncthreads();
            if (it < 256) { const int qc = it & 3, kvh = (it >> 2) & 1, b = it >> 3;
                attn_item(QB_, KCTX_ + ((size_t)(b * 2 + kvh) * 256) * 64, VCTX_ + ((size_t)(b * 2 + kvh) * 64) * 256, 256, 256, b * 256 + qc * 64, kvh, MIXB_, shm, w); }
            else { const int wi = (it - 256) * 8 + w; const int dir = wi & 1, g = (wi >> 1) & 31, pr = 16 + (wi >> 6);
                if (dir == 0) ssm_pass<0, false>(l, pr, g, UB_, (const bf16x8*)(WSP_ + WS_SSMB), (const bf16x8*)(WSP_ + WS_SSMC), (const float*)(WSP_ + WS_SSML), PKP->in[4], nullptr, (float*)(WSP_ + WS_SSEG), nullptr, nullptr, nullptr, nullptr, nullptr, w);
                else ssm_pass<1, false>(l, pr, g, UB_, (const bf16x8*)(WSP_ + WS_SSMB), (const bf16x8*)(WSP_ + WS_SSMC), (const float*)(WSP_ + WS_SSML), PKP->in[4], nullptr, (float*)(WSP_ + WS_SSEG), nullptr, nullptr, nullptr, nullptr, nullptr, w); }
          } }
        GSYNC();
        for (int rep = 0; rep < REP_ATT4; ++rep)
        for (int it = blockIdx.x; it < 512; it += gridDim.x) {
            __syncthreads();
            if (it < 256) { const int qc = it >> 3, kvh = it & 1, b = (it >> 1) & 3;
                attn_item(QB_, KLAT_ + ((size_t)(b * 2 + kvh) * 2560) * 64, VLAT_ + ((size_t)(b * 2 + kvh) * 64) * 2560, 2560, 2560, NCTX + b * 2048 + qc * 64, kvh, MIXB_, shm, w); }
            else { const int si = it - 256, pr = si >> 3, gq = si & 7, g = gq * 4 + (w & 3);
                if (w < 4) ssm_pass<0, true>(l, pr, g, UB_, (const bf16x8*)(WSP_ + WS_SSMB), (const bf16x8*)(WSP_ + WS_SSMC), (const float*)(WSP_ + WS_SSML), PKP->in[4], (const float*)(WSP_ + WS_SSEG), nullptr, YFP_, nullptr, nullptr, PKP->out + OUT_S, shm + w * 8704, w);
                else ssm_pass<1, true>(l, pr, g, UB_, (const bf16x8*)(WSP_ + WS_SSMB), (const bf16x8*)(WSP_ + WS_SSMC), (const float*)(WSP_ + WS_SSML), PKP->in[4], (const float*)(WSP_ + WS_SSEG), nullptr, (float*)(WSP_ + WS_YB), nullptr, nullptr, PKP->out + OUT_S, shm + w * 8704, w);
                __syncthreads();
                { const int tid = ltid(w); const float* YBp = (const float*)(WSP_ + WS_YB); const float* dsk = PKP->in[21] + l * 512;
#pragma unroll 4
                  for (int i = 0; i < 8; ++i) { const int idx = i * 512 + tid, tk = pr * 512 + (idx >> 3), ch = gq * 64 + (idx & 7) * 8; const size_t o = (size_t)tk * 512 + ch;
                      const u32x4 yfw = *(const u32x4*)((const bf16_t*)YFP_ + o), ybw = *(const u32x4*)((const bf16_t*)YBp + o), uw = *(const u32x4*)(UB_ + o); const f32x4 d0 = *(const f32x4*)(dsk + ch), d1 = *(const f32x4*)(dsk + ch + 4);
                      const f32x2 g0 = gelu_pk((f32x2){bflo(yfw.x) + bflo(ybw.x) + d0[0] * bflo(uw.x), bfhi(yfw.x) + bfhi(ybw.x) + d0[1] * bfhi(uw.x)});
                      const f32x2 g1 = gelu_pk((f32x2){bflo(yfw.y) + bflo(ybw.y) + d0[2] * bflo(uw.y), bfhi(yfw.y) + bfhi(ybw.y) + d0[3] * bfhi(uw.y)});
                      const f32x2 g2 = gelu_pk((f32x2){bflo(yfw.z) + bflo(ybw.z) + d1[0] * bflo(uw.z), bfhi(yfw.z) + bfhi(ybw.z) + d1[1] * bfhi(uw.z)});
                      const f32x2 g3 = gelu_pk((f32x2){bflo(yfw.w) + bflo(ybw.w) + d1[2] * bflo(uw.w), bfhi(yfw.w) + bfhi(ybw.w) + d1[3] * bfhi(uw.w)});
                      u32x4 pw; pw.x = pk2(g0.x, g0.y); pw.y = pk2(g1.x, g1.y); pw.z = pk2(g2.x, g2.y); pw.w = pk2(g3.x, g3.y); *(u32x4*)(GB_ + o) = pw; } } }
        }
        GSYNC();
        { EpiGlu E; E.G = GB_; E.bias = PKP->in[23] + l * 512; E.MIX = MIXB_; for (int rep = 0; rep < REP_GLU; ++rep) run_gemm(shm, GB_, (const bf16_t*)(WSP_ + WS_WGLU + l * SZ_WGLU), 512, 512, E, w); }
        GSYNC();
        { EpiRes E; E.xa = XA_; E.xb = XB_; E.xh = l == 0 ? nullptr : XH_; E.Xo = XH_; E.gate = MODSL_ + 2 * 1024; run_gemm(shm, MIXB_, (const bf16_t*)(WSP_ + WS_WOUT + l * SZ_WOUT), 1024, 1024, E, w); }
        GSYNC();
        for (int rep = 0; rep < REP_NORM; ++rep) norm_phase(XA_, XB_, XH_, PKP->in[10] + l * 1024, MODSL_, 6144, 3 * 1024, 4 * 1024, HB_, w);
        GSYNC();
        { EpiFfn1 E; E.ACT = ACTB_; for (int rep = 0; rep < REP_F1; ++rep) run_gemm(shm, HB_, (const bf16_t*)(WSP_ + WS_WF1 + l * SZ_WF1), 5632, 1024, E, w); }
        GSYNC();
        { EpiRes E; E.xa = XA_; E.xb = XB_; E.xh = XH_; E.Xo = XH_; E.gate = MODSL_ + 5 * 1024; run_gemm(shm, ACTB_, (const bf16_t*)(WSP_ + WS_WF2 + l * SZ_WF2), 1024, 2816, E, w); }
        GSYNC();
    }
    final_norm_phase(XH_, XP_, PKP->in[27], w);
}
#undef WSP_
#undef XP_
#undef MODS_
#undef HB_
#undef YFP_
#undef QB_
#undef UB_
#undef MIXB_
#undef GB_
#undef ACTB_
#undef KCTX_
#undef VCTX_
#undef MODSL_
#undef XA_
#undef XH_
#undef XB_
#undef KLAT_
#undef VLAT_

extern "C" void kernel_launch(void* const* d_in, const int* in_sizes, int n_in, void* d_out, int out_size, void* d_ws, size_t ws_size, hipStream_t stream) {
    static int grid_blocks = 0;
    if (grid_blocks == 0) {
        if (n_in < 28 || ws_size < WS_END) { fprintf(stderr, "kernel_launch: need 28 inputs and %zu bytes of workspace (got %d, %zu)\n", (size_t)WS_END, n_in, ws_size); grid_blocks = -1; return; }
        int dev = 0, cus = 0, per_cu = 0;
        (void)hipGetDevice(&dev);
        (void)hipDeviceGetAttribute(&cus, hipDeviceAttributeMultiprocessorCount, dev);
        if (hipFuncSetAttribute((const void*)mega_fwd, hipFuncAttributeMaxDynamicSharedMemorySize, LDS_BYTES) != hipSuccess) fprintf(stderr, "kernel_launch: hipFuncSetAttribute failed\n");
        if (hipOccupancyMaxActiveBlocksPerMultiprocessor(&per_cu, (const void*)mega_fwd, 512, LDS_BYTES) != hipSuccess || per_cu < 1) { per_cu = 1; (void)hipGetLastError(); }
        if (per_cu > 1) per_cu = 1;
        grid_blocks = cus * per_cu;
    }
    if (grid_blocks < 0) return;
    (void)hipMemsetAsync((unsigned char*)d_ws + WS_BAR, 0, SZ_BAR, stream);
    Params p{};
    for (int i = 0; i < 28; ++i) p.in[i] = (const float*)d_in[i];
    p.out = (float*)d_out; p.ws = (unsigned char*)d_ws;
    void* args[] = {&p};
    hipError_t e = hipLaunchCooperativeKernel((const void*)mega_fwd, dim3(grid_blocks), dim3(512), args, LDS_BYTES, stream);
    if (e != hipSuccess) fprintf(stderr, "cooperative launch failed: %s (grid %d)\n", hipGetErrorString(e), grid_blocks);
}
```
